# Optimizing an MI355X kernel written in HIP

```python
import math
import jax
import jax.numpy as jnp
from jax import lax
import numpy as np

D_MODEL = 1024
BATCH = 2
SEQ = 16384
DEPTH = 1

D_MIX = D_MODEL
D_HYENA = D_MIX // 2
D_POOL = D_MIX - D_HYENA
HYENA_ORDER = 2
SHORT_CONV = 3
FILTER_EMB = 33
FILTER_HIDDEN = 64
FILTER_INNER = 2
DECAY_TARGET = 1e-2
FAST_DECAY_PCT = 0.3
SLOW_DECAY_PCT = 1.5
POOL_WINDOWS = (2, 4, 8, 16)
N_POOL_GROUPS = len(POOL_WINDOWS)
POOL_GROUP = D_POOL // N_POOL_GROUPS
D_HY_STREAMS = (HYENA_ORDER + 1) * D_HYENA
D_IN_PROJ = D_HY_STREAMS + D_HYENA + 2 * D_POOL
DEEPNORM_ALPHA = (2.0 * DEPTH) ** 0.25
DEEPNORM_BETA = (8.0 * DEPTH) ** -0.25
LN_EPS = 1e-5

kernel_name = "hybrid_hyena_pool_adaln_deepnorm_encoder"


def _layer_norm(x, g, b):
    xf = x.astype(jnp.float32)
    mu = jnp.mean(xf, axis=-1, keepdims=True)
    var = jnp.mean(jnp.square(xf - mu), axis=-1, keepdims=True)
    y = (xf - mu) * lax.rsqrt(var + LN_EPS)
    return (y * g.astype(jnp.float32) + b.astype(jnp.float32)).astype(x.dtype)


def _short_conv(u, w, b):
    L = u.shape[1]
    pad = SHORT_CONV // 2
    up = jnp.pad(u, ((0, 0), (pad, SHORT_CONV - 1 - pad), (0, 0)))
    out = b
    for j in range(SHORT_CONV):
        out = out + up[:, j:j + L] * w[j]
    return out


def _filter_pos_features(L):
    t = jnp.linspace(0.0, 1.0, L, dtype=jnp.float32)[:, None]
    bands = (FILTER_EMB - 1) // 2
    w = (2.0 * math.pi / L) * jnp.arange(L, dtype=jnp.float32)[:, None]
    f = jnp.linspace(1e-4, bands - 1, bands, dtype=jnp.float32)[None, :]
    z = jnp.concatenate([t, jnp.cos(f * w), -jnp.sin(f * w)], axis=-1)
    return t, z


def _decay_window(t):
    min_decay = math.log(DECAY_TARGET) / SLOW_DECAY_PCT
    max_decay = math.log(DECAY_TARGET) / FAST_DECAY_PCT
    deltas = jnp.linspace(min_decay, max_decay, D_HYENA, dtype=jnp.float32)
    return jnp.exp(-t * jnp.abs(deltas)[None, :])


def _hyena_filters_freq(z_pos, decay, w1, b1, w_inner, b_inner, w_out, freq):
    L = z_pos.shape[0]
    f32 = jnp.float32
    fr = freq.astype(f32)
    h = jnp.sin(fr * (z_pos @ w1.astype(f32) + b1.astype(f32)))
    for i in range(FILTER_INNER):
        h = jnp.sin(fr * (h @ w_inner[i].astype(f32) + b_inner[i].astype(f32)))
    k = (h @ w_out.astype(f32)).reshape(L, HYENA_ORDER, 2, D_HYENA)
    k = k * decay[:, None, None, :]
    k2 = jnp.concatenate([k[:, :, 0], k[::-1, :, 1]], axis=0)
    return jnp.fft.rfft(k2, n=2 * L, axis=0)


def _bidir_long_conv(u, k_freq, bias):
    L = u.shape[1]
    u_freq = jnp.fft.rfft(u, n=2 * L, axis=1)
    y = jnp.fft.irfft(u_freq * k_freq[None], n=2 * L, axis=1)[:, :L]
    return y + u * bias.astype(jnp.float32)


def _hyena_branch(streams, conv_w, conv_b, k_freq, bias):
    s = _short_conv(streams, conv_w, conv_b).astype(jnp.float32)
    v, x1, x2 = jnp.split(s, HYENA_ORDER + 1, axis=-1)
    z = v
    for o, g in enumerate((x1, x2)):
        z = g * _bidir_long_conv(z, k_freq[:, o], bias[o])
    return z


def _pool_branch(u, pool_w, pool_scale):
    B, L, _ = u.shape
    uf = u.astype(jnp.float32)
    cs = jnp.pad(jnp.cumsum(uf, axis=1), ((0, 0), (1, 0), (0, 0)))
    pos = jnp.arange(L)
    groups = []
    for g, w in enumerate(POOL_WINDOWS):
        sl = slice(g * POOL_GROUP, (g + 1) * POOL_GROUP)
        hi = jnp.minimum(pos + w // 2, L)
        lo = jnp.maximum(pos - w // 2, 0)
        cnt = (hi - lo).astype(jnp.float32)[None, :, None]
        mean = (cs[:, hi, sl] - cs[:, lo, sl]) / cnt
        groups.append(mean - uf[..., sl])
    p = jnp.stack(groups, axis=2)
    p = jnp.einsum('blgc,gcd->blgd', p, pool_w.astype(jnp.float32)).reshape(B, L, D_POOL)
    return p * pool_scale.astype(jnp.float32)


def setup_inputs(seed: int = 0) -> dict:
    key = jax.random.key(seed)
    ks = jax.random.split(key, 21)
    f32 = jnp.float32

    def nrm(k, shape, scale):
        return jax.random.normal(k, shape, f32) * scale

    n = DEPTH
    return {
        "x": nrm(ks[0], (BATCH, SEQ, D_MODEL), 1.0),
        "c": nrm(ks[1], (BATCH, D_MODEL), 1.0),
        "w_ada": nrm(ks[2], (n, D_MODEL, 3 * D_MODEL), 0.5 * D_MODEL ** -0.5),
        "b_ada": nrm(ks[3], (n, 3 * D_MODEL), 0.02),
        "w_in": nrm(ks[4], (n, D_MODEL, D_IN_PROJ), D_MODEL ** -0.5),
        "b_in": nrm(ks[5], (n, D_IN_PROJ), 0.02),
        "conv_w": nrm(ks[6], (n, SHORT_CONV, D_HY_STREAMS), SHORT_CONV ** -0.5),
        "conv_b": nrm(ks[7], (n, D_HY_STREAMS), 0.02),
        "filt_w1": nrm(ks[8], (n, FILTER_EMB, FILTER_HIDDEN), FILTER_EMB ** -0.5),
        "filt_b1": nrm(ks[9], (n, FILTER_HIDDEN), 0.1),
        "filt_w_inner": nrm(ks[10], (n, FILTER_INNER, FILTER_HIDDEN, FILTER_HIDDEN), FILTER_HIDDEN ** -0.5),
        "filt_b_inner": nrm(ks[11], (n, FILTER_INNER, FILTER_HIDDEN), 0.1),
        "filt_w_out": nrm(ks[12], (n, FILTER_HIDDEN, HYENA_ORDER * 2 * D_HYENA),
                          FILTER_HIDDEN ** -0.5 * (SEQ / 8.0) ** -0.5),
        "filt_freq": 1.0 + nrm(ks[13], (n, FILTER_HIDDEN), 0.1),
        "hyena_bias": nrm(ks[14], (n, HYENA_ORDER, D_HYENA), 1.0),
        "pool_w": nrm(ks[15], (n, N_POOL_GROUPS, POOL_GROUP, POOL_GROUP), POOL_GROUP ** -0.5),
        "pool_scale": 1.0 + nrm(ks[16], (n, D_POOL), 0.1),
        "w_out": nrm(ks[17], (n, D_MIX, D_MODEL), D_MIX ** -0.5 * DEEPNORM_BETA),
        "b_out": nrm(ks[18], (n, D_MODEL), 0.02),
        "ln_g": 1.0 + nrm(ks[19], (n, D_MODEL), 0.05),
        "ln_b": nrm(ks[20], (n, D_MODEL), 0.02),
    }


def reference(x, c, w_ada, b_ada, w_in, b_in, conv_w, conv_b, filt_w1, filt_b1,
              filt_w_inner, filt_b_inner, filt_w_out, filt_freq, hyena_bias,
              pool_w, pool_scale, w_out, b_out, ln_g, ln_b):
    L = x.shape[1]
    t, z_pos = _filter_pos_features(L)
    decay = _decay_window(t)
    splits = [D_HY_STREAMS, D_HY_STREAMS + D_HYENA, D_HY_STREAMS + D_HYENA + D_POOL]
    h = x
    for layer in range(DEPTH):
        mod = jax.nn.silu(c) @ w_ada[layer] + b_ada[layer]
        shift, scale, gate = jnp.split(mod, 3, axis=-1)
        u = h * (1.0 + scale[:, None, :]) + shift[:, None, :]
        proj = u @ w_in[layer] + b_in[layer]
        hy_streams, hy_gate, pool_in, pool_gate = jnp.split(proj, splits, axis=-1)
        k_freq = _hyena_filters_freq(z_pos, decay, filt_w1[layer], filt_b1[layer],
                                     filt_w_inner[layer], filt_b_inner[layer],
                                     filt_w_out[layer], filt_freq[layer])
        y_h = _hyena_branch(hy_streams, conv_w[layer], conv_b[layer], k_freq, hyena_bias[layer])
        y_p = _pool_branch(pool_in, pool_w[layer], pool_scale[layer])
        y = jnp.concatenate([y_h * jax.nn.silu(hy_gate.astype(jnp.float32)),
                             y_p * jax.nn.silu(pool_gate.astype(jnp.float32))],
                            axis=-1).astype(x.dtype)
        out = gate[:, None, :] * (y @ w_out[layer] + b_out[layer])
        h = _layer_norm(DEEPNORM_ALPHA * h + out, ln_g[layer], ln_b[layer])
    return h
```

```cpp
#include <hip/hip_runtime.h>
#include <cstdio>
#include <cstdint>
#ifndef MK_N_LAUNCHES
#define MK_N_LAUNCHES 7
#endif
namespace pg8 {
#define PG8_LAS __attribute__((address_space(3)))
typedef unsigned short bf16_t;
typedef short bf16x8 __attribute__((ext_vector_type(8)));
typedef float f32x4 __attribute__((ext_vector_type(4)));
typedef unsigned u32x4 __attribute__((ext_vector_type(4)));
constexpr int BM = 256, BK = 64, HALF = 128, HTB = HALF * BK * 2  , STAGE_BYTES = 8 * HTB, NXCD = 8, WGM = 8;

__host__ __device__ __forceinline__ int lds_byte(int r, int c) { const int st = (r >> 4) * 2 + (c >> 5), rr = r & 15, cc = c & 31, ob = rr * 64 + cc * 2; return st * 1024 + (ob ^ (((ob >> 9) & 1) << 5)); }
__host__ __device__ __forceinline__ void stage_rc(int b, int& R, int& C) { const int st = b / 1024, sb = b % 1024, swz = sb ^ (((sb >> 9) & 1) << 5); R = (st >> 1) * 16 + swz / 64; C = (st & 1) * 32 + (swz % 64) / 2; }
__host__ __device__ __forceinline__ int perm32(int rho) { const int n = rho >> 4, i = rho & 15; return 8 * (i >> 2) + 4 * n + (i & 3); }

struct Unit { int pm, pn; };
struct Gemm { const bf16_t* A; const bf16_t* Bt; int M, N, K; };

struct StaticOrder {
    int nM, nN, nwg, G, c;
    __host__ __device__ void init(int M, int N, int G_, int c_) { nM = M / BM; nN = N / BM; nwg = nM * nN; G = G_; c = c_; }
    __host__ __device__ bool next(int i, Unit& u) const {
        const long L = (long)i * G + c; if (L >= nwg) return false;
        int wgid = (int)L; { const int q = nwg / NXCD, r = nwg % NXCD, xcd = wgid % NXCD, off = wgid / NXCD; wgid = (xcd < r ? xcd * (q + 1) : r * (q + 1) + (xcd - r) * q) + off; }
        const int nig = WGM * nN, gid = wgid / nig, fm = gid * WGM, gsz = (nM - fm) < WGM ? (nM - fm) : WGM;
        u.pm = fm + ((wgid % nig) % gsz); u.pn = (wgid % nig) / gsz; return true;
    }
    __device__ __forceinline__ void a_ready(const Unit&) const {}
    __device__ __forceinline__ void done(const Unit&) const {}
};
struct CountedOrder : StaticOrder {
    const unsigned* ready; unsigned need; unsigned* tmo;
    __device__ __forceinline__ void a_ready(const Unit& u) const {
        if (threadIdx.x < 64) {
            const unsigned long long t0 = __builtin_amdgcn_s_memrealtime(); unsigned polls = 0;
            while ((unsigned)__builtin_amdgcn_readfirstlane(__hip_atomic_load(ready + 64 * u.pm, __ATOMIC_RELAXED, __HIP_MEMORY_SCOPE_AGENT)) < need) {
                if ((++polls & 255u) == 0u && __builtin_amdgcn_readfirstlane(__hip_atomic_load(tmo, __ATOMIC_RELAXED, __HIP_MEMORY_SCOPE_AGENT)) != 0u) break;
                if (__builtin_amdgcn_s_memrealtime() - t0 > 2000000ull) {
                    if (threadIdx.x == 0) { unsigned expect = 0u; __hip_atomic_compare_exchange_strong(tmo + 1, &expect, 0x600u | (unsigned)(u.pm & 0xff), __ATOMIC_RELAXED, __ATOMIC_RELAXED, __HIP_MEMORY_SCOPE_AGENT); __hip_atomic_store(tmo, 1u, __ATOMIC_RELAXED, __HIP_MEMORY_SCOPE_AGENT); }
                    break; }
                __builtin_amdgcn_s_sleep(2); }
            __builtin_amdgcn_fence(__ATOMIC_ACQUIRE, "agent");
            asm volatile("s_waitcnt vmcnt(0)" ::: "memory");
        }
#if !defined(BROKEN_HOOK_NO_BARRIER)
        asm volatile("" ::: "memory"); __builtin_amdgcn_s_barrier(); asm volatile("" ::: "memory");
#endif
    }
};

__device__ __forceinline__ unsigned cvt_pk_bf16(float lo, float hi) { unsigned r; asm volatile("v_cvt_pk_bf16_f32 %0, %1, %2" : "=v"(r) : "v"(lo), "v"(hi)); return r; }
typedef float f32x2 __attribute__((ext_vector_type(2)));
__device__ __forceinline__ f32x2 gelu_pk(f32x2 v) {
    const f32x2 av = __builtin_elementwise_abs(v), d = av * 0.2316418882f + 1.0f;
    f32x2 t; t.x = __builtin_amdgcn_rcpf(d.x); t.y = __builtin_amdgcn_rcpf(d.y);
    f32x2 q = t * 0.5307027145f + (-0.7265760135f); q = q * t + 0.7107068705f; q = q * t + (-0.142248368f); q = q * t + 0.127414796f; q = q * t;
    const f32x2 s = (v * v) * (-0.72134752044f);
    f32x2 e; e.x = __builtin_amdgcn_exp2f(s.x); e.y = __builtin_amdgcn_exp2f(s.y);
    const f32x2 m = v * (q * e), r = v - m;
    f32x2 o; o.x = v.x < 0.f ? m.x : r.x; o.y = v.y < 0.f ? m.y : r.y; return o;
}

struct EpiF32 {
    static constexpr bool PERM = false, AFTER_DRAIN = false;
    float* C; int ldc; const float* bias;
    __device__ __forceinline__ void operator()(const f32x4 (&acc)[2][2][4][2], const Unit& u, int wr, int wc, int fr, int fq) const {
        const int row0 = u.pm * BM + wr * 64 + fr, col0 = u.pn * BM + wc * 32 + 4 * fq;
        f32x4 bv[2][2];
#pragma unroll
        for (int bj = 0; bj < 2; ++bj)
#pragma unroll
            for (int n = 0; n < 2; ++n) bv[bj][n] = bias ? *(const f32x4*)(bias + col0 + bj * HALF + n * 16) : (f32x4){0.f, 0.f, 0.f, 0.f};
#pragma unroll
        for (int ai = 0; ai < 2; ++ai)
#pragma unroll
            for (int m = 0; m < 4; ++m) { float* rowp = C + (size_t)(row0 + ai * HALF + m * 16) * ldc + col0;
#pragma unroll
                for (int bj = 0; bj < 2; ++bj)
#pragma unroll
                    for (int n = 0; n < 2; ++n) *(f32x4*)(rowp + bj * HALF + n * 16) = acc[ai][bj][m][n] + bv[bj][n]; }
    }
};
template <int ACT  > struct EpiBf16 {
    static constexpr bool PERM = true, AFTER_DRAIN = false;
    bf16_t* O; int ldc; const float* bias; int split_cols; size_t split_stride;
    __device__ __forceinline__ void operator()(const f32x4 (&acc)[2][2][4][2], const Unit& u, int wr, int wc, int fr, int fq) const {
        const int row0 = u.pm * BM + wr * 64 + fr; int colt = u.pn * BM; bf16_t* base = O;
        if (split_cols) { const int t = colt / split_cols; base += (size_t)t * split_stride; colt -= t * split_cols; }
        const int col0 = colt + wc * 32 + 8 * fq, bcol0 = u.pn * BM + wc * 32 + 8 * fq;
        f32x4 bv[2][2];
#pragma unroll
        for (int bj = 0; bj < 2; ++bj)
#pragma unroll
            for (int n = 0; n < 2; ++n) bv[bj][n] = bias ? *(const f32x4*)(bias + bcol0 + bj * HALF + 4 * n) : (f32x4){0.f, 0.f, 0.f, 0.f};
#pragma unroll
        for (int ai = 0; ai < 2; ++ai)
#pragma unroll
            for (int m = 0; m < 4; ++m) { bf16_t* rowp = base + (size_t)(row0 + ai * HALF + m * 16) * ldc + col0;
#pragma unroll
                for (int bj = 0; bj < 2; ++bj) { f32x4 v0 = acc[ai][bj][m][0] + bv[bj][0], v1 = acc[ai][bj][m][1] + bv[bj][1];
                    if (ACT == 1) { f32x2 a = gelu_pk((f32x2){v0[0], v0[1]}), b = gelu_pk((f32x2){v0[2], v0[3]}), c = gelu_pk((f32x2){v1[0], v1[1]}), d = gelu_pk((f32x2){v1[2], v1[3]});
                        v0 = (f32x4){a.x, a.y, b.x, b.y}; v1 = (f32x4){c.x, c.y, d.x, d.y}; }
                    if (ACT == 2) {
#pragma unroll
                        for (int j = 0; j < 4; ++j) { v0[j] = 0.5f * v0[j] * (1.0f + erff(v0[j] * 0.70710678f)); v1[j] = 0.5f * v1[j] * (1.0f + erff(v1[j] * 0.70710678f)); } }
                    u32x4 w; w.x = cvt_pk_bf16(v0[0], v0[1]); w.y = cvt_pk_bf16(v0[2], v0[3]); w.z = cvt_pk_bf16(v1[0], v1[1]); w.w = cvt_pk_bf16(v1[2], v1[3]);
                    *(u32x4*)(rowp + bj * HALF) = w; } }
    }
};

struct PanelStats {
    unsigned* xbuf;
    unsigned* cnt;
    unsigned* tmo;
    int ntn; float eps;
    unsigned code;
    __device__ __forceinline__ bool run(const f32x4 (&v)[2][2][4][2], const Unit& u, int wr, int wc, int fr, int fq, PG8_LAS unsigned char* lds, int wid, int lane) const {
        typedef float f32x2v __attribute__((ext_vector_type(2)));
        PG8_LAS f32x2v* P = (PG8_LAS f32x2v*)lds;
        PG8_LAS f32x2v* S = (PG8_LAS f32x2v*)(lds + 8192);
        PG8_LAS unsigned* flag = (PG8_LAS unsigned*)(lds + 8192 + 2048);
#pragma unroll
        for (int ai = 0; ai < 2; ++ai)
#pragma unroll
            for (int m = 0; m < 4; ++m) {
                float s = 0.f;
#pragma unroll
                for (int bj = 0; bj < 2; ++bj)
#pragma unroll
                    for (int n = 0; n < 2; ++n) { const f32x4 x = v[ai][bj][m][n]; s += (x[0] + x[1]) + (x[2] + x[3]); }
                s += __shfl_xor(s, 16); s += __shfl_xor(s, 32);
                const float mw = s * (1.0f / 64.0f); float q = 0.f;
#pragma unroll
                for (int bj = 0; bj < 2; ++bj)
#pragma unroll
                    for (int n = 0; n < 2; ++n) { const f32x4 d = v[ai][bj][m][n] - mw; q += (d[0] * d[0] + d[1] * d[1]) + (d[2] * d[2] + d[3] * d[3]); }
                q += __shfl_xor(q, 16); q += __shfl_xor(q, 32);
                if (fq == 0) P[(ai * HALF + wr * 64 + m * 16 + fr) * 4 + wc] = (f32x2v){mw, q};
            }
        asm volatile("s_waitcnt lgkmcnt(0)" ::: "memory"); __builtin_amdgcn_s_barrier(); asm volatile("" ::: "memory");
#if defined(BROKEN_NO_WAIT)
        if (blockIdx.x >= 64) { const long long t0 = clock64(); while (clock64() - t0 < 60000) __builtin_amdgcn_s_sleep(8); }
#endif
        const int row = wid * 32 + (lane & 31);
        if (lane < 32) {
            const f32x2v a = P[row * 4 + 0], b = P[row * 4 + 1], c = P[row * 4 + 2], d = P[row * 4 + 3];
            const float mt = (a.x + b.x + c.x + d.x) * 0.25f;
            const float da = a.x - mt, db = b.x - mt, dc = c.x - mt, dd = d.x - mt;
            const float m2 = (a.y + b.y) + (c.y + d.y) + 64.0f * ((da * da + db * db) + (dc * dc + dd * dd));
            unsigned long long* slot = (unsigned long long*)xbuf + ((size_t)(u.pm * BM + row) * 4 + u.pn);
            __hip_atomic_store(slot, ((unsigned long long)__float_as_uint(m2) << 32) | __float_as_uint(mt), __ATOMIC_RELAXED, __HIP_MEMORY_SCOPE_AGENT);
        }
        asm volatile("s_waitcnt vmcnt(0)" ::: "memory");
        if (lane == 0) __hip_atomic_fetch_add(cnt + 64 * u.pm, 1u, __ATOMIC_RELAXED, __HIP_MEMORY_SCOPE_AGENT);
        if (wid == 0) {
            bool dead = false; const unsigned long long t0 = __builtin_amdgcn_s_memrealtime(); const unsigned want = 8u * (unsigned)ntn;
            for (;;) {
#if defined(BROKEN_NO_WAIT)
                break;
#endif
                if ((unsigned)__builtin_amdgcn_readfirstlane(__hip_atomic_load(cnt + 64 * u.pm, __ATOMIC_RELAXED, __HIP_MEMORY_SCOPE_AGENT)) >= want) break;
                if (__builtin_amdgcn_s_memrealtime() - t0 > 2000000ull) {
                    if (lane == 0) { unsigned expect = 0u; __hip_atomic_compare_exchange_strong(tmo + 1, &expect, code | (unsigned)(u.pm & 0xff), __ATOMIC_RELAXED, __ATOMIC_RELAXED, __HIP_MEMORY_SCOPE_AGENT);
                                     __hip_atomic_store(tmo, 1u, __ATOMIC_RELAXED, __HIP_MEMORY_SCOPE_AGENT); }
                    dead = true; break; }
                __builtin_amdgcn_s_sleep(2);
            }
            __builtin_amdgcn_fence(__ATOMIC_ACQUIRE, "agent");
            if (lane == 0) flag[0] = dead ? 1u : 0u;
        }
        asm volatile("s_waitcnt vmcnt(0) lgkmcnt(0)" ::: "memory"); __builtin_amdgcn_s_barrier(); asm volatile("" ::: "memory");
        const bool bad = flag[0] != 0u;
        if (lane < 32) {
            const unsigned long long* slot = (const unsigned long long*)xbuf + (size_t)(u.pm * BM + row) * 4; float mt[4], m2[4]; float ms = 0.f;
#pragma unroll
            for (int t = 0; t < 4; ++t) { if (t < ntn) { const unsigned long long w = __hip_atomic_load(slot + t, __ATOMIC_RELAXED, __HIP_MEMORY_SCOPE_AGENT); mt[t] = __uint_as_float((unsigned)w); m2[t] = __uint_as_float((unsigned)(w >> 32)); } else { mt[t] = 0.f; m2[t] = 0.f; } ms += mt[t]; }
            const float mean = ms / (float)ntn; float q = 0.f;
#pragma unroll
            for (int t = 0; t < 4; ++t) if (t < ntn) { const float dm = mt[t] - mean; q += m2[t] + 256.0f * dm * dm; }
            S[row] = (f32x2v){mean, 1.0f / sqrtf(q / (256.0f * (float)ntn) + eps)};
        }
        asm volatile("s_waitcnt lgkmcnt(0)" ::: "memory"); __builtin_amdgcn_s_barrier(); asm volatile("" ::: "memory");
        return bad;
    }
};
struct EpiLnRes {
    static constexpr bool PERM = false, AFTER_DRAIN = true;
    const float* base; float* out; int ldc; const float* bias; PanelStats st; unsigned poison;
    __device__ __forceinline__ void refuse(size_t i0, size_t stride, int M, int N) const { const float q = __builtin_nanf(""); for (size_t i = i0; i < (size_t)M * N; i += stride) out[(i / N) * ldc + i % N] = q;
        if (i0 == 0) { unsigned expect = 0u; __hip_atomic_compare_exchange_strong(st.tmo + 1, &expect, 0x7f0u, __ATOMIC_RELAXED, __ATOMIC_RELAXED, __HIP_MEMORY_SCOPE_AGENT); __hip_atomic_store(st.tmo, 1u, __ATOMIC_RELAXED, __HIP_MEMORY_SCOPE_AGENT); } }
    __device__ __forceinline__ void fused(f32x4 (&acc)[2][2][4][2], const Unit& u, int wr, int wc, int fr, int fq, PG8_LAS unsigned char* lds, int wid, int lane) const {
        typedef float f32x2v __attribute__((ext_vector_type(2)));
        const PG8_LAS f32x2v* S = (const PG8_LAS f32x2v*)(lds + 8192);
        const int col0 = u.pn * BM + wc * 32 + 4 * fq;
#pragma unroll
        for (int bj = 0; bj < 2; ++bj)
#pragma unroll
            for (int n = 0; n < 2; ++n) { const f32x4 bv = bias ? *(const f32x4*)(bias + col0 + bj * HALF + n * 16) : (f32x4){0.f, 0.f, 0.f, 0.f};
#pragma unroll
                for (int ai = 0; ai < 2; ++ai)
#pragma unroll
                    for (int m = 0; m < 4; ++m) acc[ai][bj][m][n] += bv; }
        const bool bad = st.run(acc, u, wr, wc, fr, fq, lds, wid, lane) || poison != 0u;
        const float qnan = __builtin_nanf("");
#pragma unroll
        for (int ai = 0; ai < 2; ++ai)
#pragma unroll
            for (int m = 0; m < 4; ++m) { const int r = ai * HALF + wr * 64 + m * 16 + fr; const f32x2v sr = S[r]; const size_t off = (size_t)(u.pm * BM + r) * ldc + col0;
#pragma unroll
                for (int bj = 0; bj < 2; ++bj)
#pragma unroll
                    for (int n = 0; n < 2; ++n) { const f32x4 bs = *(const f32x4*)(base + off + bj * HALF + n * 16); f32x4 o = bs + (acc[ai][bj][m][n] - sr.x) * sr.y;
                        if (bad) o = (f32x4){qnan, qnan, qnan, qnan}; *(f32x4*)(out + off + bj * HALF + n * 16) = o; }
                asm volatile("" ::: "memory"); }
    }
};
struct EpiLnResLn {
    static constexpr bool PERM = false, AFTER_DRAIN = true;
    const float* base; float* out; bf16_t* xn; int ldc; const float* bias; PanelStats st1, st2; unsigned poison;
    __device__ __forceinline__ void refuse(size_t i0, size_t stride, int M, int N) const { const float q = __builtin_nanf(""); for (size_t i = i0; i < (size_t)M * N; i += stride) { const size_t o = (i / N) * ldc + i % N; out[o] = q; xn[o] = (bf16_t)0x7fc0u; }
        if (i0 == 0) { unsigned expect = 0u; __hip_atomic_compare_exchange_strong(st1.tmo + 1, &expect, 0x7f0u, __ATOMIC_RELAXED, __ATOMIC_RELAXED, __HIP_MEMORY_SCOPE_AGENT); __hip_atomic_store(st1.tmo, 1u, __ATOMIC_RELAXED, __HIP_MEMORY_SCOPE_AGENT); } }
    __device__ __forceinline__ void fused(f32x4 (&acc)[2][2][4][2], const Unit& u, int wr, int wc, int fr, int fq, PG8_LAS unsigned char* lds, int wid, int lane) const {
        typedef float f32x2v __attribute__((ext_vector_type(2))); typedef unsigned u32x2v __attribute__((ext_vector_type(2)));
        const PG8_LAS f32x2v* S = (const PG8_LAS f32x2v*)(lds + 8192);
        const int col0 = u.pn * BM + wc * 32 + 4 * fq;
#pragma unroll
        for (int bj = 0; bj < 2; ++bj)
#pragma unroll
            for (int n = 0; n < 2; ++n) { const f32x4 bv = bias ? *(const f32x4*)(bias + col0 + bj * HALF + n * 16) : (f32x4){0.f, 0.f, 0.f, 0.f};
#pragma unroll
                for (int ai = 0; ai < 2; ++ai)
#pragma unroll
                    for (int m = 0; m < 4; ++m) acc[ai][bj][m][n] += bv; }
        bool bad = st1.run(acc, u, wr, wc, fr, fq, lds, wid, lane) || poison != 0u;
        const float qnan = __builtin_nanf("");
#pragma unroll
        for (int ai = 0; ai < 2; ++ai)
#pragma unroll
            for (int m = 0; m < 4; ++m) { const int r = ai * HALF + wr * 64 + m * 16 + fr; const f32x2v sr = S[r]; const size_t off = (size_t)(u.pm * BM + r) * ldc + col0;
#pragma unroll
                for (int bj = 0; bj < 2; ++bj)
#pragma unroll
                    for (int n = 0; n < 2; ++n) { const f32x4 bs = *(const f32x4*)(base + off + bj * HALF + n * 16); acc[ai][bj][m][n] = bs + (acc[ai][bj][m][n] - sr.x) * sr.y; }
                asm volatile("" : "+v"(acc[ai][0][m][0]), "+v"(acc[ai][0][m][1]), "+v"(acc[ai][1][m][0]), "+v"(acc[ai][1][m][1]));
                if (m & 1) asm volatile("" ::: "memory"); }
        const bool bad1 = bad;
        bad = st2.run(acc, u, wr, wc, fr, fq, lds, wid, lane) || bad;
#pragma unroll
        for (int ai = 0; ai < 2; ++ai)
#pragma unroll
            for (int m = 0; m < 4; ++m) { const int r = ai * HALF + wr * 64 + m * 16 + fr; const f32x2v sr = S[r]; const size_t off = (size_t)(u.pm * BM + r) * ldc + col0;
#pragma unroll
                for (int bj = 0; bj < 2; ++bj)
#pragma unroll
                    for (int n = 0; n < 2; ++n) { const f32x4 x1 = acc[ai][bj][m][n]; *(f32x4*)(out + off + bj * HALF + n * 16) = bad1 ? (f32x4){qnan, qnan, qnan, qnan} : x1;
                        const f32x4 o = (x1 - sr.x) * sr.y; u32x2v w; w.x = cvt_pk_bf16(o[0], o[1]); w.y = cvt_pk_bf16(o[2], o[3]);
                        if (bad) { w.x = 0x7fc07fc0u; w.y = 0x7fc07fc0u; } *(u32x2v*)(xn + off + bj * HALF + n * 16) = w; }
                asm volatile("" ::: "memory"); }
    }
};

template <class Epi, class Sched, bool STAMP = false>
__device__ __forceinline__ void gemm_phase(PG8_LAS unsigned char* lds, const Gemm g, const Sched& S, const Epi& E, unsigned long long* stamps) {
    const int tid = threadIdx.x, wid = __builtin_amdgcn_readfirstlane(tid >> 6), lane = tid & 63, wr = wid >> 2, wc = wid & 3, fr = lane & 15, fq = lane >> 4;
    const int K = g.K, nt = K / BK;
    int ts_lo = 0, ts_hi = 0, nts = 0; const unsigned long long rt_entry = STAMP ? (unsigned long long)wall_clock64() : 0ull;
#define PG8_STAMP() do { if (STAMP && wid == 0 && nts < 64) { const unsigned long long _c = (unsigned long long)clock64(); \
        ts_lo = (lane == nts) ? (int)(unsigned)_c : ts_lo; ts_hi = (lane == nts) ? (int)(unsigned)(_c >> 32) : ts_hi; ++nts; } } while (0)
    PG8_STAMP();
    unsigned voffA[2], voffB[2];
#pragma unroll
    for (int i = 0; i < 2; ++i) { int R, C; stage_rc(tid * 16 + i * 8192, R, C); const int Rb = Epi::PERM ? ((R & ~31) + perm32(R & 31)) : R;
        voffA[i] = (unsigned)(R * K + C) * 2u; voffB[i] = (unsigned)(Rb * K + C) * 2u; }
    const size_t kstep = (size_t)(BK * 2);
    const size_t hstep = (size_t)HALF * K * 2;
    const size_t tstep = 2 * hstep;
    const unsigned ldsw = (unsigned)wid * 1024u;
    const int aoff = lds_byte(wr * 64 + fr, fq * 8), boff = lds_byte(wc * 32 + fr, fq * 8);
#define PG8_SA(b, h) (((b) * 2 + (h)) * HTB)
#define PG8_SB(b, h) ((4 + (b) * 2 + (h)) * HTB)
#define PG8_STAGE(bufoff, gbase, voff) do { _Pragma("unroll") for (int _i = 0; _i < 2; ++_i) \
        __builtin_amdgcn_global_load_lds((const unsigned*)((const char*)(gbase) + (voff)[_i]), (PG8_LAS unsigned*)(lds + (bufoff) + ldsw + _i * 8192), 16, 0, 0); } while (0)
#define PG8_LDA(dst, b, h) do { _Pragma("unroll") for (int m = 0; m < 4; ++m) _Pragma("unroll") for (int k = 0; k < 2; ++k) dst[m][k] = *(const PG8_LAS bf16x8*)(lds + PG8_SA(b, h) + aoff + m * 2048 + k * 1024); } while (0)
#define PG8_LDB(dst, b, h) do { _Pragma("unroll") for (int n = 0; n < 2; ++n) _Pragma("unroll") for (int k = 0; k < 2; ++k) dst[n][k] = *(const PG8_LAS bf16x8*)(lds + PG8_SB(b, h) + boff + n * 2048 + k * 1024); } while (0)
#define PG8_MMA(ai, bj, At, Bt) do { __builtin_amdgcn_s_setprio(1); _Pragma("unroll") for (int m = 0; m < 4; ++m) _Pragma("unroll") for (int n = 0; n < 2; ++n) _Pragma("unroll") for (int k = 0; k < 2; ++k) \
        acc[ai][bj][m][n] = __builtin_amdgcn_mfma_f32_16x16x32_bf16(Bt[n][k], At[m][k], acc[ai][bj][m][n], 0, 0, 0); __builtin_amdgcn_s_setprio(0); } while (0)
#define PG8_WAIT_V(n) asm volatile("s_waitcnt vmcnt(" #n ")" ::: "memory")
#define PG8_WAIT_L(n) asm volatile("s_waitcnt lgkmcnt(" #n ")" ::: "memory")
#define PG8_BAR __builtin_amdgcn_s_barrier()
#define PG8_SCHED __builtin_amdgcn_sched_barrier(0)
    Unit cur, nxt; int ui = 0;
    if (!S.next(0, cur)) return;
    f32x4 acc[2][2][4][2];
#pragma unroll
    for (int a = 0; a < 2; ++a)
#pragma unroll
        for (int b = 0; b < 2; ++b)
#pragma unroll
            for (int m = 0; m < 4; ++m)
#pragma unroll
                for (int n = 0; n < 2; ++n) acc[a][b][m][n] = (f32x4){0.f, 0.f, 0.f, 0.f};
    bf16x8 At[4][2], B0[2][2], B1[2][2];
    const char* cA = (const char*)g.A + (size_t)cur.pm * tstep; const char* cB = (const char*)g.Bt + (size_t)cur.pn * tstep;
    S.a_ready(cur);
    PG8_STAGE(PG8_SB(0, 0), cB, voffB); PG8_STAGE(PG8_SA(0, 0), cA, voffA); PG8_STAGE(PG8_SB(0, 1), cB + hstep, voffB); PG8_STAGE(PG8_SA(0, 1), cA + hstep, voffA);
    if (wr == 1) PG8_BAR;
    PG8_WAIT_V(4); PG8_BAR;
    PG8_STAGE(PG8_SB(1, 0), cB + kstep, voffB); PG8_STAGE(PG8_SA(1, 0), cA + kstep, voffA); PG8_STAGE(PG8_SB(1, 1), cB + hstep + kstep, voffB);
    PG8_WAIT_V(6); PG8_BAR;
    PG8_STAMP();
    for (;;) {
        const bool has_next = S.next(ui + 1, nxt);
        const char* nA = has_next ? (const char*)g.A + (size_t)nxt.pm * tstep : cA; const char* nB = has_next ? (const char*)g.Bt + (size_t)nxt.pn * tstep : cB;
        for (int t = 0; t < nt; t += 2) {
            const bool last = (t == nt - 2);
            const char* a1 = cA + (size_t)(t + 1) * kstep;
            const char* a2 = last ? nA : cA + (size_t)(t + 2) * kstep; const char* b2 = last ? nB : cB + (size_t)(t + 2) * kstep;
            const char* a3 = a2 + kstep; const char* b3 = b2 + kstep;
            if (last && has_next) S.a_ready(nxt);
            PG8_LDB(B0, 0, 0); PG8_SCHED; PG8_LDA(At, 0, 0); PG8_STAGE(PG8_SA(1, 1), a1 + hstep, voffA);
            PG8_WAIT_L(8); PG8_BAR; PG8_WAIT_L(0); PG8_MMA(0, 0, At, B0); PG8_BAR; PG8_SCHED;
            PG8_LDB(B1, 0, 1); PG8_STAGE(PG8_SB(0, 0), b2, voffB);
            PG8_BAR; PG8_WAIT_L(0); PG8_MMA(0, 1, At, B1); PG8_BAR;
            PG8_LDA(At, 0, 1); PG8_STAGE(PG8_SA(0, 0), a2, voffA);
            PG8_BAR; PG8_WAIT_L(0); PG8_MMA(1, 0, At, B0); PG8_BAR; PG8_SCHED;
            PG8_STAGE(PG8_SB(0, 1), b2 + hstep, voffB);
            PG8_WAIT_V(6); PG8_BAR; PG8_MMA(1, 1, At, B1); PG8_BAR;
            PG8_LDB(B0, 1, 0); PG8_SCHED; PG8_LDA(At, 1, 0); PG8_STAGE(PG8_SA(0, 1), a2 + hstep, voffA);
            PG8_WAIT_L(8); PG8_BAR; PG8_WAIT_L(0); PG8_MMA(0, 0, At, B0); PG8_BAR; PG8_SCHED;
            PG8_LDB(B1, 1, 1); PG8_STAGE(PG8_SB(1, 0), b3, voffB);
            PG8_BAR; PG8_WAIT_L(0); PG8_MMA(0, 1, At, B1); PG8_BAR;
            PG8_LDA(At, 1, 1); PG8_STAGE(PG8_SA(1, 0), a3, voffA);
            PG8_BAR; PG8_WAIT_L(0); PG8_MMA(1, 0, At, B0); PG8_BAR; PG8_SCHED;
            PG8_STAGE(PG8_SB(1, 1), b3 + hstep, voffB);
            PG8_WAIT_V(6); PG8_BAR; PG8_MMA(1, 1, At, B1); PG8_BAR;
        }
        PG8_STAMP();
        if constexpr (!Epi::AFTER_DRAIN) { E(acc, cur, wr, wc, fr, fq); S.done(cur); }
        PG8_STAMP();
        if (!has_next) break;
#pragma unroll
        for (int a = 0; a < 2; ++a)
#pragma unroll
            for (int b = 0; b < 2; ++b)
#pragma unroll
                for (int m = 0; m < 4; ++m)
#pragma unroll
                    for (int n = 0; n < 2; ++n) acc[a][b][m][n] = (f32x4){0.f, 0.f, 0.f, 0.f};
        cur = nxt; cA = nA; cB = nB; ++ui;
    }
    PG8_WAIT_V(0);
    if (wr == 0) PG8_BAR;
    PG8_BAR;
    if constexpr (Epi::AFTER_DRAIN) { E.fused(acc, cur, wr, wc, fr, fq, lds, wid, lane); S.done(cur); }
    PG8_STAMP();
    if (STAMP && wid == 0) { stamps[lane] = lane < nts ? (((unsigned long long)(unsigned)ts_hi << 32) | (unsigned)ts_lo) : 0ull;
        if (lane == 62) stamps[62] = rt_entry; if (lane == 63) stamps[63] = (unsigned long long)wall_clock64(); }
#undef PG8_STAMP
#undef PG8_SA
#undef PG8_SB
#undef PG8_STAGE
#undef PG8_LDA
#undef PG8_LDB
#undef PG8_MMA
#undef PG8_WAIT_V
#undef PG8_WAIT_L
#undef PG8_BAR
#undef PG8_SCHED
}
}
#define HD __host__ __device__ __forceinline__
#define HY_LDS __attribute__((address_space(3)))
#ifndef HY_F2_STRUCT
typedef float f2 __attribute__((ext_vector_type(2)));
#else
struct __attribute__((aligned(8))) f2 { float x, y; };
#ifndef HD
#define HD __host__ __device__ __forceinline__
#endif
HD f2 operator+(f2 a, f2 b) { return f2{a.x + b.x, a.y + b.y}; }
HD f2 operator-(f2 a, f2 b) { return f2{a.x - b.x, a.y - b.y}; }
HD f2 operator*(f2 a, float b) { return f2{a.x * b, a.y * b}; }
#endif
#ifndef HD
#define HD __host__ __device__ __forceinline__
#endif
#ifndef HY_LDS
#define HY_LDS
#endif
typedef HY_LDS f2* hy_ldsp;
typedef const HY_LDS f2* hy_cldsp;
#if defined(__HIP_DEVICE_COMPILE__)
#define HY_OPAQUE(v) asm volatile("" : "+v"(v))
#else
#define HY_OPAQUE(v) asm volatile("" : "+r"(v))
#endif
namespace hy {
constexpr int FL = 16384;
constexpr int LDS_F2 = 32 * 560;
HD int laddr(int d2, int d1, int d0) { return d2 * 560 + d1 * 17 + d0; }
HD f2 cmul(f2 a, f2 b) { return (f2){a.x * b.x - a.y * b.y, a.x * b.y + a.y * b.x}; }
HD f2 cconj(f2 a) { return (f2){a.x, -a.y}; }
constexpr float C32[32] = { 1.0f, 0.98078528040323044913f, 0.92387953251128675613f, 0.83146961230254523708f, 0.70710678118654752440f, 0.55557023301960222474f, 0.38268343236508977173f, 0.19509032201612826785f,
                            0.0f, -0.19509032201612826785f, -0.38268343236508977173f, -0.55557023301960222474f, -0.70710678118654752440f, -0.83146961230254523708f, -0.92387953251128675613f, -0.98078528040323044913f,
                           -1.0f, -0.98078528040323044913f, -0.92387953251128675613f, -0.83146961230254523708f, -0.70710678118654752440f, -0.55557023301960222474f, -0.38268343236508977173f, -0.19509032201612826785f,
                            0.0f, 0.19509032201612826785f, 0.38268343236508977173f, 0.55557023301960222474f, 0.70710678118654752440f, 0.83146961230254523708f, 0.92387953251128675613f, 0.98078528040323044913f };
constexpr float S32[32] = { 0.0f, 0.19509032201612826785f, 0.38268343236508977173f, 0.55557023301960222474f, 0.70710678118654752440f, 0.83146961230254523708f, 0.92387953251128675613f, 0.98078528040323044913f,
                            1.0f, 0.98078528040323044913f, 0.92387953251128675613f, 0.83146961230254523708f, 0.70710678118654752440f, 0.55557023301960222474f, 0.38268343236508977173f, 0.19509032201612826785f,
                            0.0f, -0.19509032201612826785f, -0.38268343236508977173f, -0.55557023301960222474f, -0.70710678118654752440f, -0.83146961230254523708f, -0.92387953251128675613f, -0.98078528040323044913f,
                           -1.0f, -0.98078528040323044913f, -0.92387953251128675613f, -0.83146961230254523708f, -0.70710678118654752440f, -0.55557023301960222474f, -0.38268343236508977173f, -0.19509032201612826785f };
template <int BITS> HD constexpr int brev(int k) { int r = 0; for (int i = 0; i < BITS; ++i) r |= ((k >> i) & 1) << (BITS - 1 - i); return r; }
template <bool INV> HD f2 twmul32(f2 d, int k) {
    k &= 31;
    if (k == 0) return d;
    if (k == 8) return INV ? (f2){-d.y, d.x} : (f2){d.y, -d.x};
    if (k == 16) return (f2){-d.x, -d.y};
    if (k == 24) return INV ? (f2){d.y, -d.x} : (f2){-d.y, d.x};
    const float c = C32[k], s = INV ? S32[k] : -S32[k];
    return (f2){d.x * c - d.y * s, d.x * s + d.y * c};
}
template <int N, int SPAN, bool INV> struct DifStage {
    static HD void run(f2 (&v)[N]) {
#pragma unroll
        for (int blk = 0; blk < N; blk += 2 * SPAN)
#pragma unroll
            for (int j = 0; j < SPAN; ++j) {
                const f2 a = v[blk + j], b = v[blk + j + SPAN];
                v[blk + j] = a + b;
                v[blk + j + SPAN] = twmul32<INV>(a - b, j * (16 / SPAN));
            }
        DifStage<N, SPAN / 2, INV>::run(v);
    }
};
template <int N, bool INV> struct DifStage<N, 0, INV> { static HD void run(f2 (&)[N]) {} };
template <int N, bool INV> HD void dft_inreg(f2 (&v)[N]) { DifStage<N, N / 2, INV>::run(v); }

HD f2 cis_rev(float rev) {
#if defined(__HIP_DEVICE_COMPILE__)
    return (f2){__builtin_amdgcn_cosf(rev), __builtin_amdgcn_sinf(rev)};
#else
    return (f2){(float)cos(6.283185307179586476925 * (double)rev), (float)sin(6.283185307179586476925 * (double)rev)};
#endif
}
#define HY_CHAIN_DECL(b0, s) f2 _c0 = (b0), _c1 = hy::cmul(_c0, (s)), _s2 = hy::cmul((s), (s)), _c2 = hy::cmul(_c0, _s2), _c3 = hy::cmul(_c1, _s2), _s4 = hy::cmul(_s2, _s2)

template <bool INV_UNUSED = false> HD void fwd_p1(f2 (&x)[32], int t, hy_ldsp lds) {
    HY_OPAQUE(t);
    dft_inreg<32, false>(x);
    const f2 w1 = cis_rev(-(float)t * (1.0f / 16384.0f));
    HY_CHAIN_DECL(((f2){1.0f, 0.0f}), w1);
    const int base = laddr(0, t >> 4, t & 15);
#pragma unroll
    for (int q = 0; q < 8; ++q) {
        lds[base + (4 * q + 0) * 560] = cmul(x[brev<5>(4 * q + 0)], _c0);
        lds[base + (4 * q + 1) * 560] = cmul(x[brev<5>(4 * q + 1)], _c1);
        lds[base + (4 * q + 2) * 560] = cmul(x[brev<5>(4 * q + 2)], _c2);
        lds[base + (4 * q + 3) * 560] = cmul(x[brev<5>(4 * q + 3)], _c3);
        _c0 = cmul(_c0, _s4); _c1 = cmul(_c1, _s4); _c2 = cmul(_c2, _s4); _c3 = cmul(_c3, _s4);
    }
}
HD void fwd_p2(int t, hy_ldsp lds) {
    HY_OPAQUE(t);
    f2 x[32];
    const int d2 = t >> 4, d0 = t & 15, base = laddr(d2, 0, d0);
#pragma unroll
    for (int j = 0; j < 32; ++j) x[j] = lds[base + j * 17];
    dft_inreg<32, false>(x);
    const f2 w1 = cis_rev(-(float)d0 * (1.0f / 512.0f));
    HY_CHAIN_DECL(((f2){1.0f, 0.0f}), w1);
#pragma unroll
    for (int q = 0; q < 8; ++q) {
        lds[base + (4 * q + 0) * 17] = cmul(x[brev<5>(4 * q + 0)], _c0);
        lds[base + (4 * q + 1) * 17] = cmul(x[brev<5>(4 * q + 1)], _c1);
        lds[base + (4 * q + 2) * 17] = cmul(x[brev<5>(4 * q + 2)], _c2);
        lds[base + (4 * q + 3) * 17] = cmul(x[brev<5>(4 * q + 3)], _c3);
        _c0 = cmul(_c0, _s4); _c1 = cmul(_c1, _s4); _c2 = cmul(_c2, _s4); _c3 = cmul(_c3, _s4);
    }
}
HD void fwd_p3(f2 (&s)[2][16], int t, hy_cldsp lds) {
#pragma unroll
    for (int h = 0; h < 2; ++h) {
        const int R = t + 512 * h, base = laddr(R >> 5, R & 31, 0);
#pragma unroll
        for (int j = 0; j < 16; ++j) s[h][j] = lds[base + j];
        dft_inreg<16, false>(s[h]);
    }
}
HD void inv_p1(f2 (&s)[2][16], int t, hy_ldsp lds) {
    HY_OPAQUE(t);
#pragma unroll
    for (int h = 0; h < 2; ++h) {
        const int R = t + 512 * h, d1 = R & 31, base = laddr(R >> 5, d1, 0);
        f2 y[16];
#pragma unroll
        for (int k = 0; k < 16; ++k) y[k] = s[h][brev<4>(k)];
        dft_inreg<16, true>(y);
        const f2 w1 = cis_rev((float)d1 * (1.0f / 512.0f));
        HY_CHAIN_DECL(((f2){1.0f, 0.0f}), w1);
#pragma unroll
        for (int q = 0; q < 4; ++q) {
            lds[base + 4 * q + 0] = cmul(y[brev<4>(4 * q + 0)], _c0);
            lds[base + 4 * q + 1] = cmul(y[brev<4>(4 * q + 1)], _c1);
            lds[base + 4 * q + 2] = cmul(y[brev<4>(4 * q + 2)], _c2);
            lds[base + 4 * q + 3] = cmul(y[brev<4>(4 * q + 3)], _c3);
            _c0 = cmul(_c0, _s4); _c1 = cmul(_c1, _s4); _c2 = cmul(_c2, _s4); _c3 = cmul(_c3, _s4);
        }
    }
}
HD void inv_p2(int t, hy_ldsp lds) {
    HY_OPAQUE(t);
    f2 x[32];
    const int d2 = t >> 4, d0 = t & 15, base = laddr(d2, 0, d0);
#pragma unroll
    for (int j = 0; j < 32; ++j) x[j] = lds[base + j * 17];
    dft_inreg<32, true>(x);
    const f2 b0 = cis_rev((float)(d0 * d2) * (1.0f / 16384.0f)), st = cis_rev((float)d2 * (1.0f / 1024.0f));
    HY_CHAIN_DECL(b0, st);
#pragma unroll
    for (int q = 0; q < 8; ++q) {
        lds[base + (4 * q + 0) * 17] = cmul(x[brev<5>(4 * q + 0)], _c0);
        lds[base + (4 * q + 1) * 17] = cmul(x[brev<5>(4 * q + 1)], _c1);
        lds[base + (4 * q + 2) * 17] = cmul(x[brev<5>(4 * q + 2)], _c2);
        lds[base + (4 * q + 3) * 17] = cmul(x[brev<5>(4 * q + 3)], _c3);
        _c0 = cmul(_c0, _s4); _c1 = cmul(_c1, _s4); _c2 = cmul(_c2, _s4); _c3 = cmul(_c3, _s4);
    }
}
HD void inv_p3(f2 (&x)[32], int t, hy_cldsp lds) {
    f2 y[32];
    const int base = laddr(0, t >> 4, t & 15);
#pragma unroll
    for (int j = 0; j < 32; ++j) y[j] = lds[base + j * 560];
    dft_inreg<32, true>(y);
#pragma unroll
    for (int j = 0; j < 32; ++j) x[j] = y[brev<5>(j)];
}
}
#define HY_FENCE() asm volatile("" ::: "memory")
namespace hy {
typedef unsigned short bf16_t;
HD float bf2f(bf16_t v) { return __builtin_bit_cast(float, ((unsigned)v) << 16); }
HD bf16_t f2bf(float f) { unsigned u = __builtin_bit_cast(unsigned, f); return (bf16_t)((u + 0x7fffu + ((u >> 16) & 1u)) >> 16); }
constexpr int SEQ = 16384, NTOK = 2 * SEQ;
struct JobArgs {
    const bf16_t* ch;
    const bf16_t* kt;
    const float* conv_w;
    const float* conv_b;
    const float* hbias;
    f2* sbase;
    bf16_t* yh;
};
#if defined(__HIP_DEVICE_COMPILE__)
typedef unsigned hy_u2 __attribute__((ext_vector_type(2)));
struct Stash { __amdgpu_buffer_rsrc_t r; };
__device__ __forceinline__ Stash make_stash(const JobArgs& J) { Stash s; s.r = __builtin_amdgcn_make_buffer_rsrc(J.sbase, (short)0, 393216, 0x00020000); return s; }
__device__ __forceinline__ f2 st_load(const Stash& s, int r, int j, int t) { const hy_u2 v = __builtin_amdgcn_raw_buffer_load_b64(s.r, t * 8, r * 131072 + j * 4096, 0); return __builtin_bit_cast(f2, v); }
__device__ __forceinline__ void st_store(const Stash& s, int r, int j, int t, f2 v) { __builtin_amdgcn_raw_buffer_store_b64(__builtin_bit_cast(hy_u2, v), s.r, t * 8, r * 131072 + j * 4096, 0); }
#else
struct Stash { f2* p; };
inline Stash make_stash(const JobArgs& J) { return Stash{J.sbase}; }
inline f2 st_load(const Stash& s, int r, int j, int t) { return s.p[r * 16384 + j * 512 + t]; }
inline void st_store(const Stash& s, int r, int j, int t, f2 v) { s.p[r * 16384 + j * 512 + t] = v; }
#endif
HD void twist_consts(bool tw, int t, f2& base, f2& step) {
    HY_OPAQUE(t);
    if (tw) { base = cis_rev(-(float)t * (1.0f / 32768.0f)); step = (f2){0.99518472667219688624f, -0.09801714032956060199f}; }
    else { base = (f2){1.0f, 0.0f}; step = (f2){1.0f, 0.0f}; }
}
template <bool FIRST, bool LAST> HD float sconv(const bf16_t* pj, int t, float w0, float w1, float w2, float cb) {
    const float pm = (!FIRST || t > 0) ? bf2f(pj[t - 1]) : 0.0f, pc = bf2f(pj[t]), pp = (!LAST || t < 511) ? bf2f(pj[t + 1]) : 0.0f;
    return cb + w0 * pm + w1 * pc + w2 * pp;
}
#define HY_SCONV(j, p, t, w0, w1, w2, cb) ((j) == 0 ? hy::sconv<true, false>((p) + (j) * 512, t, w0, w1, w2, cb) : (j) == 31 ? hy::sconv<false, true>((p) + (j) * 512, t, w0, w1, w2, cb) : hy::sconv<false, false>((p) + (j) * 512, t, w0, w1, w2, cb))
HD void seg_filter_p1(const JobArgs& J, int c, int o, bool tw, int t, hy_ldsp lds) {
    HY_OPAQUE(t); HY_OPAQUE(c);
    f2 x[32];
    const bf16_t* kf = J.kt + (size_t)((o * 2 + 0) * 512 + c) * SEQ;
    const bf16_t* kr = J.kt + (size_t)((o * 2 + 1) * 512 + c) * SEQ;
    const float sgn = tw ? -1.0f : 1.0f, bias = J.hbias[o * 512 + c];
    f2 base, step; twist_consts(tw, t, base, step);
    f2 cur = base;
#pragma unroll
    for (int j = 0; j < 32; ++j) {
        const int n = j * 512 + t;
        float a = bf2f(kf[n]) + sgn * bf2f(kr[SEQ - 1 - n]);
        if (n == 0) a += bias;
        a *= (1.0f / 32768.0f);
        x[j] = cur * a;
        cur = cmul(cur, step);
        if ((j & 7) == 7) HY_FENCE();
    }
    fwd_p1(x, t, lds);
}
HD void seg_prep(const JobArgs& J, const Stash& S, int c, int t) {
    HY_OPAQUE(t); HY_OPAQUE(c);
    const bf16_t* p0 = J.ch + (size_t)c * NTOK; const bf16_t* p1 = p0 + SEQ;
    const float w0 = J.conv_w[c], w1 = J.conv_w[1536 + c], w2 = J.conv_w[3072 + c], cb = J.conv_b[c];
#pragma unroll
    for (int j = 0; j < 32; ++j) {
        st_store(S, 1, j, t, (f2){HY_SCONV(j, p0, t, w0, w1, w2, cb), HY_SCONV(j, p1, t, w0, w1, w2, cb)});
        if ((j & 3) == 3) HY_FENCE();
    }
}
HD void seg_data_p1(const Stash& S, bool tw, int t, hy_ldsp lds) {
    HY_OPAQUE(t);
    f2 x[32];
    f2 base, step; twist_consts(tw, t, base, step);
    f2 cur = base;
#pragma unroll
    for (int j = 0; j < 32; ++j) { const f2 z = st_load(S, 1, j, t); x[j] = cmul(z, cur); cur = cmul(cur, step); if ((j & 7) == 7) HY_FENCE(); }
    fwd_p1(x, t, lds);
}
HD void seg_filter_p3(const Stash& S, int t, hy_cldsp lds) {
    f2 K[2][16];
    fwd_p3(K, t, lds);
#pragma unroll
    for (int h = 0; h < 2; ++h)
#pragma unroll
        for (int i = 0; i < 16; ++i) st_store(S, 2, h * 16 + i, t, K[h][i]);
    HY_FENCE();
}
HD void seg_mul(const Stash& S, int t, hy_ldsp lds) {
    f2 s[2][16];
    fwd_p3(s, t, lds);
#pragma unroll
    for (int h = 0; h < 2; ++h) {
#pragma unroll
        for (int i = 0; i < 16; ++i) s[h][i] = cmul(s[h][i], st_load(S, 2, h * 16 + i, t));
        HY_FENCE();
    }
    inv_p1(s, t, lds);
}
HD void seg_out(const JobArgs& J, const Stash& S, int c, int o, bool tw, int t, hy_cldsp lds) {
    HY_OPAQUE(t); HY_OPAQUE(c);
    f2 x[32];
    inv_p3(x, t, lds);
    if (!tw) {
#pragma unroll
        for (int j = 0; j < 32; ++j) st_store(S, 0, j, t, x[j]);
        HY_FENCE();
        return;
    }
    f2 base, step; twist_consts(true, t, base, step);
    f2 cur = cconj(base); const f2 stc = cconj(step);
    const int row = (o == 0 ? 512 : 1024) + c;
    const bf16_t* p0 = J.ch + (size_t)row * NTOK; const bf16_t* p1 = p0 + SEQ;
    const float w0 = J.conv_w[row], w1 = J.conv_w[1536 + row], w2 = J.conv_w[3072 + row], cb = J.conv_b[row];
    const bf16_t* g0 = J.ch + (size_t)(1536 + c) * NTOK; const bf16_t* g1 = g0 + SEQ;
#pragma unroll
    for (int j = 0; j < 32; ++j) {
        const int n = j * 512 + t;
        const f2 r = cmul(x[j], cur) + st_load(S, 0, j, t); cur = cmul(cur, stc);
        const float a0 = HY_SCONV(j, p0, t, w0, w1, w2, cb) * r.x, a1 = HY_SCONV(j, p1, t, w0, w1, w2, cb) * r.y;
        if (o == 0) st_store(S, 1, j, t, (f2){a0, a1});
        else {
            const float q0 = bf2f(g0[n]), q1 = bf2f(g1[n]);
            bf16_t* y = J.yh + (size_t)c * NTOK;
            y[n] = f2bf(a0 * q0 / (1.0f + __builtin_expf(-q0)));
            y[SEQ + n] = f2bf(a1 * q1 / (1.0f + __builtin_expf(-q1)));
        }
        if ((j & 3) == 3) HY_FENCE();
    }
}
}
#define LAS __attribute__((address_space(3)))
#define GAS __attribute__((address_space(1)))
typedef unsigned short bf16;
typedef unsigned u32x4v __attribute__((ext_vector_type(4)));
typedef float f32x4v __attribute__((ext_vector_type(4)));

#ifndef MK_N_LAUNCHES
#define MK_N_LAUNCHES 1
#endif
constexpr int N_PHASES = 7;
constexpr int NT = 512;
constexpr int DM = 1024, SEQ = 16384, NB = 2, NTOK = NB * SEQ, DINP = 3072, DH = 512;
constexpr float LN_EPS = 1e-5f, DN_ALPHA = 1.18920711500272106672f;
constexpr size_t MiB = 1u << 20;
constexpr size_t WS_CTL = 0, CTL_BYTES = 1 * MiB;
constexpr size_t WS_MOD = WS_CTL + CTL_BYTES;
constexpr size_t WS_WINT = WS_MOD + 1 * MiB;
constexpr size_t WS_WOUTT = WS_WINT + 6 * MiB;
constexpr size_t WS_PWT = WS_WOUTT + 2 * MiB;
constexpr size_t WS_FWT = WS_PWT + 1 * MiB;
constexpr size_t WS_H3 = WS_FWT + 1 * MiB;
constexpr size_t WS_U = WS_H3 + 8 * MiB;
constexpr size_t WS_KT = WS_U + 64 * MiB;
constexpr size_t WS_CH = WS_KT + 64 * MiB;
constexpr size_t WS_TP = WS_CH + 128 * MiB;
constexpr size_t WS_PP = WS_TP + 64 * MiB;
constexpr size_t WS_YH = WS_PP + 32 * MiB;
constexpr size_t WS_ST = WS_YH + 32 * MiB;
constexpr size_t WS_END = WS_ST + 96 * MiB;
constexpr size_t WS_Y = WS_U;
constexpr int LDS_MISC = 143360;
constexpr int LDS_BYTES = LDS_MISC + 256;

#define XB_TMO      128
#define XB_XCNT(j)  (256  + 64 * (j))
#define XB_XSUB(j)  (1280 + 64 * (j))
#define XB_XGEN(j)  (2304 + 64 * (j))
#define XB_TOP      3328
#define XB_TOPGEN   3392
#define XCD_BAR_WORDS 3456
#define XB_SPIN_CAP (1u << 18)
__device__ __forceinline__ unsigned xb_ld(unsigned* p)              { return __hip_atomic_load(p, __ATOMIC_RELAXED, __HIP_MEMORY_SCOPE_AGENT); }
__device__ __forceinline__ unsigned xb_add(unsigned* p, unsigned v) { return __hip_atomic_fetch_add(p, v, __ATOMIC_RELAXED, __HIP_MEMORY_SCOPE_AGENT); }
__device__ __forceinline__ unsigned xb_xcc_id() { return (unsigned)__builtin_amdgcn_s_getreg((3 << 11) | 20) & 0xFu; }
#define XB_SPIN(cond, bar) do { unsigned _sp = 0; while (cond) { __builtin_amdgcn_s_sleep(1); \
    if ((++_sp & 255u) == 0u) { if (xb_ld(&(bar)[XB_TMO])) break; if (_sp > XB_SPIN_CAP) { atomicAdd(&(bar)[XB_TMO], 1u); break; } } } } while (0)
struct XcdBarrier { unsigned* bar; unsigned x; volatile LAS unsigned* st; };
__device__ __forceinline__ XcdBarrier xcd_barrier_post(unsigned* bar, volatile LAS unsigned* st) {
    XcdBarrier b; b.bar = bar; b.x = xb_xcc_id(); b.st = st;
    if (threadIdx.x == 0) (void)xb_add(&bar[XB_XCNT(b.x)], 1u);
    return b;
}
__device__ __forceinline__ void xcd_barrier_complete(unsigned* bar, unsigned x, unsigned& nloc, unsigned& nx) {
    const unsigned G = gridDim.x * gridDim.y * gridDim.z;
    unsigned sum, cnt, mine, sp = 0u;
    for (;;) {
        sum = 0u; cnt = 0u; mine = 0u;
#pragma unroll
        for (unsigned j = 0; j < 16; ++j) { const unsigned c = xb_ld(&bar[XB_XCNT(j)]); sum += c; cnt += (c > 0u) ? 1u : 0u; mine = (j == x) ? c : mine; }
        if (sum == G) break;
        __builtin_amdgcn_s_sleep(1);
        if ((++sp & 255u) == 0u) { if (xb_ld(&bar[XB_TMO])) break; if (sp > XB_SPIN_CAP) { atomicAdd(&bar[XB_TMO], 1u); break; } }
    }
    nloc = mine > 0u ? mine : 1u; nx = cnt > 0u ? cnt : 1u;
}
__device__ __forceinline__ void xcd_barrier(const XcdBarrier& b) {
    asm volatile("s_waitcnt vmcnt(0)" ::: "memory");
    __syncthreads();
    if (threadIdx.x == 0) {
        unsigned* bar = b.bar;
        __builtin_amdgcn_s_waitcnt(0);
        unsigned nloc = b.st[0], nx = b.st[1];
        if (nloc == 0u) { xcd_barrier_complete(bar, b.x, nloc, nx); b.st[0] = nloc; b.st[1] = nx; }
        const unsigned old = xb_add(&bar[XB_XSUB(b.x)], 1u);
        const unsigned gen = old / nloc;
        if (old + 1u == (gen + 1u) * nloc) {
            __builtin_amdgcn_fence(__ATOMIC_RELEASE, "agent");
            asm volatile("s_waitcnt vmcnt(0)" ::: "memory");
            const unsigned og = xb_add(&bar[XB_TOP], 1u);
            const unsigned tg = og / nx;
            if (og + 1u == (tg + 1u) * nx) xb_add(&bar[XB_TOPGEN], 1u);
            else XB_SPIN(xb_ld(&bar[XB_TOPGEN]) == tg, bar);
            __builtin_amdgcn_fence(__ATOMIC_ACQUIRE, "agent");
            xb_add(&bar[XB_XGEN(b.x)], 1u);
            asm volatile("s_waitcnt vmcnt(0)" ::: "memory");
        } else {
            XB_SPIN(xb_ld(&bar[XB_XGEN(b.x)]) == gen, bar);
            __builtin_amdgcn_fence(__ATOMIC_ACQUIRE, "agent");
            asm volatile("s_waitcnt vmcnt(0)" ::: "memory");
        }
    }
    __syncthreads();
}

__device__ __forceinline__ unsigned f2bf_u(float f) { unsigned u = __builtin_bit_cast(unsigned, f); return (u + 0x7fffu + ((u >> 16) & 1u)) >> 16; }
__device__ __forceinline__ unsigned pk2(float lo, float hi) { return f2bf_u(lo) | (f2bf_u(hi) << 16); }
__device__ __forceinline__ float bflo(unsigned w) { return __builtin_bit_cast(float, w << 16); }
__device__ __forceinline__ float bfhi(unsigned w) { return __builtin_bit_cast(float, w & 0xffff0000u); }
__device__ __forceinline__ float silu_f(float v) { return v / (1.0f + __expf(-v)); }

struct Args { const float* in[21]; float* out; unsigned char* ws; int ph_lo, ph_hi; };
enum { I_X = 0, I_C, I_WADA, I_BADA, I_WIN, I_BIN, I_CONVW, I_CONVB, I_FW1, I_FB1, I_FWI, I_FBI, I_FWO, I_FFREQ, I_HBIAS, I_POOLW, I_POOLS, I_WOUT, I_BOUT, I_LNG, I_LNB };
typedef const __attribute__((address_space(4))) Args* ArgsP;
struct Frame { LAS unsigned char* lds; int tid, lane, wave, G, blk; ArgsP ap; };
#define AP_FRESH(F) ArgsP ap = (F).ap; asm volatile("" : "+s"(ap))
template <class T> __device__ __forceinline__ T* wsp(ArgsP ap, size_t off) { return (T*)(ap->ws + off); }

__device__ void tile_transpose(const Frame& F, const float* src, int lds_, int k0s, int n0s, bf16* dst, int ldd, int n0d, int k0d, const float* colscale) {
    LAS float* tile = (LAS float*)F.lds;
    const int t = F.tid;
    if (src) {
        const int i = t >> 3, jq = (t & 7) * 8;
        const f32x4v a = *(const f32x4v*)(src + (size_t)(k0s + i) * lds_ + n0s + jq), b = *(const f32x4v*)(src + (size_t)(k0s + i) * lds_ + n0s + jq + 4);
#pragma unroll
        for (int e = 0; e < 4; ++e) { tile[i * 65 + jq + e] = a[e]; tile[i * 65 + jq + 4 + e] = b[e]; }
    }
    __syncthreads();
    {
        const int j = t >> 3, iq = (t & 7) * 8;
        float v[8];
#pragma unroll
        for (int e = 0; e < 8; ++e) v[e] = src ? tile[(iq + e) * 65 + j] : 0.0f;
        if (src && colscale) { const float s = colscale[n0s + j];
#pragma unroll
            for (int e = 0; e < 8; ++e) v[e] *= s; }
        u32x4v w; w.x = pk2(v[0], v[1]); w.y = pk2(v[2], v[3]); w.z = pk2(v[4], v[5]); w.w = pk2(v[6], v[7]);
        *(u32x4v*)(dst + (size_t)(n0d + j) * ldd + k0d + iq) = w;
    }
    __syncthreads();
}
__device__ void p0_prologue(const Frame& F) {
    const int t = F.tid, blk = F.blk, G = F.G;
    AP_FRESH(F);
    const float *c_in = ap->in[I_C], *w_ada = ap->in[I_WADA], *b_ada = ap->in[I_BADA]; float* mod = wsp<float>(ap, WS_MOD);
    for (int job = blk; job < 256; job += G) {
        const int j0 = job * 12;
        LAS float* red = (LAS float*)F.lds;
        if (t < 510) {
            const int r = t / 3, q = t % 3;
            f32x4v a0 = {0.f, 0.f, 0.f, 0.f}, a1 = {0.f, 0.f, 0.f, 0.f};
            for (int i = r; i < DM; i += 170) {
                const f32x4v w = *(const f32x4v*)(w_ada + (size_t)i * 3072 + j0 + 4 * q);
                const float s0 = silu_f(c_in[i]), s1 = silu_f(c_in[DM + i]);
                a0 += w * s0; a1 += w * s1;
            }
#pragma unroll
            for (int e = 0; e < 4; ++e) { red[(r * 3 + q) * 8 + e] = a0[e]; red[(r * 3 + q) * 8 + 4 + e] = a1[e]; }
        }
        __syncthreads();
        if (t < 24) {
            const int b = t / 12, jj = t % 12, q = jj >> 2, e = jj & 3;
            float s = 0.f;
            for (int r = 0; r < 170; ++r) s += red[(r * 3 + q) * 8 + b * 4 + e];
            mod[b * 3072 + j0 + jj] = s + b_ada[j0 + jj];
        }
        __syncthreads();
    }
    const float *w_in = ap->in[I_WIN], *w_out = ap->in[I_WOUT], *f_wo = ap->in[I_FWO], *pool_w = ap->in[I_POOLW], *pool_scale = ap->in[I_POOLS];
    bf16 *WinT = wsp<bf16>(ap, WS_WINT), *WoutT = wsp<bf16>(ap, WS_WOUTT), *FWT = wsp<bf16>(ap, WS_FWT), *PWT = wsp<bf16>(ap, WS_PWT);
    constexpr int J_WIN = 16 * 48, J_WOUT = 16 * 16, J_FW = 32 * 4, J_PW = 64, J_ALL = J_WIN + J_WOUT + J_FW + J_PW;
    for (int job = blk; job < J_ALL; job += G) {
        int j = job;
        if (j < J_WIN) { const int kt = j / 48, nt = j % 48; tile_transpose(F, w_in, 3072, kt * 64, nt * 64, WinT, 1024, nt * 64, kt * 64, nullptr); continue; }
        j -= J_WIN;
        if (j < J_WOUT) { const int kt = j / 16, nt = j % 16; tile_transpose(F, w_out, 1024, kt * 64, nt * 64, WoutT, 1024, nt * 64, kt * 64, nullptr); continue; }
        j -= J_WOUT;
        if (j < J_FW) { const int nt = j / 4, kt = j % 4; tile_transpose(F, kt == 0 ? f_wo : nullptr, 2048, 0, nt * 64, FWT, 256, nt * 64, kt * 64, nullptr); continue; }
        j -= J_FW;
        { const int nt = j / 8, kt = j % 8, g = nt / 2;
          const bool diag = (kt / 2) == g;
          tile_transpose(F, diag ? pool_w + (size_t)g * 128 * 128 : nullptr, 128, (kt & 1) * 64, (nt & 1) * 64, PWT, 512, nt * 64, kt * 64, pool_scale + g * 128);
        }
    }
    {
        const int lane = F.lane, gw = blk * 8 + F.wave, nw = G * 8;
        const float *f_w1 = ap->in[I_FW1], *f_wi = ap->in[I_FWI], *f_bi = ap->in[I_FBI]; bf16* H3 = wsp<bf16>(ap, WS_H3);
        const float freq = ap->in[I_FFREQ][lane], b1 = ap->in[I_FB1][lane], bi0 = f_bi[lane], bi1 = f_bi[64 + lane];
        for (int grp = gw; grp < SEQ / 8; grp += nw) {
            const int l0 = grp * 8;
            float feat[8];
#pragma unroll
            for (int p = 0; p < 8; ++p) {
                const int l = l0 + p; float f = 0.f;
                if (lane == 0) f = (float)l * (1.0f / (float)(SEQ - 1));
                else if (lane < 33) { const int bi = (lane - 1) & 15; const float fr = 1e-4f + (float)bi * ((15.0f - 1e-4f) / 15.0f);
                    const float w = (6.283185307179586f / (float)SEQ) * (float)l; const float arg = fr * w; f = lane < 17 ? cosf(arg) : -sinf(arg); }
                feat[p] = f;
            }
            float acc[8];
#pragma unroll
            for (int p = 0; p < 8; ++p) acc[p] = b1;
            for (int i = 0; i < 33; ++i) { const float w = f_w1[i * 64 + lane];
#pragma unroll
                for (int p = 0; p < 8; ++p) acc[p] += __shfl(feat[p], i) * w; }
            float h[8];
#pragma unroll
            for (int p = 0; p < 8; ++p) h[p] = sinf(freq * acc[p]);
#pragma unroll
            for (int layer = 0; layer < 2; ++layer) {
                const float* W = f_wi + layer * 4096; const float bb = layer ? bi1 : bi0;
#pragma unroll
                for (int p = 0; p < 8; ++p) acc[p] = bb;
                for (int i = 0; i < 64; ++i) { const float w = W[i * 64 + lane];
#pragma unroll
                    for (int p = 0; p < 8; ++p) acc[p] += __shfl(h[p], i) * w; }
#pragma unroll
                for (int p = 0; p < 8; ++p) h[p] = sinf(freq * acc[p]);
            }
#pragma unroll
            for (int p = 0; p < 8; ++p) { bf16* row = H3 + (size_t)(l0 + p) * 256; row[lane] = (bf16)f2bf_u(h[p]); row[64 + lane] = 0; row[128 + lane] = 0; row[192 + lane] = 0; }
        }
    }
}

namespace pg8 {
struct EpiRowBias {
    static constexpr bool PERM = true, AFTER_DRAIN = false;
    bf16_t* O; int ldc; const float* rbias;
    __device__ __forceinline__ void operator()(const f32x4 (&acc)[2][2][4][2], const Unit& u, int wr, int wc, int fr, int fq) const {
        const int row0 = u.pm * BM + wr * 64 + fr, col0 = u.pn * BM + wc * 32 + 8 * fq;
#pragma unroll
        for (int ai = 0; ai < 2; ++ai)
#pragma unroll
            for (int m = 0; m < 4; ++m) { const int row = row0 + ai * HALF + m * 16; const float b = rbias[row]; bf16_t* rowp = O + (size_t)row * ldc + col0;
#pragma unroll
                for (int bj = 0; bj < 2; ++bj) { const f32x4 v0 = acc[ai][bj][m][0] + b, v1 = acc[ai][bj][m][1] + b;
                    u32x4 w; w.x = cvt_pk_bf16(v0[0], v0[1]); w.y = cvt_pk_bf16(v0[2], v0[3]); w.z = cvt_pk_bf16(v1[0], v1[1]); w.w = cvt_pk_bf16(v1[2], v1[3]);
                    *(u32x4*)(rowp + bj * HALF) = w; } }
    }
};
struct EpiDecay {
    static constexpr bool PERM = true, AFTER_DRAIN = false;
    bf16_t* O; int ldc;
    __device__ __forceinline__ void operator()(const f32x4 (&acc)[2][2][4][2], const Unit& u, int wr, int wc, int fr, int fq) const {
        const int row0 = u.pm * BM + wr * 64 + fr, col0 = u.pn * BM + wc * 32 + 8 * fq;
        const float dmin = -3.0701134573253944f, dmax = -15.350567286626972f;
#pragma unroll
        for (int ai = 0; ai < 2; ++ai)
#pragma unroll
            for (int m = 0; m < 4; ++m) { const int row = row0 + ai * HALF + m * 16, c = row & 511;
                const float dl2 = (dmin + (dmax - dmin) * ((float)c * (1.0f / 511.0f))) * 1.4426950408889634f * (1.0f / 16383.0f);
                bf16_t* rowp = O + (size_t)row * ldc + col0;
#pragma unroll
                for (int bj = 0; bj < 2; ++bj) { float v[8];
#pragma unroll
                    for (int e = 0; e < 8; ++e) { const int l = col0 + bj * HALF + e; v[e] = acc[ai][bj][m][e >> 2][e & 3] * __builtin_amdgcn_exp2f(dl2 * (float)l); }
                    u32x4 w; w.x = cvt_pk_bf16(v[0], v[1]); w.y = cvt_pk_bf16(v[2], v[3]); w.z = cvt_pk_bf16(v[4], v[5]); w.w = cvt_pk_bf16(v[6], v[7]);
                    *(u32x4*)(rowp + bj * HALF) = w; } }
    }
};
struct EpiPoolGate {
    static constexpr bool PERM = true, AFTER_DRAIN = false;
    bf16_t* Y; const bf16_t* TP;
    __device__ __forceinline__ void operator()(const f32x4 (&acc)[2][2][4][2], const Unit& u, int wr, int wc, int fr, int fq) const {
        const int row0 = u.pm * BM + wr * 64 + fr, col0 = u.pn * BM + wc * 32 + 8 * fq;
#pragma unroll
        for (int ai = 0; ai < 2; ++ai)
#pragma unroll
            for (int m = 0; m < 4; ++m) { const int row = row0 + ai * HALF + m * 16;
#pragma unroll
                for (int bj = 0; bj < 2; ++bj) { const size_t off = (size_t)row * 1024 + 512 + col0 + bj * HALF;
                    const u32x4 g = *(const u32x4*)(TP + off); float v[8];
#pragma unroll
                    for (int e = 0; e < 8; ++e) { const unsigned gw = e < 2 ? g.x : e < 4 ? g.y : e < 6 ? g.z : g.w; const float q = (e & 1) ? __builtin_bit_cast(float, gw & 0xffff0000u) : __builtin_bit_cast(float, gw << 16);
                        v[e] = acc[ai][bj][m][e >> 2][e & 3] * (q / (1.0f + __expf(-q))); }
                    u32x4 w; w.x = cvt_pk_bf16(v[0], v[1]); w.y = cvt_pk_bf16(v[2], v[3]); w.z = cvt_pk_bf16(v[4], v[5]); w.w = cvt_pk_bf16(v[6], v[7]);
                    *(u32x4*)(Y + off) = w; } }
    }
};
struct EpiResGate {
    static constexpr bool PERM = false, AFTER_DRAIN = false;
    float* C; const float* X; const float* mod; const float* bout; float alpha;
    __device__ __forceinline__ void operator()(const f32x4 (&acc)[2][2][4][2], const Unit& u, int wr, int wc, int fr, int fq) const {
        const int row0 = u.pm * BM + wr * 64 + fr, col0 = u.pn * BM + wc * 32 + 4 * fq;
        const float* gate = mod + ((u.pm * BM) >= 16384 ? 3072 : 0) + 2048;
        f32x4 bv[2][2], gv[2][2];
#pragma unroll
        for (int bj = 0; bj < 2; ++bj)
#pragma unroll
            for (int n = 0; n < 2; ++n) { bv[bj][n] = *(const f32x4*)(bout + col0 + bj * HALF + n * 16); gv[bj][n] = *(const f32x4*)(gate + col0 + bj * HALF + n * 16); }
#pragma unroll
        for (int ai = 0; ai < 2; ++ai)
#pragma unroll
            for (int m = 0; m < 4; ++m) { const size_t off = (size_t)(row0 + ai * HALF + m * 16) * 1024 + col0;
#pragma unroll
                for (int bj = 0; bj < 2; ++bj)
#pragma unroll
                    for (int n = 0; n < 2; ++n) { const f32x4 xv = *(const f32x4*)(X + off + bj * HALF + n * 16);
                        *(f32x4*)(C + off + bj * HALF + n * 16) = xv * alpha + gv[bj][n] * (acc[ai][bj][m][n] + bv[bj][n]); } }
    }
};
}

__device__ void p1_modulate(const Frame& F) {
    AP_FRESH(F);
    const float* x = ap->in[I_X]; const float* mod = wsp<float>(ap, WS_MOD); bf16* U = wsp<bf16>(ap, WS_U);
    const size_t n8 = (size_t)NTOK * DM / 8, stride = (size_t)F.G * NT;
    for (size_t i = (size_t)F.blk * NT + F.tid; i < n8; i += stride) {
        const size_t e0 = i * 8; const int col = (int)(e0 & (DM - 1)); const int b = (int)(e0 >= (size_t)SEQ * DM);
        const float* md = mod + b * 3072;
        const f32x4v x0 = *(const f32x4v*)(x + e0), x1 = *(const f32x4v*)(x + e0 + 4);
        const f32x4v sh0 = *(const f32x4v*)(md + col), sh1 = *(const f32x4v*)(md + col + 4), sc0 = *(const f32x4v*)(md + 1024 + col), sc1 = *(const f32x4v*)(md + 1024 + col + 4);
        const f32x4v u0 = x0 * (sc0 + 1.0f) + sh0, u1 = x1 * (sc1 + 1.0f) + sh1;
        u32x4v w; w.x = pk2(u0[0], u0[1]); w.y = pk2(u0[2], u0[3]); w.z = pk2(u1[0], u1[1]); w.w = pk2(u1[2], u1[3]);
        *(u32x4v*)(U + e0) = w;
    }
}

__device__ void p3_pool(const Frame& F) {
    AP_FRESH(F);
    const bf16* TP = wsp<bf16>(ap, WS_TP); bf16* PP = wsp<bf16>(ap, WS_PP);
    const size_t n8 = (size_t)NTOK * 512 / 8, stride = (size_t)F.G * NT;
    for (size_t i = (size_t)F.blk * NT + F.tid; i < n8; i += stride) {
        const int tok = (int)(i >> 6), c8 = (int)(i & 63) * 8, g = c8 >> 7, hw = 1 << g;
        const int b = tok >> 14, pos = tok & (SEQ - 1);
        const int lo = pos - hw < 0 ? 0 : pos - hw, hi = pos + hw > SEQ ? SEQ : pos + hw;
        float s[8] = {0.f, 0.f, 0.f, 0.f, 0.f, 0.f, 0.f, 0.f}, own[8];
        const bf16* base = TP + (size_t)b * SEQ * 1024 + c8;
        for (int q = lo; q < hi; ++q) {
            const u32x4v v = *(const u32x4v*)(base + (size_t)q * 1024);
            s[0] += bflo(v.x); s[1] += bfhi(v.x); s[2] += bflo(v.y); s[3] += bfhi(v.y); s[4] += bflo(v.z); s[5] += bfhi(v.z); s[6] += bflo(v.w); s[7] += bfhi(v.w);
        }
        { const u32x4v v = *(const u32x4v*)(base + (size_t)pos * 1024);
          own[0] = bflo(v.x); own[1] = bfhi(v.x); own[2] = bflo(v.y); own[3] = bfhi(v.y); own[4] = bflo(v.z); own[5] = bfhi(v.z); own[6] = bflo(v.w); own[7] = bfhi(v.w); }
        const float inv = 1.0f / (float)(hi - lo);
        u32x4v w; w.x = pk2(s[0] * inv - own[0], s[1] * inv - own[1]); w.y = pk2(s[2] * inv - own[2], s[3] * inv - own[3]);
        w.z = pk2(s[4] * inv - own[4], s[5] * inv - own[5]); w.w = pk2(s[6] * inv - own[6], s[7] * inv - own[7]);
        *(u32x4v*)(PP + (size_t)tok * 512 + c8) = w;
    }
}

__device__ void p3_hyena(const Frame& F) {
    LAS f2* L = (LAS f2*)F.lds;
    const int t = F.tid;
    AP_FRESH(F);
    hy::JobArgs J;
    J.ch = wsp<bf16>(ap, WS_CH); J.kt = wsp<bf16>(ap, WS_KT); J.conv_w = ap->in[I_CONVW]; J.conv_b = ap->in[I_CONVB]; J.hbias = ap->in[I_HBIAS];
    J.sbase = (f2*)(ap->ws + WS_ST + (size_t)F.blk * 393216); J.yh = wsp<bf16>(ap, WS_YH);
    const hy::Stash S = hy::make_stash(J);
    for (int c = F.blk; c < DH; c += F.G) {
        hy::seg_prep(J, S, c, t);
        for (int oh = 0; oh < 4; ++oh) {
            const int o = oh >> 1; const bool tw = oh & 1;
            hy::seg_filter_p1(J, c, o, tw, t, L); __syncthreads();
            hy::fwd_p2(t, L); __syncthreads();
            hy::seg_filter_p3(S, t, L); __syncthreads();
            hy::seg_data_p1(S, tw, t, L); __syncthreads();
            hy::fwd_p2(t, L); __syncthreads();
            hy::seg_mul(S, t, L); __syncthreads();
            hy::inv_p2(t, L); __syncthreads();
            hy::seg_out(J, S, c, o, tw, t, L); __syncthreads();
        }
    }
}

__device__ void p4_transpose(const Frame& F) {
    LAS bf16* tile = (LAS bf16*)F.lds;
    const int t = F.tid;
    AP_FRESH(F);
    const bf16* YH = wsp<bf16>(ap, WS_YH); bf16* Y = wsp<bf16>(ap, WS_Y);
    for (int job = F.blk; job < 8 * 512; job += F.G) {
        const int ct = job & 7, tt = job >> 3;
        { const int r = t >> 3, q = (t & 7) * 8;
          const u32x4v v = *(const u32x4v*)(YH + (size_t)(ct * 64 + r) * NTOK + tt * 64 + q);
          tile[(q + 0) * 66 + r] = (bf16)(v.x & 0xffff); tile[(q + 1) * 66 + r] = (bf16)(v.x >> 16); tile[(q + 2) * 66 + r] = (bf16)(v.y & 0xffff); tile[(q + 3) * 66 + r] = (bf16)(v.y >> 16);
          tile[(q + 4) * 66 + r] = (bf16)(v.z & 0xffff); tile[(q + 5) * 66 + r] = (bf16)(v.z >> 16); tile[(q + 6) * 66 + r] = (bf16)(v.w & 0xffff); tile[(q + 7) * 66 + r] = (bf16)(v.w >> 16); }
        __syncthreads();
        { const int tok = t >> 3, q = (t & 7) * 8;
          const LAS unsigned* p = (const LAS unsigned*)(tile + tok * 66 + q);
          u32x4v w; w.x = p[0]; w.y = p[1]; w.z = p[2]; w.w = p[3];
          *(u32x4v*)(Y + (size_t)(tt * 64 + tok) * 1024 + ct * 64 + q) = w; }
        __syncthreads();
    }
}

__device__ void p6_layernorm(const Frame& F) {
    const int lane = F.lane;
    AP_FRESH(F);
    float* out = ap->out; const float *ln_g = ap->in[I_LNG], *ln_b = ap->in[I_LNB];
    for (int row = F.blk * 8 + F.wave; row < NTOK; row += F.G * 8) {
        float* p = out + (size_t)row * DM;
        f32x4v v[4]; float s = 0.f;
#pragma unroll
        for (int k = 0; k < 4; ++k) { v[k] = *(const f32x4v*)(p + k * 256 + lane * 4); s += (v[k][0] + v[k][1]) + (v[k][2] + v[k][3]); }
#pragma unroll
        for (int o = 32; o >= 1; o >>= 1) s += __shfl_xor(s, o);
        const float mean = s * (1.0f / DM); float q = 0.f;
#pragma unroll
        for (int k = 0; k < 4; ++k) { const f32x4v d = v[k] - mean; q += (d[0] * d[0] + d[1] * d[1]) + (d[2] * d[2] + d[3] * d[3]); }
#pragma unroll
        for (int o = 32; o >= 1; o >>= 1) q += __shfl_xor(q, o);
        const float rstd = 1.0f / sqrtf(q * (1.0f / DM) + LN_EPS);
#pragma unroll
        for (int k = 0; k < 4; ++k) { const f32x4v g = *(const f32x4v*)(ln_g + k * 256 + lane * 4), b = *(const f32x4v*)(ln_b + k * 256 + lane * 4);
            *(f32x4v*)(p + k * 256 + lane * 4) = (v[k] - mean) * rstd * g + b; }
    }
}

__global__ void __launch_bounds__(NT, 2) fwd_kernel(Args args) {
    extern __shared__ __attribute__((aligned(16))) unsigned char lds_raw[];
    Frame F;
    F.lds = (LAS unsigned char*)lds_raw; F.tid = threadIdx.x; F.lane = F.tid & 63; F.wave = __builtin_amdgcn_readfirstlane(F.tid >> 6); F.G = gridDim.x; F.blk = blockIdx.x;
    F.ap = (ArgsP)__builtin_amdgcn_kernarg_segment_ptr();
    unsigned char* ws = args.ws;
    volatile LAS unsigned* MISC = (volatile LAS unsigned*)(F.lds + LDS_MISC);
    if (F.tid < 64) MISC[F.tid] = 0u;
    __syncthreads();
    XcdBarrier bar; bar.bar = (unsigned*)(ws + WS_CTL); bar.x = 0; bar.st = nullptr;
    const int lo = args.ph_lo, hi = args.ph_hi;
    if (hi - lo > 1) bar = xcd_barrier_post((unsigned*)(ws + WS_CTL), MISC + 8);
#define IN(k) (lo <= (k) && (k) < hi)
#define SEAM(k) do { if (IN(k) && IN((k) + 1)) xcd_barrier(bar); } while (0)
    const int vcu = (F.G % 8 == 0) ? (F.blk % 8) * (F.G / 8) + F.blk / 8 : F.blk; (void)vcu;

    if (IN(0)) p0_prologue(F);
    SEAM(0);
    if (IN(1)) {
        p1_modulate(F);
        AP_FRESH(F);
        pg8::Gemm g{wsp<bf16>(ap, WS_FWT), wsp<bf16>(ap, WS_H3), 2048, SEQ, 256}; pg8::StaticOrder S; S.init(g.M, g.N, F.G, F.blk); pg8::EpiDecay E{wsp<bf16>(ap, WS_KT), SEQ};
        pg8::gemm_phase<pg8::EpiDecay, pg8::StaticOrder, false>(F.lds, g, S, E, nullptr);
    }
    SEAM(1);
    if (IN(2)) {
        { AP_FRESH(F);
          pg8::Gemm g{wsp<bf16>(ap, WS_WINT), wsp<bf16>(ap, WS_U), 2048, NTOK, DM}; pg8::StaticOrder S; S.init(g.M, g.N, F.G, F.blk); pg8::EpiRowBias E{wsp<bf16>(ap, WS_CH), NTOK, ap->in[I_BIN]};
          pg8::gemm_phase<pg8::EpiRowBias, pg8::StaticOrder, false>(F.lds, g, S, E, nullptr); }
        __syncthreads();
        { AP_FRESH(F);
          pg8::Gemm g{wsp<bf16>(ap, WS_U), wsp<bf16>(ap, WS_WINT) + (size_t)2048 * DM, NTOK, 1024, DM}; pg8::StaticOrder S; S.init(g.M, g.N, F.G, F.blk); pg8::EpiBf16<0> E{wsp<bf16>(ap, WS_TP), 1024, ap->in[I_BIN] + 2048, 0, 0};
          pg8::gemm_phase<pg8::EpiBf16<0>, pg8::StaticOrder, false>(F.lds, g, S, E, nullptr); }
    }
    SEAM(2);
    if (IN(3)) { p3_hyena(F); p3_pool(F); }
    SEAM(3);
    if (IN(4)) {
        p4_transpose(F);
        __syncthreads();
        AP_FRESH(F);
        pg8::Gemm g{wsp<bf16>(ap, WS_PP), wsp<bf16>(ap, WS_PWT), NTOK, 512, 512}; pg8::StaticOrder S; S.init(g.M, g.N, F.G, F.blk); pg8::EpiPoolGate E{wsp<bf16>(ap, WS_Y), wsp<bf16>(ap, WS_TP)};
        pg8::gemm_phase<pg8::EpiPoolGate, pg8::StaticOrder, false>(F.lds, g, S, E, nullptr);
    }
    SEAM(4);
    if (IN(5)) {
        AP_FRESH(F);
        pg8::Gemm g{wsp<bf16>(ap, WS_Y), wsp<bf16>(ap, WS_WOUTT), NTOK, DM, DM}; pg8::StaticOrder S; S.init(g.M, g.N, F.G, F.blk); pg8::EpiResGate E{ap->out, ap->in[I_X], wsp<float>(ap, WS_MOD), ap->in[I_BOUT], DN_ALPHA};
        pg8::gemm_phase<pg8::EpiResGate, pg8::StaticOrder, false>(F.lds, g, S, E, nullptr);
    }
    SEAM(5);
    if (IN(6)) p6_layernorm(F);
#undef IN
#undef SEAM
}

extern "C" void kernel_launch(void* const* d_in, const int* in_sizes, int n_in, void* d_out, int out_size, void* d_ws, size_t ws_size, hipStream_t stream) {
    static int grid = 0;
    if (grid == 0) {
        if (n_in != 21 || in_sizes[0] != NTOK * DM || out_size != NTOK * DM || ws_size < WS_END) {
            fprintf(stderr, "kernel_launch: unexpected shapes (n_in %d, in0 %d, out %d, ws %zu < %zu)\n", n_in, n_in > 0 ? in_sizes[0] : -1, out_size, ws_size, (size_t)WS_END); grid = -1; return; }
        int dev = 0, cus = 0, per_cu = 0;
        if (hipGetDevice(&dev) != hipSuccess || hipDeviceGetAttribute(&cus, hipDeviceAttributeMultiprocessorCount, dev) != hipSuccess) { grid = -1; return; }
        if (hipFuncSetAttribute((const void*)fwd_kernel, hipFuncAttributeMaxDynamicSharedMemorySize, LDS_BYTES) != hipSuccess) { fprintf(stderr, "kernel_launch: hipFuncSetAttribute failed\n"); grid = -1; return; }
        if (hipOccupancyMaxActiveBlocksPerMultiprocessor(&per_cu, (const void*)fwd_kernel, NT, LDS_BYTES) != hipSuccess || per_cu < 1) { fprintf(stderr, "kernel_launch: occupancy query says %d blocks per CU\n", per_cu); }
        (void)hipGetLastError();
        grid = cus;
    }
    if (grid < 0) return;
    (void)hipMemsetAsync((char*)d_ws + WS_CTL, 0, CTL_BYTES, stream);
    Args a{};
    for (int i = 0; i < 21; ++i) a.in[i] = (const float*)d_in[i];
    a.out = (float*)d_out; a.ws = (unsigned char*)d_ws;
    if (MK_N_LAUNCHES == 1) { a.ph_lo = 0; a.ph_hi = N_PHASES; hipLaunchKernelGGL(fwd_kernel, dim3(grid), dim3(NT), LDS_BYTES, stream, a); }
    else for (int p = 0; p < N_PHASES; ++p) { a.ph_lo = p; a.ph_hi = p + 1; hipLaunchKernelGGL(fwd_kernel, dim3(grid), dim3(NT), LDS_BYTES, stream, a); }
}
```

```cpp
#include <hip/hip_runtime.h>
#include <cstdio>
#include <cstdint>
#ifndef MK_N_LAUNCHES
#define MK_N_LAUNCHES 1
#endif
namespace pg8 {
#define PG8_LAS __attribute__((address_space(3)))
typedef unsigned short bf16_t;
typedef short bf16x8 __attribute__((ext_vector_type(8)));
typedef float f32x4 __attribute__((ext_vector_type(4)));
typedef unsigned u32x4 __attribute__((ext_vector_type(4)));
constexpr int BM = 256, BK = 64, HALF = 128, HTB = HALF * BK * 2  , STAGE_BYTES = 8 * HTB, NXCD = 8, WGM = 8;

__host__ __device__ __forceinline__ int lds_byte(int r, int c) { const int st = (r >> 4) * 2 + (c >> 5), rr = r & 15, cc = c & 31, ob = rr * 64 + cc * 2; return st * 1024 + (ob ^ (((ob >> 9) & 1) << 5)); }
__host__ __device__ __forceinline__ void stage_rc(int b, int& R, int& C) { const int st = b / 1024, sb = b % 1024, swz = sb ^ (((sb >> 9) & 1) << 5); R = (st >> 1) * 16 + swz / 64; C = (st & 1) * 32 + (swz % 64) / 2; }
__host__ __device__ __forceinline__ int perm32(int rho) { const int n = rho >> 4, i = rho & 15; return 8 * (i >> 2) + 4 * n + (i & 3); }

struct Unit { int pm, pn; };
struct Gemm { const bf16_t* A; const bf16_t* Bt; int M, N, K; };

struct StaticOrder {
    int nM, nN, nwg, G, c;
    __host__ __device__ void init(int M, int N, int G_, int c_) { nM = M / BM; nN = N / BM; nwg = nM * nN; G = G_; c = c_; }
    __host__ __device__ bool next(int i, Unit& u) const {
        const long L = (long)i * G + c; if (L >= nwg) return false;
        int wgid = (int)L; { const int q = nwg / NXCD, r = nwg % NXCD, xcd = wgid % NXCD, off = wgid / NXCD; wgid = (xcd < r ? xcd * (q + 1) : r * (q + 1) + (xcd - r) * q) + off; }
        const int nig = WGM * nN, gid = wgid / nig, fm = gid * WGM, gsz = (nM - fm) < WGM ? (nM - fm) : WGM;
        u.pm = fm + ((wgid % nig) % gsz); u.pn = (wgid % nig) / gsz; return true;
    }
    __device__ __forceinline__ void a_ready(const Unit&) const {}
    __device__ __forceinline__ void done(const Unit&) const {}
};
struct CountedOrder : StaticOrder {
    const unsigned* ready; unsigned need; unsigned* tmo;
    __device__ __forceinline__ void a_ready(const Unit& u) const {
        if (threadIdx.x < 64) {
            const unsigned long long t0 = __builtin_amdgcn_s_memrealtime(); unsigned polls = 0;
            while ((unsigned)__builtin_amdgcn_readfirstlane(__hip_atomic_load(ready + 64 * u.pm, __ATOMIC_RELAXED, __HIP_MEMORY_SCOPE_AGENT)) < need) {
                if ((++polls & 255u) == 0u && __builtin_amdgcn_readfirstlane(__hip_atomic_load(tmo, __ATOMIC_RELAXED, __HIP_MEMORY_SCOPE_AGENT)) != 0u) break;
                if (__builtin_amdgcn_s_memrealtime() - t0 > 2000000ull) {
                    if (threadIdx.x == 0) { unsigned expect = 0u; __hip_atomic_compare_exchange_strong(tmo + 1, &expect, 0x600u | (unsigned)(u.pm & 0xff), __ATOMIC_RELAXED, __ATOMIC_RELAXED, __HIP_MEMORY_SCOPE_AGENT); __hip_atomic_store(tmo, 1u, __ATOMIC_RELAXED, __HIP_MEMORY_SCOPE_AGENT); }
                    break; }
                __builtin_amdgcn_s_sleep(2); }
            __builtin_amdgcn_fence(__ATOMIC_ACQUIRE, "agent");
            asm volatile("s_waitcnt vmcnt(0)" ::: "memory");
        }
#if !defined(BROKEN_HOOK_NO_BARRIER)
        asm volatile("" ::: "memory"); __builtin_amdgcn_s_barrier(); asm volatile("" ::: "memory");
#endif
    }
};

__device__ __forceinline__ unsigned cvt_pk_bf16(float lo, float hi) { unsigned r; asm volatile("v_cvt_pk_bf16_f32 %0, %1, %2" : "=v"(r) : "v"(lo), "v"(hi)); return r; }
typedef float f32x2 __attribute__((ext_vector_type(2)));
__device__ __forceinline__ f32x2 gelu_pk(f32x2 v) {
    const f32x2 av = __builtin_elementwise_abs(v), d = av * 0.2316418882f + 1.0f;
    f32x2 t; t.x = __builtin_amdgcn_rcpf(d.x); t.y = __builtin_amdgcn_rcpf(d.y);
    f32x2 q = t * 0.5307027145f + (-0.7265760135f); q = q * t + 0.7107068705f; q = q * t + (-0.142248368f); q = q * t + 0.127414796f; q = q * t;
    const f32x2 s = (v * v) * (-0.72134752044f);
    f32x2 e; e.x = __builtin_amdgcn_exp2f(s.x); e.y = __builtin_amdgcn_exp2f(s.y);
    const f32x2 m = v * (q * e), r = v - m;
    f32x2 o; o.x = v.x < 0.f ? m.x : r.x; o.y = v.y < 0.f ? m.y : r.y; return o;
}

struct EpiF32 {
    static constexpr bool PERM = false, AFTER_DRAIN = false;
    float* C; int ldc; const float* bias;
    __device__ __forceinline__ void operator()(const f32x4 (&acc)[2][2][4][2], const Unit& u, int wr, int wc, int fr, int fq) const {
        const int row0 = u.pm * BM + wr * 64 + fr, col0 = u.pn * BM + wc * 32 + 4 * fq;
        f32x4 bv[2][2];
#pragma unroll
        for (int bj = 0; bj < 2; ++bj)
#pragma unroll
            for (int n = 0; n < 2; ++n) bv[bj][n] = bias ? *(const f32x4*)(bias + col0 + bj * HALF + n * 16) : (f32x4){0.f, 0.f, 0.f, 0.f};
#pragma unroll
        for (int ai = 0; ai < 2; ++ai)
#pragma unroll
            for (int m = 0; m < 4; ++m) { float* rowp = C + (size_t)(row0 + ai * HALF + m * 16) * ldc + col0;
#pragma unroll
                for (int bj = 0; bj < 2; ++bj)
#pragma unroll
                    for (int n = 0; n < 2; ++n) *(f32x4*)(rowp + bj * HALF + n * 16) = acc[ai][bj][m][n] + bv[bj][n]; }
    }
};
template <int ACT  > struct EpiBf16 {
    static constexpr bool PERM = true, AFTER_DRAIN = false;
    bf16_t* O; int ldc; const float* bias; int split_cols; size_t split_stride;
    __device__ __forceinline__ void operator()(const f32x4 (&acc)[2][2][4][2], const Unit& u, int wr, int wc, int fr, int fq) const {
        const int row0 = u.pm * BM + wr * 64 + fr; int colt = u.pn * BM; bf16_t* base = O;
        if (split_cols) { const int t = colt / split_cols; base += (size_t)t * split_stride; colt -= t * split_cols; }
        const int col0 = colt + wc * 32 + 8 * fq, bcol0 = u.pn * BM + wc * 32 + 8 * fq;
        f32x4 bv[2][2];
#pragma unroll
        for (int bj = 0; bj < 2; ++bj)
#pragma unroll
            for (int n = 0; n < 2; ++n) bv[bj][n] = bias ? *(const f32x4*)(bias + bcol0 + bj * HALF + 4 * n) : (f32x4){0.f, 0.f, 0.f, 0.f};
#pragma unroll
        for (int ai = 0; ai < 2; ++ai)
#pragma unroll
            for (int m = 0; m < 4; ++m) { bf16_t* rowp = base + (size_t)(row0 + ai * HALF + m * 16) * ldc + col0;
#pragma unroll
                for (int bj = 0; bj < 2; ++bj) { f32x4 v0 = acc[ai][bj][m][0] + bv[bj][0], v1 = acc[ai][bj][m][1] + bv[bj][1];
                    if (ACT == 1) { f32x2 a = gelu_pk((f32x2){v0[0], v0[1]}), b = gelu_pk((f32x2){v0[2], v0[3]}), c = gelu_pk((f32x2){v1[0], v1[1]}), d = gelu_pk((f32x2){v1[2], v1[3]});
                        v0 = (f32x4){a.x, a.y, b.x, b.y}; v1 = (f32x4){c.x, c.y, d.x, d.y}; }
                    if (ACT == 2) {
#pragma unroll
                        for (int j = 0; j < 4; ++j) { v0[j] = 0.5f * v0[j] * (1.0f + erff(v0[j] * 0.70710678f)); v1[j] = 0.5f * v1[j] * (1.0f + erff(v1[j] * 0.70710678f)); } }
                    u32x4 w; w.x = cvt_pk_bf16(v0[0], v0[1]); w.y = cvt_pk_bf16(v0[2], v0[3]); w.z = cvt_pk_bf16(v1[0], v1[1]); w.w = cvt_pk_bf16(v1[2], v1[3]);
                    *(u32x4*)(rowp + bj * HALF) = w; } }
    }
};

struct PanelStats {
    unsigned* xbuf;
    unsigned* cnt;
    unsigned* tmo;
    int ntn; float eps;
    unsigned code;
    __device__ __forceinline__ bool run(const f32x4 (&v)[2][2][4][2], const Unit& u, int wr, int wc, int fr, int fq, PG8_LAS unsigned char* lds, int wid, int lane) const {
        typedef float f32x2v __attribute__((ext_vector_type(2)));
        PG8_LAS f32x2v* P = (PG8_LAS f32x2v*)lds;
        PG8_LAS f32x2v* S = (PG8_LAS f32x2v*)(lds + 8192);
        PG8_LAS unsigned* flag = (PG8_LAS unsigned*)(lds + 8192 + 2048);
#pragma unroll
        for (int ai = 0; ai < 2; ++ai)
#pragma unroll
            for (int m = 0; m < 4; ++m) {
                float s = 0.f;
#pragma unroll
                for (int bj = 0; bj < 2; ++bj)
#pragma unroll
                    for (int n = 0; n < 2; ++n) { const f32x4 x = v[ai][bj][m][n]; s += (x[0] + x[1]) + (x[2] + x[3]); }
                s += __shfl_xor(s, 16); s += __shfl_xor(s, 32);
                const float mw = s * (1.0f / 64.0f); float q = 0.f;
#pragma unroll
                for (int bj = 0; bj < 2; ++bj)
#pragma unroll
                    for (int n = 0; n < 2; ++n) { const f32x4 d = v[ai][bj][m][n] - mw; q += (d[0] * d[0] + d[1] * d[1]) + (d[2] * d[2] + d[3] * d[3]); }
                q += __shfl_xor(q, 16); q += __shfl_xor(q, 32);
                if (fq == 0) P[(ai * HALF + wr * 64 + m * 16 + fr) * 4 + wc] = (f32x2v){mw, q};
            }
        asm volatile("s_waitcnt lgkmcnt(0)" ::: "memory"); __builtin_amdgcn_s_barrier(); asm volatile("" ::: "memory");
#if defined(BROKEN_NO_WAIT)
        if (blockIdx.x >= 64) { const long long t0 = clock64(); while (clock64() - t0 < 60000) __builtin_amdgcn_s_sleep(8); }
#endif
        const int row = wid * 32 + (lane & 31);
        if (lane < 32) {
            const f32x2v a = P[row * 4 + 0], b = P[row * 4 + 1], c = P[row * 4 + 2], d = P[row * 4 + 3];
            const float mt = (a.x + b.x + c.x + d.x) * 0.25f;
            const float da = a.x - mt, db = b.x - mt, dc = c.x - mt, dd = d.x - mt;
            const float m2 = (a.y + b.y) + (c.y + d.y) + 64.0f * ((da * da + db * db) + (dc * dc + dd * dd));
            unsigned long long* slot = (unsigned long long*)xbuf + ((size_t)(u.pm * BM + row) * 4 + u.pn);
            __hip_atomic_store(slot, ((unsigned long long)__float_as_uint(m2) << 32) | __float_as_uint(mt), __ATOMIC_RELAXED, __HIP_MEMORY_SCOPE_AGENT);
        }
        asm volatile("s_waitcnt vmcnt(0)" ::: "memory");
        if (lane == 0) __hip_atomic_fetch_add(cnt + 64 * u.pm, 1u, __ATOMIC_RELAXED, __HIP_MEMORY_SCOPE_AGENT);
        if (wid == 0) {
            bool dead = false; const unsigned long long t0 = __builtin_amdgcn_s_memrealtime(); const unsigned want = 8u * (unsigned)ntn;
            for (;;) {
#if defined(BROKEN_NO_WAIT)
                break;
#endif
                if ((unsigned)__builtin_amdgcn_readfirstlane(__hip_atomic_load(cnt + 64 * u.pm, __ATOMIC_RELAXED, __HIP_MEMORY_SCOPE_AGENT)) >= want) break;
                if (__builtin_amdgcn_s_memrealtime() - t0 > 2000000ull) {
                    if (lane == 0) { unsigned expect = 0u; __hip_atomic_compare_exchange_strong(tmo + 1, &expect, code | (unsigned)(u.pm & 0xff), __ATOMIC_RELAXED, __ATOMIC_RELAXED, __HIP_MEMORY_SCOPE_AGENT);
                                     __hip_atomic_store(tmo, 1u, __ATOMIC_RELAXED, __HIP_MEMORY_SCOPE_AGENT); }
                    dead = true; break; }
                __builtin_amdgcn_s_sleep(2);
            }
            __builtin_amdgcn_fence(__ATOMIC_ACQUIRE, "agent");
            if (lane == 0) flag[0] = dead ? 1u : 0u;
        }
        asm volatile("s_waitcnt vmcnt(0) lgkmcnt(0)" ::: "memory"); __builtin_amdgcn_s_barrier(); asm volatile("" ::: "memory");
        const bool bad = flag[0] != 0u;
        if (lane < 32) {
            const unsigned long long* slot = (const unsigned long long*)xbuf + (size_t)(u.pm * BM + row) * 4; float mt[4], m2[4]; float ms = 0.f;
#pragma unroll
            for (int t = 0; t < 4; ++t) { if (t < ntn) { const unsigned long long w = __hip_atomic_load(slot + t, __ATOMIC_RELAXED, __HIP_MEMORY_SCOPE_AGENT); mt[t] = __uint_as_float((unsigned)w); m2[t] = __uint_as_float((unsigned)(w >> 32)); } else { mt[t] = 0.f; m2[t] = 0.f; } ms += mt[t]; }
            const float mean = ms / (float)ntn; float q = 0.f;
#pragma unroll
            for (int t = 0; t < 4; ++t) if (t < ntn) { const float dm = mt[t] - mean; q += m2[t] + 256.0f * dm * dm; }
            S[row] = (f32x2v){mean, 1.0f / sqrtf(q / (256.0f * (float)ntn) + eps)};
        }
        asm volatile("s_waitcnt lgkmcnt(0)" ::: "memory"); __builtin_amdgcn_s_barrier(); asm volatile("" ::: "memory");
        return bad;
    }
};
struct EpiLnRes {
    static constexpr bool PERM = false, AFTER_DRAIN = true;
    const float* base; float* out; int ldc; const float* bias; PanelStats st; unsigned poison;
    __device__ __forceinline__ void refuse(size_t i0, size_t stride, int M, int N) const { const float q = __builtin_nanf(""); for (size_t i = i0; i < (size_t)M * N; i += stride) out[(i / N) * ldc + i % N] = q;
        if (i0 == 0) { unsigned expect = 0u; __hip_atomic_compare_exchange_strong(st.tmo + 1, &expect, 0x7f0u, __ATOMIC_RELAXED, __ATOMIC_RELAXED, __HIP_MEMORY_SCOPE_AGENT); __hip_atomic_store(st.tmo, 1u, __ATOMIC_RELAXED, __HIP_MEMORY_SCOPE_AGENT); } }
    __device__ __forceinline__ void fused(f32x4 (&acc)[2][2][4][2], const Unit& u, int wr, int wc, int fr, int fq, PG8_LAS unsigned char* lds, int wid, int lane) const {
        typedef float f32x2v __attribute__((ext_vector_type(2)));
        const PG8_LAS f32x2v* S = (const PG8_LAS f32x2v*)(lds + 8192);
        const int col0 = u.pn * BM + wc * 32 + 4 * fq;
#pragma unroll
        for (int bj = 0; bj < 2; ++bj)
#pragma unroll
            for (int n = 0; n < 2; ++n) { const f32x4 bv = bias ? *(const f32x4*)(bias + col0 + bj * HALF + n * 16) : (f32x4){0.f, 0.f, 0.f, 0.f};
#pragma unroll
                for (int ai = 0; ai < 2; ++ai)
#pragma unroll
                    for (int m = 0; m < 4; ++m) acc[ai][bj][m][n] += bv; }
        const bool bad = st.run(acc, u, wr, wc, fr, fq, lds, wid, lane) || poison != 0u;
        const float qnan = __builtin_nanf("");
#pragma unroll
        for (int ai = 0; ai < 2; ++ai)
#pragma unroll
            for (int m = 0; m < 4; ++m) { const int r = ai * HALF + wr * 64 + m * 16 + fr; const f32x2v sr = S[r]; const size_t off = (size_t)(u.pm * BM + r) * ldc + col0;
#pragma unroll
                for (int bj = 0; bj < 2; ++bj)
#pragma unroll
                    for (int n = 0; n < 2; ++n) { const f32x4 bs = *(const f32x4*)(base + off + bj * HALF + n * 16); f32x4 o = bs + (acc[ai][bj][m][n] - sr.x) * sr.y;
                        if (bad) o = (f32x4){qnan, qnan, qnan, qnan}; *(f32x4*)(out + off + bj * HALF + n * 16) = o; }
                asm volatile("" ::: "memory"); }
    }
};
struct EpiLnResLn {
    static constexpr bool PERM = false, AFTER_DRAIN = true;
    const float* base; float* out; bf16_t* xn; int ldc; const float* bias; PanelStats st1, st2; unsigned poison;
    __device__ __forceinline__ void refuse(size_t i0, size_t stride, int M, int N) const { const float q = __builtin_nanf(""); for (size_t i = i0; i < (size_t)M * N; i += stride) { const size_t o = (i / N) * ldc + i % N; out[o] = q; xn[o] = (bf16_t)0x7fc0u; }
        if (i0 == 0) { unsigned expect = 0u; __hip_atomic_compare_exchange_strong(st1.tmo + 1, &expect, 0x7f0u, __ATOMIC_RELAXED, __ATOMIC_RELAXED, __HIP_MEMORY_SCOPE_AGENT); __hip_atomic_store(st1.tmo, 1u, __ATOMIC_RELAXED, __HIP_MEMORY_SCOPE_AGENT); } }
    __device__ __forceinline__ void fused(f32x4 (&acc)[2][2][4][2], const Unit& u, int wr, int wc, int fr, int fq, PG8_LAS unsigned char* lds, int wid, int lane) const {
        typedef float f32x2v __attribute__((ext_vector_type(2))); typedef unsigned u32x2v __attribute__((ext_vector_type(2)));
        const PG8_LAS f32x2v* S = (const PG8_LAS f32x2v*)(lds + 8192);
        const int col0 = u.pn * BM + wc * 32 + 4 * fq;
#pragma unroll
        for (int bj = 0; bj < 2; ++bj)
#pragma unroll
            for (int n = 0; n < 2; ++n) { const f32x4 bv = bias ? *(const f32x4*)(bias + col0 + bj * HALF + n * 16) : (f32x4){0.f, 0.f, 0.f, 0.f};
#pragma unroll
                for (int ai = 0; ai < 2; ++ai)
#pragma unroll
                    for (int m = 0; m < 4; ++m) acc[ai][bj][m][n] += bv; }
        bool bad = st1.run(acc, u, wr, wc, fr, fq, lds, wid, lane) || poison != 0u;
        const float qnan = __builtin_nanf("");
#pragma unroll
        for (int ai = 0; ai < 2; ++ai)
#pragma unroll
            for (int m = 0; m < 4; ++m) { const int r = ai * HALF + wr * 64 + m * 16 + fr; const f32x2v sr = S[r]; const size_t off = (size_t)(u.pm * BM + r) * ldc + col0;
#pragma unroll
                for (int bj = 0; bj < 2; ++bj)
#pragma unroll
                    for (int n = 0; n < 2; ++n) { const f32x4 bs = *(const f32x4*)(base + off + bj * HALF + n * 16); acc[ai][bj][m][n] = bs + (acc[ai][bj][m][n] - sr.x) * sr.y; }
                asm volatile("" : "+v"(acc[ai][0][m][0]), "+v"(acc[ai][0][m][1]), "+v"(acc[ai][1][m][0]), "+v"(acc[ai][1][m][1]));
                if (m & 1) asm volatile("" ::: "memory"); }
        const bool bad1 = bad;
        bad = st2.run(acc, u, wr, wc, fr, fq, lds, wid, lane) || bad;
#pragma unroll
        for (int ai = 0; ai < 2; ++ai)
#pragma unroll
            for (int m = 0; m < 4; ++m) { const int r = ai * HALF + wr * 64 + m * 16 + fr; const f32x2v sr = S[r]; const size_t off = (size_t)(u.pm * BM + r) * ldc + col0;
#pragma unroll
                for (int bj = 0; bj < 2; ++bj)
#pragma unroll
                    for (int n = 0; n < 2; ++n) { const f32x4 x1 = acc[ai][bj][m][n]; *(f32x4*)(out + off + bj * HALF + n * 16) = bad1 ? (f32x4){qnan, qnan, qnan, qnan} : x1;
                        const f32x4 o = (x1 - sr.x) * sr.y; u32x2v w; w.x = cvt_pk_bf16(o[0], o[1]); w.y = cvt_pk_bf16(o[2], o[3]);
                        if (bad) { w.x = 0x7fc07fc0u; w.y = 0x7fc07fc0u; } *(u32x2v*)(xn + off + bj * HALF + n * 16) = w; }
                asm volatile("" ::: "memory"); }
    }
};

template <class Epi, class Sched, bool STAMP = false>
__device__ __forceinline__ void gemm_phase(PG8_LAS unsigned char* lds, const Gemm g, const Sched& S, const Epi& E, unsigned long long* stamps) {
    const int tid = threadIdx.x, wid = __builtin_amdgcn_readfirstlane(tid >> 6), lane = tid & 63, wr = wid >> 2, wc = wid & 3, fr = lane & 15, fq = lane >> 4;
    const int K = g.K, nt = K / BK;
    int ts_lo = 0, ts_hi = 0, nts = 0; const unsigned long long rt_entry = STAMP ? (unsigned long long)wall_clock64() : 0ull;
#define PG8_STAMP() do { if (STAMP && wid == 0 && nts < 64) { const unsigned long long _c = (unsigned long long)clock64(); \
        ts_lo = (lane == nts) ? (int)(unsigned)_c : ts_lo; ts_hi = (lane == nts) ? (int)(unsigned)(_c >> 32) : ts_hi; ++nts; } } while (0)
    PG8_STAMP();
    unsigned voffA[2], voffB[2];
#pragma unroll
    for (int i = 0; i < 2; ++i) { int R, C; stage_rc(tid * 16 + i * 8192, R, C); const int Rb = Epi::PERM ? ((R & ~31) + perm32(R & 31)) : R;
        voffA[i] = (unsigned)(R * K + C) * 2u; voffB[i] = (unsigned)(Rb * K + C) * 2u; }
    const size_t kstep = (size_t)(BK * 2);
    const size_t hstep = (size_t)HALF * K * 2;
    const size_t tstep = 2 * hstep;
    const unsigned ldsw = (unsigned)wid * 1024u;
    const int aoff = lds_byte(wr * 64 + fr, fq * 8), boff = lds_byte(wc * 32 + fr, fq * 8);
#define PG8_SA(b, h) (((b) * 2 + (h)) * HTB)
#define PG8_SB(b, h) ((4 + (b) * 2 + (h)) * HTB)
#define PG8_STAGE(bufoff, gbase, voff) do { _Pragma("unroll") for (int _i = 0; _i < 2; ++_i) \
        __builtin_amdgcn_global_load_lds((const unsigned*)((const char*)(gbase) + (voff)[_i]), (PG8_LAS unsigned*)(lds + (bufoff) + ldsw + _i * 8192), 16, 0, 0); } while (0)
#define PG8_LDA(dst, b, h) do { _Pragma("unroll") for (int m = 0; m < 4; ++m) _Pragma("unroll") for (int k = 0; k < 2; ++k) dst[m][k] = *(const PG8_LAS bf16x8*)(lds + PG8_SA(b, h) + aoff + m * 2048 + k * 1024); } while (0)
#define PG8_LDB(dst, b, h) do { _Pragma("unroll") for (int n = 0; n < 2; ++n) _Pragma("unroll") for (int k = 0; k < 2; ++k) dst[n][k] = *(const PG8_LAS bf16x8*)(lds + PG8_SB(b, h) + boff + n * 2048 + k * 1024); } while (0)
#define PG8_MMA(ai, bj, At, Bt) do { __builtin_amdgcn_s_setprio(1); _Pragma("unroll") for (int m = 0; m < 4; ++m) _Pragma("unroll") for (int n = 0; n < 2; ++n) _Pragma("unroll") for (int k = 0; k < 2; ++k) \
        acc[ai][bj][m][n] = __builtin_amdgcn_mfma_f32_16x16x32_bf16(Bt[n][k], At[m][k], acc[ai][bj][m][n], 0, 0, 0); __builtin_amdgcn_s_setprio(0); } while (0)
#define PG8_WAIT_V(n) asm volatile("s_waitcnt vmcnt(" #n ")" ::: "memory")
#define PG8_WAIT_L(n) asm volatile("s_waitcnt lgkmcnt(" #n ")" ::: "memory")
#define PG8_BAR __builtin_amdgcn_s_barrier()
#define PG8_SCHED __builtin_amdgcn_sched_barrier(0)
    Unit cur, nxt; int ui = 0;
    if (!S.next(0, cur)) return;
    f32x4 acc[2][2][4][2];
#pragma unroll
    for (int a = 0; a < 2; ++a)
#pragma unroll
        for (int b = 0; b < 2; ++b)
#pragma unroll
            for (int m = 0; m < 4; ++m)
#pragma unroll
                for (int n = 0; n < 2; ++n) acc[a][b][m][n] = (f32x4){0.f, 0.f, 0.f, 0.f};
    bf16x8 At[4][2], B0[2][2], B1[2][2];
    const char* cA = (const char*)g.A + (size_t)cur.pm * tstep; const char* cB = (const char*)g.Bt + (size_t)cur.pn * tstep;
    S.a_ready(cur);
    PG8_STAGE(PG8_SB(0, 0), cB, voffB); PG8_STAGE(PG8_SA(0, 0), cA, voffA); PG8_STAGE(PG8_SB(0, 1), cB + hstep, voffB); PG8_STAGE(PG8_SA(0, 1), cA + hstep, voffA);
    if (wr == 1) PG8_BAR;
    PG8_WAIT_V(4); PG8_BAR;
    PG8_STAGE(PG8_SB(1, 0), cB + kstep, voffB); PG8_STAGE(PG8_SA(1, 0), cA + kstep, voffA); PG8_STAGE(PG8_SB(1, 1), cB + hstep + kstep, voffB);
    PG8_WAIT_V(6); PG8_BAR;
    PG8_STAMP();
    for (;;) {
        const bool has_next = S.next(ui + 1, nxt);
        const char* nA = has_next ? (const char*)g.A + (size_t)nxt.pm * tstep : cA; const char* nB = has_next ? (const char*)g.Bt + (size_t)nxt.pn * tstep : cB;
        for (int t = 0; t < nt; t += 2) {
            const bool last = (t == nt - 2);
            const char* a1 = cA + (size_t)(t + 1) * kstep;
            const char* a2 = last ? nA : cA + (size_t)(t + 2) * kstep; const char* b2 = last ? nB : cB + (size_t)(t + 2) * kstep;
            const char* a3 = a2 + kstep; const char* b3 = b2 + kstep;
            if (last && has_next) S.a_ready(nxt);
            PG8_LDB(B0, 0, 0); PG8_SCHED; PG8_LDA(At, 0, 0); PG8_STAGE(PG8_SA(1, 1), a1 + hstep, voffA);
            PG8_WAIT_L(8); PG8_BAR; PG8_WAIT_L(0); PG8_MMA(0, 0, At, B0); PG8_BAR; PG8_SCHED;
            PG8_LDB(B1, 0, 1); PG8_STAGE(PG8_SB(0, 0), b2, voffB);
            PG8_BAR; PG8_WAIT_L(0); PG8_MMA(0, 1, At, B1); PG8_BAR;
            PG8_LDA(At, 0, 1); PG8_STAGE(PG8_SA(0, 0), a2, voffA);
            PG8_BAR; PG8_WAIT_L(0); PG8_MMA(1, 0, At, B0); PG8_BAR; PG8_SCHED;
            PG8_STAGE(PG8_SB(0, 1), b2 + hstep, voffB);
            PG8_WAIT_V(6); PG8_BAR; PG8_MMA(1, 1, At, B1); PG8_BAR;
            PG8_LDB(B0, 1, 0); PG8_SCHED; PG8_LDA(At, 1, 0); PG8_STAGE(PG8_SA(0, 1), a2 + hstep, voffA);
            PG8_WAIT_L(8); PG8_BAR; PG8_WAIT_L(0); PG8_MMA(0, 0, At, B0); PG8_BAR; PG8_SCHED;
            PG8_LDB(B1, 1, 1); PG8_STAGE(PG8_SB(1, 0), b3, voffB);
            PG8_BAR; PG8_WAIT_L(0); PG8_MMA(0, 1, At, B1); PG8_BAR;
            PG8_LDA(At, 1, 1); PG8_STAGE(PG8_SA(1, 0), a3, voffA);
            PG8_BAR; PG8_WAIT_L(0); PG8_MMA(1, 0, At, B0); PG8_BAR; PG8_SCHED;
            PG8_STAGE(PG8_SB(1, 1), b3 + hstep, voffB);
            PG8_WAIT_V(6); PG8_BAR; PG8_MMA(1, 1, At, B1); PG8_BAR;
        }
        PG8_STAMP();
        if constexpr (!Epi::AFTER_DRAIN) { E(acc, cur, wr, wc, fr, fq); S.done(cur); }
        PG8_STAMP();
        if (!has_next) break;
#pragma unroll
        for (int a = 0; a < 2; ++a)
#pragma unroll
            for (int b = 0; b < 2; ++b)
#pragma unroll
                for (int m = 0; m < 4; ++m)
#pragma unroll
                    for (int n = 0; n < 2; ++n) acc[a][b][m][n] = (f32x4){0.f, 0.f, 0.f, 0.f};
        cur = nxt; cA = nA; cB = nB; ++ui;
    }
    PG8_WAIT_V(0);
    if (wr == 0) PG8_BAR;
    PG8_BAR;
    if constexpr (Epi::AFTER_DRAIN) { E.fused(acc, cur, wr, wc, fr, fq, lds, wid, lane); S.done(cur); }
    PG8_STAMP();
    if (STAMP && wid == 0) { stamps[lane] = lane < nts ? (((unsigned long long)(unsigned)ts_hi << 32) | (unsigned)ts_lo) : 0ull;
        if (lane == 62) stamps[62] = rt_entry; if (lane == 63) stamps[63] = (unsigned long long)wall_clock64(); }
#undef PG8_STAMP
#undef PG8_SA
#undef PG8_SB
#undef PG8_STAGE
#undef PG8_LDA
#undef PG8_LDB
#undef PG8_MMA
#undef PG8_WAIT_V
#undef PG8_WAIT_L
#undef PG8_BAR
#undef PG8_SCHED
}
}
#define HD __host__ __device__ __forceinline__
#define HY_LDS __attribute__((address_space(3)))
#ifndef HY_F2_STRUCT
typedef float f2 __attribute__((ext_vector_type(2)));
#else
struct __attribute__((aligned(8))) f2 { float x, y; };
#ifndef HD
#define HD __host__ __device__ __forceinline__
#endif
HD f2 operator+(f2 a, f2 b) { return f2{a.x + b.x, a.y + b.y}; }
HD f2 operator-(f2 a, f2 b) { return f2{a.x - b.x, a.y - b.y}; }
HD f2 operator*(f2 a, float b) { return f2{a.x * b, a.y * b}; }
#endif
#ifndef HD
#define HD __host__ __device__ __forceinline__
#endif
#ifndef HY_LDS
#define HY_LDS
#endif
typedef HY_LDS f2* hy_ldsp;
typedef const HY_LDS f2* hy_cldsp;
#if defined(__HIP_DEVICE_COMPILE__)
#define HY_OPAQUE(v) asm volatile("" : "+v"(v))
#else
#define HY_OPAQUE(v) asm volatile("" : "+r"(v))
#endif
namespace hy {
constexpr int FL = 16384;
constexpr int LDS_F2 = 32 * 560;
HD int laddr(int d2, int d1, int d0) { return d2 * 560 + d1 * 17 + d0; }
HD f2 cmul(f2 a, f2 b) { return (f2){a.x * b.x - a.y * b.y, a.x * b.y + a.y * b.x}; }
HD f2 cconj(f2 a) { return (f2){a.x, -a.y}; }
constexpr float C32[32] = { 1.0f, 0.98078528040323044913f, 0.92387953251128675613f, 0.83146961230254523708f, 0.70710678118654752440f, 0.55557023301960222474f, 0.38268343236508977173f, 0.19509032201612826785f,
                            0.0f, -0.19509032201612826785f, -0.38268343236508977173f, -0.55557023301960222474f, -0.70710678118654752440f, -0.83146961230254523708f, -0.92387953251128675613f, -0.98078528040323044913f,
                           -1.0f, -0.98078528040323044913f, -0.92387953251128675613f, -0.83146961230254523708f, -0.70710678118654752440f, -0.55557023301960222474f, -0.38268343236508977173f, -0.19509032201612826785f,
                            0.0f, 0.19509032201612826785f, 0.38268343236508977173f, 0.55557023301960222474f, 0.70710678118654752440f, 0.83146961230254523708f, 0.92387953251128675613f, 0.98078528040323044913f };
constexpr float S32[32] = { 0.0f, 0.19509032201612826785f, 0.38268343236508977173f, 0.55557023301960222474f, 0.70710678118654752440f, 0.83146961230254523708f, 0.92387953251128675613f, 0.98078528040323044913f,
                            1.0f, 0.98078528040323044913f, 0.92387953251128675613f, 0.83146961230254523708f, 0.70710678118654752440f, 0.55557023301960222474f, 0.38268343236508977173f, 0.19509032201612826785f,
                            0.0f, -0.19509032201612826785f, -0.38268343236508977173f, -0.55557023301960222474f, -0.70710678118654752440f, -0.83146961230254523708f, -0.92387953251128675613f, -0.98078528040323044913f,
                           -1.0f, -0.98078528040323044913f, -0.92387953251128675613f, -0.83146961230254523708f, -0.70710678118654752440f, -0.55557023301960222474f, -0.38268343236508977173f, -0.19509032201612826785f };
template <int BITS> HD constexpr int brev(int k) { int r = 0; for (int i = 0; i < BITS; ++i) r |= ((k >> i) & 1) << (BITS - 1 - i); return r; }
template <bool INV> HD f2 twmul32(f2 d, int k) {
    k &= 31;
    if (k == 0) return d;
    if (k == 8) return INV ? (f2){-d.y, d.x} : (f2){d.y, -d.x};
    if (k == 16) return (f2){-d.x, -d.y};
    if (k == 24) return INV ? (f2){d.y, -d.x} : (f2){-d.y, d.x};
    const float c = C32[k], s = INV ? S32[k] : -S32[k];
    return (f2){d.x * c - d.y * s, d.x * s + d.y * c};
}
template <int N, int SPAN, bool INV> struct DifStage {
    static HD void run(f2 (&v)[N]) {
#pragma unroll
        for (int blk = 0; blk < N; blk += 2 * SPAN)
#pragma unroll
            for (int j = 0; j < SPAN; ++j) {
                const f2 a = v[blk + j], b = v[blk + j + SPAN];
                v[blk + j] = a + b;
                v[blk + j + SPAN] = twmul32<INV>(a - b, j * (16 / SPAN));
            }
        DifStage<N, SPAN / 2, INV>::run(v);
    }
};
template <int N, bool INV> struct DifStage<N, 0, INV> { static HD void run(f2 (&)[N]) {} };
template <int N, bool INV> HD void dft_inreg(f2 (&v)[N]) { DifStage<N, N / 2, INV>::run(v); }

HD f2 cis_rev(float rev) {
#if defined(__HIP_DEVICE_COMPILE__)
    return (f2){__builtin_amdgcn_cosf(rev), __builtin_amdgcn_sinf(rev)};
#else
    return (f2){(float)cos(6.283185307179586476925 * (double)rev), (float)sin(6.283185307179586476925 * (double)rev)};
#endif
}
#define HY_CHAIN_DECL(b0, s) f2 _c0 = (b0), _c1 = hy::cmul(_c0, (s)), _s2 = hy::cmul((s), (s)), _c2 = hy::cmul(_c0, _s2), _c3 = hy::cmul(_c1, _s2), _s4 = hy::cmul(_s2, _s2)

template <bool INV_UNUSED = false> HD void fwd_p1(f2 (&x)[32], int t, hy_ldsp lds) {
    HY_OPAQUE(t);
    dft_inreg<32, false>(x);
    const f2 w1 = cis_rev(-(float)t * (1.0f / 16384.0f));
    HY_CHAIN_DECL(((f2){1.0f, 0.0f}), w1);
    const int base = laddr(0, t >> 4, t & 15);
#pragma unroll
    for (int q = 0; q < 8; ++q) {
        lds[base + (4 * q + 0) * 560] = cmul(x[brev<5>(4 * q + 0)], _c0);
        lds[base + (4 * q + 1) * 560] = cmul(x[brev<5>(4 * q + 1)], _c1);
        lds[base + (4 * q + 2) * 560] = cmul(x[brev<5>(4 * q + 2)], _c2);
        lds[base + (4 * q + 3) * 560] = cmul(x[brev<5>(4 * q + 3)], _c3);
        _c0 = cmul(_c0, _s4); _c1 = cmul(_c1, _s4); _c2 = cmul(_c2, _s4); _c3 = cmul(_c3, _s4);
    }
}
HD void fwd_p2(int t, hy_ldsp lds) {
    HY_OPAQUE(t);
    f2 x[32];
    const int d2 = t >> 4, d0 = t & 15, base = laddr(d2, 0, d0);
#pragma unroll
    for (int j = 0; j < 32; ++j) x[j] = lds[base + j * 17];
    dft_inreg<32, false>(x);
    const f2 w1 = cis_rev(-(float)d0 * (1.0f / 512.0f));
    HY_CHAIN_DECL(((f2){1.0f, 0.0f}), w1);
#pragma unroll
    for (int q = 0; q < 8; ++q) {
        lds[base + (4 * q + 0) * 17] = cmul(x[brev<5>(4 * q + 0)], _c0);
        lds[base + (4 * q + 1) * 17] = cmul(x[brev<5>(4 * q + 1)], _c1);
        lds[base + (4 * q + 2) * 17] = cmul(x[brev<5>(4 * q + 2)], _c2);
        lds[base + (4 * q + 3) * 17] = cmul(x[brev<5>(4 * q + 3)], _c3);
        _c0 = cmul(_c0, _s4); _c1 = cmul(_c1, _s4); _c2 = cmul(_c2, _s4); _c3 = cmul(_c3, _s4);
    }
}
HD void fwd_p3(f2 (&s)[2][16], int t, hy_cldsp lds) {
#pragma unroll
    for (int h = 0; h < 2; ++h) {
        const int R = t + 512 * h, base = laddr(R >> 5, R & 31, 0);
#pragma unroll
        for (int j = 0; j < 16; ++j) s[h][j] = lds[base + j];
        dft_inreg<16, false>(s[h]);
    }
}
HD void inv_p1(f2 (&s)[2][16], int t, hy_ldsp lds) {
    HY_OPAQUE(t);
#pragma unroll
    for (int h = 0; h < 2; ++h) {
        const int R = t + 512 * h, d1 = R & 31, base = laddr(R >> 5, d1, 0);
        f2 y[16];
#pragma unroll
        for (int k = 0; k < 16; ++k) y[k] = s[h][brev<4>(k)];
        dft_inreg<16, true>(y);
        const f2 w1 = cis_rev((float)d1 * (1.0f / 512.0f));
        HY_CHAIN_DECL(((f2){1.0f, 0.0f}), w1);
#pragma unroll
        for (int q = 0; q < 4; ++q) {
            lds[base + 4 * q + 0] = cmul(y[brev<4>(4 * q + 0)], _c0);
            lds[base + 4 * q + 1] = cmul(y[brev<4>(4 * q + 1)], _c1);
            lds[base + 4 * q + 2] = cmul(y[brev<4>(4 * q + 2)], _c2);
            lds[base + 4 * q + 3] = cmul(y[brev<4>(4 * q + 3)], _c3);
            _c0 = cmul(_c0, _s4); _c1 = cmul(_c1, _s4); _c2 = cmul(_c2, _s4); _c3 = cmul(_c3, _s4);
        }
    }
}
HD void inv_p2(int t, hy_ldsp lds) {
    HY_OPAQUE(t);
    f2 x[32];
    const int d2 = t >> 4, d0 = t & 15, base = laddr(d2, 0, d0);
#pragma unroll
    for (int j = 0; j < 32; ++j) x[j] = lds[base + j * 17];
    dft_inreg<32, true>(x);
    const f2 b0 = cis_rev((float)(d0 * d2) * (1.0f / 16384.0f)), st = cis_rev((float)d2 * (1.0f / 1024.0f));
    HY_CHAIN_DECL(b0, st);
#pragma unroll
    for (int q = 0; q < 8; ++q) {
        lds[base + (4 * q + 0) * 17] = cmul(x[brev<5>(4 * q + 0)], _c0);
        lds[base + (4 * q + 1) * 17] = cmul(x[brev<5>(4 * q + 1)], _c1);
        lds[base + (4 * q + 2) * 17] = cmul(x[brev<5>(4 * q + 2)], _c2);
        lds[base + (4 * q + 3) * 17] = cmul(x[brev<5>(4 * q + 3)], _c3);
        _c0 = cmul(_c0, _s4); _c1 = cmul(_c1, _s4); _c2 = cmul(_c2, _s4); _c3 = cmul(_c3, _s4);
    }
}
HD void inv_p3(f2 (&x)[32], int t, hy_cldsp lds) {
    f2 y[32];
    const int base = laddr(0, t >> 4, t & 15);
#pragma unroll
    for (int j = 0; j < 32; ++j) y[j] = lds[base + j * 560];
    dft_inreg<32, true>(y);
#pragma unroll
    for (int j = 0; j < 32; ++j) x[j] = y[brev<5>(j)];
}
}
#define HY_FENCE() asm volatile("" ::: "memory")
namespace hy {
typedef unsigned short bf16_t;
HD float bf2f(bf16_t v) { return __builtin_bit_cast(float, ((unsigned)v) << 16); }
HD bf16_t f2bf(float f) { unsigned u = __builtin_bit_cast(unsigned, f); return (bf16_t)((u + 0x7fffu + ((u >> 16) & 1u)) >> 16); }
constexpr int SEQ = 16384, NTOK = 2 * SEQ;
struct JobArgs {
    const bf16_t* ch;
    const bf16_t* kt;
    const float* conv_w;
    const float* conv_b;
    const float* hbias;
    f2* sbase;
    bf16_t* yh;
};
#if defined(__HIP_DEVICE_COMPILE__)
typedef unsigned hy_u2 __attribute__((ext_vector_type(2)));
struct Stash { __amdgpu_buffer_rsrc_t r; };
__device__ __forceinline__ Stash make_stash(const JobArgs& J) { Stash s; s.r = __builtin_amdgcn_make_buffer_rsrc(J.sbase, (short)0, 393216, 0x00020000); return s; }
__device__ __forceinline__ f2 st_load(const Stash& s, int r, int j, int t) { const hy_u2 v = __builtin_amdgcn_raw_buffer_load_b64(s.r, t * 8, r * 131072 + j * 4096, 0); return __builtin_bit_cast(f2, v); }
__device__ __forceinline__ void st_store(const Stash& s, int r, int j, int t, f2 v) { __builtin_amdgcn_raw_buffer_store_b64(__builtin_bit_cast(hy_u2, v), s.r, t * 8, r * 131072 + j * 4096, 0); }
#else
struct Stash { f2* p; };
inline Stash make_stash(const JobArgs& J) { return Stash{J.sbase}; }
inline f2 st_load(const Stash& s, int r, int j, int t) { return s.p[r * 16384 + j * 512 + t]; }
inline void st_store(const Stash& s, int r, int j, int t, f2 v) { s.p[r * 16384 + j * 512 + t] = v; }
#endif
HD void twist_consts(bool tw, int t, f2& base, f2& step) {
    HY_OPAQUE(t);
    if (tw) { base = cis_rev(-(float)t * (1.0f / 32768.0f)); step = (f2){0.99518472667219688624f, -0.09801714032956060199f}; }
    else { base = (f2){1.0f, 0.0f}; step = (f2){1.0f, 0.0f}; }
}
template <bool FIRST, bool LAST> HD float sconv(const bf16_t* pj, int t, float w0, float w1, float w2, float cb) {
    const float pm = (!FIRST || t > 0) ? bf2f(pj[t - 1]) : 0.0f, pc = bf2f(pj[t]), pp = (!LAST || t < 511) ? bf2f(pj[t + 1]) : 0.0f;
    return cb + w0 * pm + w1 * pc + w2 * pp;
}
#define HY_SCONV(j, p, t, w0, w1, w2, cb) ((j) == 0 ? hy::sconv<true, false>((p) + (j) * 512, t, w0, w1, w2, cb) : (j) == 31 ? hy::sconv<false, true>((p) + (j) * 512, t, w0, w1, w2, cb) : hy::sconv<false, false>((p) + (j) * 512, t, w0, w1, w2, cb))
HD void seg_filter_p1(const JobArgs& J, int c, int o, bool tw, int t, hy_ldsp lds) {
    HY_OPAQUE(t); HY_OPAQUE(c);
    f2 x[32];
    const bf16_t* kf = J.kt + (size_t)((o * 2 + 0) * 512 + c) * SEQ;
    const bf16_t* kr = J.kt + (size_t)((o * 2 + 1) * 512 + c) * SEQ;
    const float sgn = tw ? -1.0f : 1.0f, bias = J.hbias[o * 512 + c];
    f2 base, step; twist_consts(tw, t, base, step);
    f2 cur = base;
#pragma unroll
    for (int j = 0; j < 32; ++j) {
        const int n = j * 512 + t;
        float a = bf2f(kf[n]) + sgn * bf2f(kr[SEQ - 1 - n]);
        if (n == 0) a += bias;
        a *= (1.0f / 32768.0f);
        x[j] = cur * a;
        cur = cmul(cur, step);
        if ((j & 7) == 7) HY_FENCE();
    }
    fwd_p1(x, t, lds);
}
HD void seg_prep(const JobArgs& J, const Stash& S, int c, int t) {
    HY_OPAQUE(t); HY_OPAQUE(c);
    const bf16_t* p0 = J.ch + (size_t)c * NTOK; const bf16_t* p1 = p0 + SEQ;
    const float w0 = J.conv_w[c], w1 = J.conv_w[1536 + c], w2 = J.conv_w[3072 + c], cb = J.conv_b[c];
#pragma unroll
    for (int j = 0; j < 32; ++j) {
        st_store(S, 1, j, t, (f2){HY_SCONV(j, p0, t, w0, w1, w2, cb), HY_SCONV(j, p1, t, w0, w1, w2, cb)});
        if ((j & 3) == 3) HY_FENCE();
    }
}
HD void seg_data_p1(const Stash& S, bool tw, int t, hy_ldsp lds) {
    HY_OPAQUE(t);
    f2 x[32];
    f2 base, step; twist_consts(tw, t, base, step);
    f2 cur = base;
#pragma unroll
    for (int j = 0; j < 32; ++j) { const f2 z = st_load(S, 1, j, t); x[j] = cmul(z, cur); cur = cmul(cur, step); if ((j & 7) == 7) HY_FENCE(); }
    fwd_p1(x, t, lds);
}
HD void seg_filter_p3(const Stash& S, int t, hy_cldsp lds) {
    f2 K[2][16];
    fwd_p3(K, t, lds);
#pragma unroll
    for (int h = 0; h < 2; ++h)
#pragma unroll
        for (int i = 0; i < 16; ++i) st_store(S, 2, h * 16 + i, t, K[h][i]);
    HY_FENCE();
}
HD void seg_mul(const Stash& S, int t, hy_ldsp lds) {
    f2 s[2][16];
    fwd_p3(s, t, lds);
#pragma unroll
    for (int h = 0; h < 2; ++h) {
#pragma unroll
        for (int i = 0; i < 16; ++i) s[h][i] = cmul(s[h][i], st_load(S, 2, h * 16 + i, t));
        HY_FENCE();
    }
    inv_p1(s, t, lds);
}
HD void seg_out(const JobArgs& J, const Stash& S, int c, int o, bool tw, int t, hy_cldsp lds) {
    HY_OPAQUE(t); HY_OPAQUE(c);
    f2 x[32];
    inv_p3(x, t, lds);
    if (!tw) {
#pragma unroll
        for (int j = 0; j < 32; ++j) st_store(S, 0, j, t, x[j]);
        HY_FENCE();
        return;
    }
    f2 base, step; twist_consts(true, t, base, step);
    f2 cur = cconj(base); const f2 stc = cconj(step);
    const int row = (o == 0 ? 512 : 1024) + c;
    const bf16_t* p0 = J.ch + (size_t)row * NTOK; const bf16_t* p1 = p0 + SEQ;
    const float w0 = J.conv_w[row], w1 = J.conv_w[1536 + row], w2 = J.conv_w[3072 + row], cb = J.conv_b[row];
    const bf16_t* g0 = J.ch + (size_t)(1536 + c) * NTOK; const bf16_t* g1 = g0 + SEQ;
#pragma unroll
    for (int j = 0; j < 32; ++j) {
        const int n = j * 512 + t;
        const f2 r = cmul(x[j], cur) + st_load(S, 0, j, t); cur = cmul(cur, stc);
        const float a0 = HY_SCONV(j, p0, t, w0, w1, w2, cb) * r.x, a1 = HY_SCONV(j, p1, t, w0, w1, w2, cb) * r.y;
        if (o == 0) st_store(S, 1, j, t, (f2){a0, a1});
        else {
            const float q0 = bf2f(g0[n]), q1 = bf2f(g1[n]);
            bf16_t* y = J.yh + (size_t)c * NTOK;
            y[n] = f2bf(a0 * q0 / (1.0f + __builtin_expf(-q0)));
            y[SEQ + n] = f2bf(a1 * q1 / (1.0f + __builtin_expf(-q1)));
        }
        if ((j & 3) == 3) HY_FENCE();
    }
}
}
#define LAS __attribute__((address_space(3)))
#define GAS __attribute__((address_space(1)))
typedef unsigned short bf16;
typedef unsigned u32x4v __attribute__((ext_vector_type(4)));
typedef float f32x4v __attribute__((ext_vector_type(4)));

#ifndef MK_N_LAUNCHES
#define MK_N_LAUNCHES 1
#endif
constexpr int N_PHASES = 7;
constexpr int NT = 512;
constexpr int DM = 1024, SEQ = 16384, NB = 2, NTOK = NB * SEQ, DINP = 3072, DH = 512;
constexpr float LN_EPS = 1e-5f, DN_ALPHA = 1.18920711500272106672f;
constexpr size_t MiB = 1u << 20;
constexpr size_t WS_CTL = 0, CTL_BYTES = 1 * MiB;
constexpr size_t WS_MOD = WS_CTL + CTL_BYTES;
constexpr size_t WS_WINT = WS_MOD + 1 * MiB;
constexpr size_t WS_WOUTT = WS_WINT + 6 * MiB;
constexpr size_t WS_PWT = WS_WOUTT + 2 * MiB;
constexpr size_t WS_FWT = WS_PWT + 1 * MiB;
constexpr size_t WS_H3 = WS_FWT + 1 * MiB;
constexpr size_t WS_U = WS_H3 + 8 * MiB;
constexpr size_t WS_KT = WS_U + 64 * MiB;
constexpr size_t WS_CH = WS_KT + 64 * MiB;
constexpr size_t WS_TP = WS_CH + 128 * MiB;
constexpr size_t WS_PP = WS_TP + 64 * MiB;
constexpr size_t WS_YH = WS_PP + 32 * MiB;
constexpr size_t WS_ST = WS_YH + 32 * MiB;
constexpr size_t WS_END = WS_ST + 96 * MiB;
constexpr size_t WS_Y = WS_U;
constexpr int LDS_MISC = 143360;
constexpr int LDS_BYTES = LDS_MISC + 256;

#define XB_TMO      128
#define XB_XCNT(j)  (256  + 64 * (j))
#define XB_XSUB(j)  (1280 + 64 * (j))
#define XB_XGEN(j)  (2304 + 64 * (j))
#define XB_TOP      3328
#define XB_TOPGEN   3392
#define XCD_BAR_WORDS 3456
#define XB_SPIN_CAP (1u << 18)
__device__ __forceinline__ unsigned xb_ld(unsigned* p)              { return __hip_atomic_load(p, __ATOMIC_RELAXED, __HIP_MEMORY_SCOPE_AGENT); }
__device__ __forceinline__ unsigned xb_add(unsigned* p, unsigned v) { return __hip_atomic_fetch_add(p, v, __ATOMIC_RELAXED, __HIP_MEMORY_SCOPE_AGENT); }
__device__ __forceinline__ unsigned xb_xcc_id() { return (unsigned)__builtin_amdgcn_s_getreg((3 << 11) | 20) & 0xFu; }
#define XB_SPIN(cond, bar) do { unsigned _sp = 0; while (cond) { __builtin_amdgcn_s_sleep(1); \
    if ((++_sp & 255u) == 0u) { if (xb_ld(&(bar)[XB_TMO])) break; if (_sp > XB_SPIN_CAP) { atomicAdd(&(bar)[XB_TMO], 1u); break; } } } } while (0)
struct XcdBarrier { unsigned* bar; unsigned x; volatile LAS unsigned* st; };
__device__ __forceinline__ XcdBarrier xcd_barrier_post(unsigned* bar, volatile LAS unsigned* st) {
    XcdBarrier b; b.bar = bar; b.x = xb_xcc_id(); b.st = st;
    if (threadIdx.x == 0) (void)xb_add(&bar[XB_XCNT(b.x)], 1u);
    return b;
}
__device__ __forceinline__ void xcd_barrier_complete(unsigned* bar, unsigned x, unsigned& nloc, unsigned& nx) {
    const unsigned G = gridDim.x * gridDim.y * gridDim.z;
    unsigned sum, cnt, mine, sp = 0u;
    for (;;) {
        sum = 0u; cnt = 0u; mine = 0u;
#pragma unroll
        for (unsigned j = 0; j < 16; ++j) { const unsigned c = xb_ld(&bar[XB_XCNT(j)]); sum += c; cnt += (c > 0u) ? 1u : 0u; mine = (j == x) ? c : mine; }
        if (sum == G) break;
        __builtin_amdgcn_s_sleep(1);
        if ((++sp & 255u) == 0u) { if (xb_ld(&bar[XB_TMO])) break; if (sp > XB_SPIN_CAP) { atomicAdd(&bar[XB_TMO], 1u); break; } }
    }
    nloc = mine > 0u ? mine : 1u; nx = cnt > 0u ? cnt : 1u;
}
__device__ __forceinline__ void xcd_barrier(const XcdBarrier& b) {
    asm volatile("s_waitcnt vmcnt(0)" ::: "memory");
    __syncthreads();
    if (threadIdx.x == 0) {
        unsigned* bar = b.bar;
        __builtin_amdgcn_s_waitcnt(0);
        unsigned nloc = b.st[0], nx = b.st[1];
        if (nloc == 0u) { xcd_barrier_complete(bar, b.x, nloc, nx); b.st[0] = nloc; b.st[1] = nx; }
        const unsigned old = xb_add(&bar[XB_XSUB(b.x)], 1u);
        const unsigned gen = old / nloc;
        if (old + 1u == (gen + 1u) * nloc) {
            __builtin_amdgcn_fence(__ATOMIC_RELEASE, "agent");
            asm volatile("s_waitcnt vmcnt(0)" ::: "memory");
            const unsigned og = xb_add(&bar[XB_TOP], 1u);
            const unsigned tg = og / nx;
            if (og + 1u == (tg + 1u) * nx) xb_add(&bar[XB_TOPGEN], 1u);
            else XB_SPIN(xb_ld(&bar[XB_TOPGEN]) == tg, bar);
            __builtin_amdgcn_fence(__ATOMIC_ACQUIRE, "agent");
            xb_add(&bar[XB_XGEN(b.x)], 1u);
            asm volatile("s_waitcnt vmcnt(0)" ::: "memory");
        } else {
            XB_SPIN(xb_ld(&bar[XB_XGEN(b.x)]) == gen, bar);
            __builtin_amdgcn_fence(__ATOMIC_ACQUIRE, "agent");
            asm volatile("s_waitcnt vmcnt(0)" ::: "memory");
        }
    }
    __syncthreads();
}

__device__ __forceinline__ unsigned f2bf_u(float f) { unsigned u = __builtin_bit_cast(unsigned, f); return (u + 0x7fffu + ((u >> 16) & 1u)) >> 16; }
__device__ __forceinline__ unsigned pk2(float lo, float hi) { return f2bf_u(lo) | (f2bf_u(hi) << 16); }
__device__ __forceinline__ float bflo(unsigned w) { return __builtin_bit_cast(float, w << 16); }
__device__ __forceinline__ float bfhi(unsigned w) { return __builtin_bit_cast(float, w & 0xffff0000u); }
__device__ __forceinline__ float silu_f(float v) { return v / (1.0f + __expf(-v)); }

struct Args { const float* in[21]; float* out; unsigned char* ws; int ph_lo, ph_hi; };
enum { I_X = 0, I_C, I_WADA, I_BADA, I_WIN, I_BIN, I_CONVW, I_CONVB, I_FW1, I_FB1, I_FWI, I_FBI, I_FWO, I_FFREQ, I_HBIAS, I_POOLW, I_POOLS, I_WOUT, I_BOUT, I_LNG, I_LNB };
typedef const __attribute__((address_space(4))) Args* ArgsP;
struct Frame { LAS unsigned char* lds; int tid, lane, wave, G, blk; ArgsP ap; };
#define AP_FRESH(F) ArgsP ap = (F).ap; asm volatile("" : "+s"(ap))
template <class T> __device__ __forceinline__ T* wsp(ArgsP ap, size_t off) { return (T*)(ap->ws + off); }

__device__ void tile_transpose(const Frame& F, const float* src, int lds_, int k0s, int n0s, bf16* dst, int ldd, int n0d, int k0d, const float* colscale) {
    LAS float* tile = (LAS float*)F.lds;
    const int t = F.tid;
    if (src) {
        const int i = t >> 3, jq = (t & 7) * 8;
        const f32x4v a = *(const f32x4v*)(src + (size_t)(k0s + i) * lds_ + n0s + jq), b = *(const f32x4v*)(src + (size_t)(k0s + i) * lds_ + n0s + jq + 4);
#pragma unroll
        for (int e = 0; e < 4; ++e) { tile[i * 65 + jq + e] = a[e]; tile[i * 65 + jq + 4 + e] = b[e]; }
    }
    __syncthreads();
    {
        const int j = t >> 3, iq = (t & 7) * 8;
        float v[8];
#pragma unroll
        for (int e = 0; e < 8; ++e) v[e] = src ? tile[(iq + e) * 65 + j] : 0.0f;
        if (src && colscale) { const float s = colscale[n0s + j];
#pragma unroll
            for (int e = 0; e < 8; ++e) v[e] *= s; }
        u32x4v w; w.x = pk2(v[0], v[1]); w.y = pk2(v[2], v[3]); w.z = pk2(v[4], v[5]); w.w = pk2(v[6], v[7]);
        *(u32x4v*)(dst + (size_t)(n0d + j) * ldd + k0d + iq) = w;
    }
    __syncthreads();
}
__device__ void p0_prologue(const Frame& F) {
    const int t = F.tid, blk = F.blk, G = F.G;
    AP_FRESH(F);
    const float *c_in = ap->in[I_C], *w_ada = ap->in[I_WADA], *b_ada = ap->in[I_BADA]; float* mod = wsp<float>(ap, WS_MOD);
    for (int job = blk; job < 256; job += G) {
        const int j0 = job * 12;
        LAS float* red = (LAS float*)F.lds;
        if (t < 510) {
            const int r = t / 3, q = t % 3;
            f32x4v a0 = {0.f, 0.f, 0.f, 0.f}, a1 = {0.f, 0.f, 0.f, 0.f};
            for (int i = r; i < DM; i += 170) {
                const f32x4v w = *(const f32x4v*)(w_ada + (size_t)i * 3072 + j0 + 4 * q);
                const float s0 = silu_f(c_in[i]), s1 = silu_f(c_in[DM + i]);
                a0 += w * s0; a1 += w * s1;
            }
#pragma unroll
            for (int e = 0; e < 4; ++e) { red[(r * 3 + q) * 8 + e] = a0[e]; red[(r * 3 + q) * 8 + 4 + e] = a1[e]; }
        }
        __syncthreads();
        if (t < 24) {
            const int b = t / 12, jj = t % 12, q = jj >> 2, e = jj & 3;
            float s = 0.f;
            for (int r = 0; r < 170; ++r) s += red[(r * 3 + q) * 8 + b * 4 + e];
            mod[b * 3072 + j0 + jj] = s + b_ada[j0 + jj];
        }
        __syncthreads();
    }
    const float *w_in = ap->in[I_WIN], *w_out = ap->in[I_WOUT], *f_wo = ap->in[I_FWO], *pool_w = ap->in[I_POOLW], *pool_scale = ap->in[I_POOLS];
    bf16 *WinT = wsp<bf16>(ap, WS_WINT), *WoutT = wsp<bf16>(ap, WS_WOUTT), *FWT = wsp<bf16>(ap, WS_FWT), *PWT = wsp<bf16>(ap, WS_PWT);
    constexpr int J_WIN = 16 * 48, J_WOUT = 16 * 16, J_FW = 32 * 4, J_PW = 64, J_ALL = J_WIN + J_WOUT + J_FW + J_PW;
    for (int job = blk; job < J_ALL; job += G) {
        int j = job;
        if (j < J_WIN) { const int kt = j / 48, nt = j % 48; tile_transpose(F, w_in, 3072, kt * 64, nt * 64, WinT, 1024, nt * 64, kt * 64, nullptr); continue; }
        j -= J_WIN;
        if (j < J_WOUT) { const int kt = j / 16, nt = j % 16; tile_transpose(F, w_out, 1024, kt * 64, nt * 64, WoutT, 1024, nt * 64, kt * 64, nullptr); continue; }
        j -= J_WOUT;
        if (j < J_FW) { const int nt = j / 4, kt = j % 4; tile_transpose(F, kt == 0 ? f_wo : nullptr, 2048, 0, nt * 64, FWT, 256, nt * 64, kt * 64, nullptr); continue; }
        j -= J_FW;
        { const int nt = j / 8, kt = j % 8, g = nt / 2;
          const bool diag = (kt / 2) == g;
          tile_transpose(F, diag ? pool_w + (size_t)g * 128 * 128 : nullptr, 128, (kt & 1) * 64, (nt & 1) * 64, PWT, 512, nt * 64, kt * 64, pool_scale + g * 128);
        }
    }
    {
        const int lane = F.lane, gw = blk * 8 + F.wave, nw = G * 8;
        const float *f_w1 = ap->in[I_FW1], *f_wi = ap->in[I_FWI], *f_bi = ap->in[I_FBI]; bf16* H3 = wsp<bf16>(ap, WS_H3);
        const float freq = ap->in[I_FFREQ][lane], b1 = ap->in[I_FB1][lane], bi0 = f_bi[lane], bi1 = f_bi[64 + lane];
        for (int grp = gw; grp < SEQ / 8; grp += nw) {
            const int l0 = grp * 8;
            float feat[8];
#pragma unroll
            for (int p = 0; p < 8; ++p) {
                const int l = l0 + p; float f = 0.f;
                if (lane == 0) f = (float)l * (1.0f / (float)(SEQ - 1));
                else if (lane < 33) { const int bi = (lane - 1) & 15; const float fr = 1e-4f + (float)bi * ((15.0f - 1e-4f) / 15.0f);
                    const float w = (6.283185307179586f / (float)SEQ) * (float)l; const float arg = fr * w; f = lane < 17 ? cosf(arg) : -sinf(arg); }
                feat[p] = f;
            }
            float acc[8];
#pragma unroll
            for (int p = 0; p < 8; ++p) acc[p] = b1;
            for (int i = 0; i < 33; ++i) { const float w = f_w1[i * 64 + lane];
#pragma unroll
                for (int p = 0; p < 8; ++p) acc[p] += __shfl(feat[p], i) * w; }
            float h[8];
#pragma unroll
            for (int p = 0; p < 8; ++p) h[p] = sinf(freq * acc[p]);
#pragma unroll
            for (int layer = 0; layer < 2; ++layer) {
                const float* W = f_wi + layer * 4096; const float bb = layer ? bi1 : bi0;
#pragma unroll
                for (int p = 0; p < 8; ++p) acc[p] = bb;
                for (int i = 0; i < 64; ++i) { const float w = W[i * 64 + lane];
#pragma unroll
                    for (int p = 0; p < 8; ++p) acc[p] += __shfl(h[p], i) * w; }
#pragma unroll
                for (int p = 0; p < 8; ++p) h[p] = sinf(freq * acc[p]);
            }
#pragma unroll
            for (int p = 0; p < 8; ++p) { bf16* row = H3 + (size_t)(l0 + p) * 256; row[lane] = (bf16)f2bf_u(h[p]); row[64 + lane] = 0; row[128 + lane] = 0; row[192 + lane] = 0; }
        }
    }
}

namespace pg8 {
struct EpiRowBias {
    static constexpr bool PERM = true, AFTER_DRAIN = false;
    bf16_t* O; int ldc; const float* rbias;
    __device__ __forceinline__ void operator()(const f32x4 (&acc)[2][2][4][2], const Unit& u, int wr, int wc, int fr, int fq) const {
        const int row0 = u.pm * BM + wr * 64 + fr, col0 = u.pn * BM + wc * 32 + 8 * fq;
#pragma unroll
        for (int ai = 0; ai < 2; ++ai)
#pragma unroll
            for (int m = 0; m < 4; ++m) { const int row = row0 + ai * HALF + m * 16; const float b = rbias[row]; bf16_t* rowp = O + (size_t)row * ldc + col0;
#pragma unroll
                for (int bj = 0; bj < 2; ++bj) { const f32x4 v0 = acc[ai][bj][m][0] + b, v1 = acc[ai][bj][m][1] + b;
                    u32x4 w; w.x = cvt_pk_bf16(v0[0], v0[1]); w.y = cvt_pk_bf16(v0[2], v0[3]); w.z = cvt_pk_bf16(v1[0], v1[1]); w.w = cvt_pk_bf16(v1[2], v1[3]);
                    *(u32x4*)(rowp + bj * HALF) = w; } }
    }
};
struct EpiDecay {
    static constexpr bool PERM = true, AFTER_DRAIN = false;
    bf16_t* O; int ldc;
    __device__ __forceinline__ void operator()(const f32x4 (&acc)[2][2][4][2], const Unit& u, int wr, int wc, int fr, int fq) const {
        const int row0 = u.pm * BM + wr * 64 + fr, col0 = u.pn * BM + wc * 32 + 8 * fq;
        const float dmin = -3.0701134573253944f, dmax = -15.350567286626972f;
#pragma unroll
        for (int ai = 0; ai < 2; ++ai)
#pragma unroll
            for (int m = 0; m < 4; ++m) { const int row = row0 + ai * HALF + m * 16, c = row & 511;
                const float dl2 = (dmin + (dmax - dmin) * ((float)c * (1.0f / 511.0f))) * 1.4426950408889634f * (1.0f / 16383.0f);
                bf16_t* rowp = O + (size_t)row * ldc + col0;
#pragma unroll
                for (int bj = 0; bj < 2; ++bj) { float v[8];
#pragma unroll
                    for (int e = 0; e < 8; ++e) { const int l = col0 + bj * HALF + e; v[e] = acc[ai][bj][m][e >> 2][e & 3] * __builtin_amdgcn_exp2f(dl2 * (float)l); }
                    u32x4 w; w.x = cvt_pk_bf16(v[0], v[1]); w.y = cvt_pk_bf16(v[2], v[3]); w.z = cvt_pk_bf16(v[4], v[5]); w.w = cvt_pk_bf16(v[6], v[7]);
                    *(u32x4*)(rowp + bj * HALF) = w; } }
    }
};
struct EpiPoolGate {
    static constexpr bool PERM = true, AFTER_DRAIN = false;
    bf16_t* Y; const bf16_t* TP;
    __device__ __forceinline__ void operator()(const f32x4 (&acc)[2][2][4][2], const Unit& u, int wr, int wc, int fr, int fq) const {
        const int row0 = u.pm * BM + wr * 64 + fr, col0 = u.pn * BM + wc * 32 + 8 * fq;
#pragma unroll
        for (int ai = 0; ai < 2; ++ai)
#pragma unroll
            for (int m = 0; m < 4; ++m) { const int row = row0 + ai * HALF + m * 16;
#pragma unroll
                for (int bj = 0; bj < 2; ++bj) { const size_t off = (size_t)row * 1024 + 512 + col0 + bj * HALF;
                    const u32x4 g = *(const u32x4*)(TP + off); float v[8];
#pragma unroll
                    for (int e = 0; e < 8; ++e) { const unsigned gw = e < 2 ? g.x : e < 4 ? g.y : e < 6 ? g.z : g.w; const float q = (e & 1) ? __builtin_bit_cast(float, gw & 0xffff0000u) : __builtin_bit_cast(float, gw << 16);
                        v[e] = acc[ai][bj][m][e >> 2][e & 3] * (q / (1.0f + __expf(-q))); }
                    u32x4 w; w.x = cvt_pk_bf16(v[0], v[1]); w.y = cvt_pk_bf16(v[2], v[3]); w.z = cvt_pk_bf16(v[4], v[5]); w.w = cvt_pk_bf16(v[6], v[7]);
                    *(u32x4*)(Y + off) = w; } }
    }
};
struct EpiResGate {
    static constexpr bool PERM = false, AFTER_DRAIN = false;
    float* C; const float* X; const float* mod; const float* bout; float alpha;
    __device__ __forceinline__ void operator()(const f32x4 (&acc)[2][2][4][2], const Unit& u, int wr, int wc, int fr, int fq) const {
        const int row0 = u.pm * BM + wr * 64 + fr, col0 = u.pn * BM + wc * 32 + 4 * fq;
        const float* gate = mod + ((u.pm * BM) >= 16384 ? 3072 : 0) + 2048;
        f32x4 bv[2][2], gv[2][2];
#pragma unroll
        for (int bj = 0; bj < 2; ++bj)
#pragma unroll
            for (int n = 0; n < 2; ++n) { bv[bj][n] = *(const f32x4*)(bout + col0 + bj * HALF + n * 16); gv[bj][n] = *(const f32x4*)(gate + col0 + bj * HALF + n * 16); }
#pragma unroll
        for (int ai = 0; ai < 2; ++ai)
#pragma unroll
            for (int m = 0; m < 4; ++m) { const size_t off = (size_t)(row0 + ai * HALF + m * 16) * 1024 + col0;
#pragma unroll
                for (int bj = 0; bj < 2; ++bj)
#pragma unroll
                    for (int n = 0; n < 2; ++n) { const f32x4 xv = *(const f32x4*)(X + off + bj * HALF + n * 16);
                        *(f32x4*)(C + off + bj * HALF + n * 16) = xv * alpha + gv[bj][n] * (acc[ai][bj][m][n] + bv[bj][n]); } }
    }
};
}

__device__ void p1_modulate(const Frame& F) {
    AP_FRESH(F);
    const float* x = ap->in[I_X]; const float* mod = wsp<float>(ap, WS_MOD); bf16* U = wsp<bf16>(ap, WS_U);
    const size_t n8 = (size_t)NTOK * DM / 8, stride = (size_t)F.G * NT;
    for (size_t i = (size_t)F.blk * NT + F.tid; i < n8; i += stride) {
        const size_t e0 = i * 8; const int col = (int)(e0 & (DM - 1)); const int b = (int)(e0 >= (size_t)SEQ * DM);
        const float* md = mod + b * 3072;
        const f32x4v x0 = *(const f32x4v*)(x + e0), x1 = *(const f32x4v*)(x + e0 + 4);
        const f32x4v sh0 = *(const f32x4v*)(md + col), sh1 = *(const f32x4v*)(md + col + 4), sc0 = *(const f32x4v*)(md + 1024 + col), sc1 = *(const f32x4v*)(md + 1024 + col + 4);
        const f32x4v u0 = x0 * (sc0 + 1.0f) + sh0, u1 = x1 * (sc1 + 1.0f) + sh1;
        u32x4v w; w.x = pk2(u0[0], u0[1]); w.y = pk2(u0[2], u0[3]); w.z = pk2(u1[0], u1[1]); w.w = pk2(u1[2], u1[3]);
        *(u32x4v*)(U + e0) = w;
    }
}

__device__ void p3_pool(const Frame& F) {
    AP_FRESH(F);
    const bf16* TP = wsp<bf16>(ap, WS_TP); bf16* PP = wsp<bf16>(ap, WS_PP);
    const size_t n8 = (size_t)NTOK * 512 / 8, stride = (size_t)F.G * NT;
    for (size_t i = (size_t)F.blk * NT + F.tid; i < n8; i += stride) {
        const int tok = (int)(i >> 6), c8 = (int)(i & 63) * 8, g = c8 >> 7, hw = 1 << g;
        const int b = tok >> 14, pos = tok & (SEQ - 1);
        const int lo = pos - hw < 0 ? 0 : pos - hw, hi = pos + hw > SEQ ? SEQ : pos + hw;
        float s[8] = {0.f, 0.f, 0.f, 0.f, 0.f, 0.f, 0.f, 0.f}, own[8];
        const bf16* base = TP + (size_t)b * SEQ * 1024 + c8;
        for (int q = lo; q < hi; ++q) {
            const u32x4v v = *(const u32x4v*)(base + (size_t)q * 1024);
            s[0] += bflo(v.x); s[1] += bfhi(v.x); s[2] += bflo(v.y); s[3] += bfhi(v.y); s[4] += bflo(v.z); s[5] += bfhi(v.z); s[6] += bflo(v.w); s[7] += bfhi(v.w);
        }
        { const u32x4v v = *(const u32x4v*)(base + (size_t)pos * 1024);
          own[0] = bflo(v.x); own[1] = bfhi(v.x); own[2] = bflo(v.y); own[3] = bfhi(v.y); own[4] = bflo(v.z); own[5] = bfhi(v.z); own[6] = bflo(v.w); own[7] = bfhi(v.w); }
        const float inv = 1.0f / (float)(hi - lo);
        u32x4v w; w.x = pk2(s[0] * inv - own[0], s[1] * inv - own[1]); w.y = pk2(s[2] * inv - own[2], s[3] * inv - own[3]);
        w.z = pk2(s[4] * inv - own[4], s[5] * inv - own[5]); w.w = pk2(s[6] * inv - own[6], s[7] * inv - own[7]);
        *(u32x4v*)(PP + (size_t)tok * 512 + c8) = w;
    }
}

__device__ void p3_hyena(const Frame& F) {
    LAS f2* L = (LAS f2*)F.lds;
    const int t = F.tid;
    AP_FRESH(F);
    hy::JobArgs J;
    J.ch = wsp<bf16>(ap, WS_CH); J.kt = wsp<bf16>(ap, WS_KT); J.conv_w = ap->in[I_CONVW]; J.conv_b = ap->in[I_CONVB]; J.hbias = ap->in[I_HBIAS];
    J.sbase = (f2*)(ap->ws + WS_ST + (size_t)F.blk * 393216); J.yh = wsp<bf16>(ap, WS_YH);
    const hy::Stash S = hy::make_stash(J);
    for (int c = F.blk; c < DH; c += F.G) {
        hy::seg_prep(J, S, c, t);
        for (int oh = 0; oh < 4; ++oh) {
            const int o = oh >> 1; const bool tw = oh & 1;
            hy::seg_filter_p1(J, c, o, tw, t, L); __syncthreads();
            hy::fwd_p2(t, L); __syncthreads();
            hy::seg_filter_p3(S, t, L); __syncthreads();
            hy::seg_data_p1(S, tw, t, L); __syncthreads();
            hy::fwd_p2(t, L); __syncthreads();
            hy::seg_mul(S, t, L); __syncthreads();
            hy::inv_p2(t, L); __syncthreads();
            hy::seg_out(J, S, c, o, tw, t, L); __syncthreads();
        }
    }
}

__device__ void p4_transpose(const Frame& F) {
    LAS bf16* tile = (LAS bf16*)F.lds;
    const int t = F.tid;
    AP_FRESH(F);
    const bf16* YH = wsp<bf16>(ap, WS_YH); bf16* Y = wsp<bf16>(ap, WS_Y);
    for (int job = F.blk; job < 8 * 512; job += F.G) {
        const int ct = job & 7, tt = job >> 3;
        { const int r = t >> 3, q = (t & 7) * 8;
          const u32x4v v = *(const u32x4v*)(YH + (size_t)(ct * 64 + r) * NTOK + tt * 64 + q);
          tile[(q + 0) * 66 + r] = (bf16)(v.x & 0xffff); tile[(q + 1) * 66 + r] = (bf16)(v.x >> 16); tile[(q + 2) * 66 + r] = (bf16)(v.y & 0xffff); tile[(q + 3) * 66 + r] = (bf16)(v.y >> 16);
          tile[(q + 4) * 66 + r] = (bf16)(v.z & 0xffff); tile[(q + 5) * 66 + r] = (bf16)(v.z >> 16); tile[(q + 6) * 66 + r] = (bf16)(v.w & 0xffff); tile[(q + 7) * 66 + r] = (bf16)(v.w >> 16); }
        __syncthreads();
        { const int tok = t >> 3, q = (t & 7) * 8;
          const LAS unsigned* p = (const LAS unsigned*)(tile + tok * 66 + q);
          u32x4v w; w.x = p[0]; w.y = p[1]; w.z = p[2]; w.w = p[3];
          *(u32x4v*)(Y + (size_t)(tt * 64 + tok) * 1024 + ct * 64 + q) = w; }
        __syncthreads();
    }
}

__device__ void p6_layernorm(const Frame& F) {
    const int lane = F.lane;
    AP_FRESH(F);
    float* out = ap->out; const float *ln_g = ap->in[I_LNG], *ln_b = ap->in[I_LNB];
    for (int row = F.blk * 8 + F.wave; row < NTOK; row += F.G * 8) {
        float* p = out + (size_t)row * DM;
        f32x4v v[4]; float s = 0.f;
#pragma unroll
        for (int k = 0; k < 4; ++k) { v[k] = *(const f32x4v*)(p + k * 256 + lane * 4); s += (v[k][0] + v[k][1]) + (v[k][2] + v[k][3]); }
#pragma unroll
        for (int o = 32; o >= 1; o >>= 1) s += __shfl_xor(s, o);
        const float mean = s * (1.0f / DM); float q = 0.f;
#pragma unroll
        for (int k = 0; k < 4; ++k) { const f32x4v d = v[k] - mean; q += (d[0] * d[0] + d[1] * d[1]) + (d[2] * d[2] + d[3] * d[3]); }
#pragma unroll
        for (int o = 32; o >= 1; o >>= 1) q += __shfl_xor(q, o);
        const float rstd = 1.0f / sqrtf(q * (1.0f / DM) + LN_EPS);
#pragma unroll
        for (int k = 0; k < 4; ++k) { const f32x4v g = *(const f32x4v*)(ln_g + k * 256 + lane * 4), b = *(const f32x4v*)(ln_b + k * 256 + lane * 4);
            *(f32x4v*)(p + k * 256 + lane * 4) = (v[k] - mean) * rstd * g + b; }
    }
}

__global__ void __launch_bounds__(NT, 2) fwd_kernel(Args args) {
    extern __shared__ __attribute__((aligned(16))) unsigned char lds_raw[];
    Frame F;
    F.lds = (LAS unsigned char*)lds_raw; F.tid = threadIdx.x; F.lane = F.tid & 63; F.wave = __builtin_amdgcn_readfirstlane(F.tid >> 6); F.G = gridDim.x; F.blk = blockIdx.x;
    F.ap = (ArgsP)__builtin_amdgcn_kernarg_segment_ptr();
    unsigned char* ws = args.ws;
    volatile LAS unsigned* MISC = (volatile LAS unsigned*)(F.lds + LDS_MISC);
    if (F.tid < 64) MISC[F.tid] = 0u;
    __syncthreads();
    XcdBarrier bar; bar.bar = (unsigned*)(ws + WS_CTL); bar.x = 0; bar.st = nullptr;
    const int lo = args.ph_lo, hi = args.ph_hi;
    if (hi - lo > 1) bar = xcd_barrier_post((unsigned*)(ws + WS_CTL), MISC + 8);
#define IN(k) (lo <= (k) && (k) < hi)
#define SEAM(k) do { if (IN(k) && IN((k) + 1)) xcd_barrier(bar); } while (0)
    const int vcu = (F.G % 8 == 0) ? (F.blk % 8) * (F.G / 8) + F.blk / 8 : F.blk; (void)vcu;

    if (IN(0)) p0_prologue(F);
    SEAM(0);
    if (IN(1)) {
        p1_modulate(F);
        AP_FRESH(F);
        pg8::Gemm g{wsp<bf16>(ap, WS_FWT), wsp<bf16>(ap, WS_H3), 2048, SEQ, 256}; pg8::StaticOrder S; S.init(g.M, g.N, F.G, F.blk); pg8::EpiDecay E{wsp<bf16>(ap, WS_KT), SEQ};
        pg8::gemm_phase<pg8::EpiDecay, pg8::StaticOrder, false>(F.lds, g, S, E, nullptr);
    }
    SEAM(1);
    if (IN(2)) {
        { AP_FRESH(F);
          pg8::Gemm g{wsp<bf16>(ap, WS_WINT), wsp<bf16>(ap, WS_U), 2048, NTOK, DM}; pg8::StaticOrder S; S.init(g.M, g.N, F.G, F.blk); pg8::EpiRowBias E{wsp<bf16>(ap, WS_CH), NTOK, ap->in[I_BIN]};
          pg8::gemm_phase<pg8::EpiRowBias, pg8::StaticOrder, false>(F.lds, g, S, E, nullptr); }
        __syncthreads();
        { AP_FRESH(F);
          pg8::Gemm g{wsp<bf16>(ap, WS_U), wsp<bf16>(ap, WS_WINT) + (size_t)2048 * DM, NTOK, 1024, DM}; pg8::StaticOrder S; S.init(g.M, g.N, F.G, F.blk); pg8::EpiBf16<0> E{wsp<bf16>(ap, WS_TP), 1024, ap->in[I_BIN] + 2048, 0, 0};
          pg8::gemm_phase<pg8::EpiBf16<0>, pg8::StaticOrder, false>(F.lds, g, S, E, nullptr); }
    }
    SEAM(2);
    if (IN(3)) { p3_hyena(F); p3_pool(F); }
    SEAM(3);
    if (IN(4)) {
        p4_transpose(F);
        __syncthreads();
        AP_FRESH(F);
        pg8::Gemm g{wsp<bf16>(ap, WS_PP), wsp<bf16>(ap, WS_PWT), NTOK, 512, 512}; pg8::StaticOrder S; S.init(g.M, g.N, F.G, F.blk); pg8::EpiPoolGate E{wsp<bf16>(ap, WS_Y), wsp<bf16>(ap, WS_TP)};
        pg8::gemm_phase<pg8::EpiPoolGate, pg8::StaticOrder, false>(F.lds, g, S, E, nullptr);
    }
    SEAM(4);
    if (IN(5)) {
        AP_FRESH(F);
        pg8::Gemm g{wsp<bf16>(ap, WS_Y), wsp<bf16>(ap, WS_WOUTT), NTOK, DM, DM}; pg8::StaticOrder S; S.init(g.M, g.N, F.G, F.blk); pg8::EpiResGate E{ap->out, ap->in[I_X], wsp<float>(ap, WS_MOD), ap->in[I_BOUT], DN_ALPHA};
        pg8::gemm_phase<pg8::EpiResGate, pg8::StaticOrder, false>(F.lds, g, S, E, nullptr);
    }
    SEAM(5);
    if (IN(6)) p6_layernorm(F);
#undef IN
#undef SEAM
}

extern "C" void kernel_launch(void* const* d_in, const int* in_sizes, int n_in, void* d_out, int out_size, void* d_ws, size_t ws_size, hipStream_t stream) {
    static int grid = 0;
    if (grid == 0) {
        if (n_in != 21 || in_sizes[0] != NTOK * DM || out_size != NTOK * DM || ws_size < WS_END) {
            fprintf(stderr, "kernel_launch: unexpected shapes (n_in %d, in0 %d, out %d, ws %zu < %zu)\n", n_in, n_in > 0 ? in_sizes[0] : -1, out_size, ws_size, (size_t)WS_END); grid = -1; return; }
        int dev = 0, cus = 0, per_cu = 0;
        if (hipGetDevice(&dev) != hipSuccess || hipDeviceGetAttribute(&cus, hipDeviceAttributeMultiprocessorCount, dev) != hipSuccess) { grid = -1; return; }
        if (hipFuncSetAttribute((const void*)fwd_kernel, hipFuncAttributeMaxDynamicSharedMemorySize, LDS_BYTES) != hipSuccess) { fprintf(stderr, "kernel_launch: hipFuncSetAttribute failed\n"); grid = -1; return; }
        if (hipOccupancyMaxActiveBlocksPerMultiprocessor(&per_cu, (const void*)fwd_kernel, NT, LDS_BYTES) != hipSuccess || per_cu < 1) { fprintf(stderr, "kernel_launch: occupancy query says %d blocks per CU\n", per_cu); }
        (void)hipGetLastError();
        grid = cus;
    }
    if (grid < 0) return;
    (void)hipMemsetAsync((char*)d_ws + WS_CTL, 0, CTL_BYTES, stream);
    Args a{};
    for (int i = 0; i < 21; ++i) a.in[i] = (const float*)d_in[i];
    a.out = (float*)d_out; a.ws = (unsigned char*)d_ws;
    if (MK_N_LAUNCHES == 1) { a.ph_lo = 0; a.ph_hi = N_PHASES; hipLaunchKernelGGL(fwd_kernel, dim3(grid), dim3(NT), LDS_BYTES, stream, a); }
    else for (int p = 0; p < N_PHASES; ++p) { a.ph_lo = p; a.ph_hi = p + 1; hipLaunchKernelGGL(fwd_kernel, dim3(grid), dim3(NT), LDS_BYTES, stream, a); }
}
```

```cpp
#include <hip/hip_runtime.h>
#include <cstdio>
#include <cstdint>
#ifndef MK_N_LAUNCHES
#define MK_N_LAUNCHES 1
#define PROBE_MASK 0
#define HP 0
#endif
namespace pg8 {
#define PG8_LAS __attribute__((address_space(3)))
typedef unsigned short bf16_t;
typedef short bf16x8 __attribute__((ext_vector_type(8)));
typedef float f32x4 __attribute__((ext_vector_type(4)));
typedef unsigned u32x4 __attribute__((ext_vector_type(4)));
constexpr int BM = 256, BK = 64, HALF = 128, HTB = HALF * BK * 2  , STAGE_BYTES = 8 * HTB, NXCD = 8, WGM = 8;

__host__ __device__ __forceinline__ int lds_byte(int r, int c) { const int st = (r >> 4) * 2 + (c >> 5), rr = r & 15, cc = c & 31, ob = rr * 64 + cc * 2; return st * 1024 + (ob ^ (((ob >> 9) & 1) << 5)); }
__host__ __device__ __forceinline__ void stage_rc(int b, int& R, int& C) { const int st = b / 1024, sb = b % 1024, swz = sb ^ (((sb >> 9) & 1) << 5); R = (st >> 1) * 16 + swz / 64; C = (st & 1) * 32 + (swz % 64) / 2; }
__host__ __device__ __forceinline__ int perm32(int rho) { const int n = rho >> 4, i = rho & 15; return 8 * (i >> 2) + 4 * n + (i & 3); }

struct Unit { int pm, pn; };
struct Gemm { const bf16_t* A; const bf16_t* Bt; int M, N, K; };

struct StaticOrder {
    int nM, nN, nwg, G, c;
    __host__ __device__ void init(int M, int N, int G_, int c_) { nM = M / BM; nN = N / BM; nwg = nM * nN; G = G_; c = c_; }
    __host__ __device__ bool next(int i, Unit& u) const {
        const long L = (long)i * G + c; if (L >= nwg) return false;
        int wgid = (int)L; { const int q = nwg / NXCD, r = nwg % NXCD, xcd = wgid % NXCD, off = wgid / NXCD; wgid = (xcd < r ? xcd * (q + 1) : r * (q + 1) + (xcd - r) * q) + off; }
        const int nig = WGM * nN, gid = wgid / nig, fm = gid * WGM, gsz = (nM - fm) < WGM ? (nM - fm) : WGM;
        u.pm = fm + ((wgid % nig) % gsz); u.pn = (wgid % nig) / gsz; return true;
    }
    __device__ __forceinline__ void a_ready(const Unit&) const {}
    __device__ __forceinline__ void done(const Unit&) const {}
};
struct CountedOrder : StaticOrder {
    const unsigned* ready; unsigned need; unsigned* tmo;
    __device__ __forceinline__ void a_ready(const Unit& u) const {
        if (threadIdx.x < 64) {
            const unsigned long long t0 = __builtin_amdgcn_s_memrealtime(); unsigned polls = 0;
            while ((unsigned)__builtin_amdgcn_readfirstlane(__hip_atomic_load(ready + 64 * u.pm, __ATOMIC_RELAXED, __HIP_MEMORY_SCOPE_AGENT)) < need) {
                if ((++polls & 255u) == 0u && __builtin_amdgcn_readfirstlane(__hip_atomic_load(tmo, __ATOMIC_RELAXED, __HIP_MEMORY_SCOPE_AGENT)) != 0u) break;
                if (__builtin_amdgcn_s_memrealtime() - t0 > 2000000ull) {
                    if (threadIdx.x == 0) { unsigned expect = 0u; __hip_atomic_compare_exchange_strong(tmo + 1, &expect, 0x600u | (unsigned)(u.pm & 0xff), __ATOMIC_RELAXED, __ATOMIC_RELAXED, __HIP_MEMORY_SCOPE_AGENT); __hip_atomic_store(tmo, 1u, __ATOMIC_RELAXED, __HIP_MEMORY_SCOPE_AGENT); }
                    break; }
                __builtin_amdgcn_s_sleep(2); }
            __builtin_amdgcn_fence(__ATOMIC_ACQUIRE, "agent");
            asm volatile("s_waitcnt vmcnt(0)" ::: "memory");
        }
#if !defined(BROKEN_HOOK_NO_BARRIER)
        asm volatile("" ::: "memory"); __builtin_amdgcn_s_barrier(); asm volatile("" ::: "memory");
#endif
    }
};

__device__ __forceinline__ unsigned cvt_pk_bf16(float lo, float hi) { unsigned r; asm volatile("v_cvt_pk_bf16_f32 %0, %1, %2" : "=v"(r) : "v"(lo), "v"(hi)); return r; }
typedef float f32x2 __attribute__((ext_vector_type(2)));
__device__ __forceinline__ f32x2 gelu_pk(f32x2 v) {
    const f32x2 av = __builtin_elementwise_abs(v), d = av * 0.2316418882f + 1.0f;
    f32x2 t; t.x = __builtin_amdgcn_rcpf(d.x); t.y = __builtin_amdgcn_rcpf(d.y);
    f32x2 q = t * 0.5307027145f + (-0.7265760135f); q = q * t + 0.7107068705f; q = q * t + (-0.142248368f); q = q * t + 0.127414796f; q = q * t;
    const f32x2 s = (v * v) * (-0.72134752044f);
    f32x2 e; e.x = __builtin_amdgcn_exp2f(s.x); e.y = __builtin_amdgcn_exp2f(s.y);
    const f32x2 m = v * (q * e), r = v - m;
    f32x2 o; o.x = v.x < 0.f ? m.x : r.x; o.y = v.y < 0.f ? m.y : r.y; return o;
}

struct EpiF32 {
    static constexpr bool PERM = false, AFTER_DRAIN = false;
    float* C; int ldc; const float* bias;
    __device__ __forceinline__ void operator()(const f32x4 (&acc)[2][2][4][2], const Unit& u, int wr, int wc, int fr, int fq) const {
        const int row0 = u.pm * BM + wr * 64 + fr, col0 = u.pn * BM + wc * 32 + 4 * fq;
        f32x4 bv[2][2];
#pragma unroll
        for (int bj = 0; bj < 2; ++bj)
#pragma unroll
            for (int n = 0; n < 2; ++n) bv[bj][n] = bias ? *(const f32x4*)(bias + col0 + bj * HALF + n * 16) : (f32x4){0.f, 0.f, 0.f, 0.f};
#pragma unroll
        for (int ai = 0; ai < 2; ++ai)
#pragma unroll
            for (int m = 0; m < 4; ++m) { float* rowp = C + (size_t)(row0 + ai * HALF + m * 16) * ldc + col0;
#pragma unroll
                for (int bj = 0; bj < 2; ++bj)
#pragma unroll
                    for (int n = 0; n < 2; ++n) *(f32x4*)(rowp + bj * HALF + n * 16) = acc[ai][bj][m][n] + bv[bj][n]; }
    }
};
template <int ACT  > struct EpiBf16 {
    static constexpr bool PERM = true, AFTER_DRAIN = false;
    bf16_t* O; int ldc; const float* bias; int split_cols; size_t split_stride;
    __device__ __forceinline__ void operator()(const f32x4 (&acc)[2][2][4][2], const Unit& u, int wr, int wc, int fr, int fq) const {
        const int row0 = u.pm * BM + wr * 64 + fr; int colt = u.pn * BM; bf16_t* base = O;
        if (split_cols) { const int t = colt / split_cols; base += (size_t)t * split_stride; colt -= t * split_cols; }
        const int col0 = colt + wc * 32 + 8 * fq, bcol0 = u.pn * BM + wc * 32 + 8 * fq;
        f32x4 bv[2][2];
#pragma unroll
        for (int bj = 0; bj < 2; ++bj)
#pragma unroll
            for (int n = 0; n < 2; ++n) bv[bj][n] = bias ? *(const f32x4*)(bias + bcol0 + bj * HALF + 4 * n) : (f32x4){0.f, 0.f, 0.f, 0.f};
#pragma unroll
        for (int ai = 0; ai < 2; ++ai)
#pragma unroll
            for (int m = 0; m < 4; ++m) { bf16_t* rowp = base + (size_t)(row0 + ai * HALF + m * 16) * ldc + col0;
#pragma unroll
                for (int bj = 0; bj < 2; ++bj) { f32x4 v0 = acc[ai][bj][m][0] + bv[bj][0], v1 = acc[ai][bj][m][1] + bv[bj][1];
                    if (ACT == 1) { f32x2 a = gelu_pk((f32x2){v0[0], v0[1]}), b = gelu_pk((f32x2){v0[2], v0[3]}), c = gelu_pk((f32x2){v1[0], v1[1]}), d = gelu_pk((f32x2){v1[2], v1[3]});
                        v0 = (f32x4){a.x, a.y, b.x, b.y}; v1 = (f32x4){c.x, c.y, d.x, d.y}; }
                    if (ACT == 2) {
#pragma unroll
                        for (int j = 0; j < 4; ++j) { v0[j] = 0.5f * v0[j] * (1.0f + erff(v0[j] * 0.70710678f)); v1[j] = 0.5f * v1[j] * (1.0f + erff(v1[j] * 0.70710678f)); } }
                    u32x4 w; w.x = cvt_pk_bf16(v0[0], v0[1]); w.y = cvt_pk_bf16(v0[2], v0[3]); w.z = cvt_pk_bf16(v1[0], v1[1]); w.w = cvt_pk_bf16(v1[2], v1[3]);
                    *(u32x4*)(rowp + bj * HALF) = w; } }
    }
};

struct PanelStats {
    unsigned* xbuf;
    unsigned* cnt;
    unsigned* tmo;
    int ntn; float eps;
    unsigned code;
    __device__ __forceinline__ bool run(const f32x4 (&v)[2][2][4][2], const Unit& u, int wr, int wc, int fr, int fq, PG8_LAS unsigned char* lds, int wid, int lane) const {
        typedef float f32x2v __attribute__((ext_vector_type(2)));
        PG8_LAS f32x2v* P = (PG8_LAS f32x2v*)lds;
        PG8_LAS f32x2v* S = (PG8_LAS f32x2v*)(lds + 8192);
        PG8_LAS unsigned* flag = (PG8_LAS unsigned*)(lds + 8192 + 2048);
#pragma unroll
        for (int ai = 0; ai < 2; ++ai)
#pragma unroll
            for (int m = 0; m < 4; ++m) {
                float s = 0.f;
#pragma unroll
                for (int bj = 0; bj < 2; ++bj)
#pragma unroll
                    for (int n = 0; n < 2; ++n) { const f32x4 x = v[ai][bj][m][n]; s += (x[0] + x[1]) + (x[2] + x[3]); }
                s += __shfl_xor(s, 16); s += __shfl_xor(s, 32);
                const float mw = s * (1.0f / 64.0f); float q = 0.f;
#pragma unroll
                for (int bj = 0; bj < 2; ++bj)
#pragma unroll
                    for (int n = 0; n < 2; ++n) { const f32x4 d = v[ai][bj][m][n] - mw; q += (d[0] * d[0] + d[1] * d[1]) + (d[2] * d[2] + d[3] * d[3]); }
                q += __shfl_xor(q, 16); q += __shfl_xor(q, 32);
                if (fq == 0) P[(ai * HALF + wr * 64 + m * 16 + fr) * 4 + wc] = (f32x2v){mw, q};
            }
        asm volatile("s_waitcnt lgkmcnt(0)" ::: "memory"); __builtin_amdgcn_s_barrier(); asm volatile("" ::: "memory");
#if defined(BROKEN_NO_WAIT)
        if (blockIdx.x >= 64) { const long long t0 = clock64(); while (clock64() - t0 < 60000) __builtin_amdgcn_s_sleep(8); }
#endif
        const int row = wid * 32 + (lane & 31);
        if (lane < 32) {
            const f32x2v a = P[row * 4 + 0], b = P[row * 4 + 1], c = P[row * 4 + 2], d = P[row * 4 + 3];
            const float mt = (a.x + b.x + c.x + d.x) * 0.25f;
            const float da = a.x - mt, db = b.x - mt, dc = c.x - mt, dd = d.x - mt;
            const float m2 = (a.y + b.y) + (c.y + d.y) + 64.0f * ((da * da + db * db) + (dc * dc + dd * dd));
            unsigned long long* slot = (unsigned long long*)xbuf + ((size_t)(u.pm * BM + row) * 4 + u.pn);
            __hip_atomic_store(slot, ((unsigned long long)__float_as_uint(m2) << 32) | __float_as_uint(mt), __ATOMIC_RELAXED, __HIP_MEMORY_SCOPE_AGENT);
        }
        asm volatile("s_waitcnt vmcnt(0)" ::: "memory");
        if (lane == 0) __hip_atomic_fetch_add(cnt + 64 * u.pm, 1u, __ATOMIC_RELAXED, __HIP_MEMORY_SCOPE_AGENT);
        if (wid == 0) {
            bool dead = false; const unsigned long long t0 = __builtin_amdgcn_s_memrealtime(); const unsigned want = 8u * (unsigned)ntn;
            for (;;) {
#if defined(BROKEN_NO_WAIT)
                break;
#endif
                if ((unsigned)__builtin_amdgcn_readfirstlane(__hip_atomic_load(cnt + 64 * u.pm, __ATOMIC_RELAXED, __HIP_MEMORY_SCOPE_AGENT)) >= want) break;
                if (__builtin_amdgcn_s_memrealtime() - t0 > 2000000ull) {
                    if (lane == 0) { unsigned expect = 0u; __hip_atomic_compare_exchange_strong(tmo + 1, &expect, code | (unsigned)(u.pm & 0xff), __ATOMIC_RELAXED, __ATOMIC_RELAXED, __HIP_MEMORY_SCOPE_AGENT);
                                     __hip_atomic_store(tmo, 1u, __ATOMIC_RELAXED, __HIP_MEMORY_SCOPE_AGENT); }
                    dead = true; break; }
                __builtin_amdgcn_s_sleep(2);
            }
            __builtin_amdgcn_fence(__ATOMIC_ACQUIRE, "agent");
            if (lane == 0) flag[0] = dead ? 1u : 0u;
        }
        asm volatile("s_waitcnt vmcnt(0) lgkmcnt(0)" ::: "memory"); __builtin_amdgcn_s_barrier(); asm volatile("" ::: "memory");
        const bool bad = flag[0] != 0u;
        if (lane < 32) {
            const unsigned long long* slot = (const unsigned long long*)xbuf + (size_t)(u.pm * BM + row) * 4; float mt[4], m2[4]; float ms = 0.f;
#pragma unroll
            for (int t = 0; t < 4; ++t) { if (t < ntn) { const unsigned long long w = __hip_atomic_load(slot + t, __ATOMIC_RELAXED, __HIP_MEMORY_SCOPE_AGENT); mt[t] = __uint_as_float((unsigned)w); m2[t] = __uint_as_float((unsigned)(w >> 32)); } else { mt[t] = 0.f; m2[t] = 0.f; } ms += mt[t]; }
            const float mean = ms / (float)ntn; float q = 0.f;
#pragma unroll
            for (int t = 0; t < 4; ++t) if (t < ntn) { const float dm = mt[t] - mean; q += m2[t] + 256.0f * dm * dm; }
            S[row] = (f32x2v){mean, 1.0f / sqrtf(q / (256.0f * (float)ntn) + eps)};
        }
        asm volatile("s_waitcnt lgkmcnt(0)" ::: "memory"); __builtin_amdgcn_s_barrier(); asm volatile("" ::: "memory");
        return bad;
    }
};
struct EpiLnRes {
    static constexpr bool PERM = false, AFTER_DRAIN = true;
    const float* base; float* out; int ldc; const float* bias; PanelStats st; unsigned poison;
    __device__ __forceinline__ void refuse(size_t i0, size_t stride, int M, int N) const { const float q = __builtin_nanf(""); for (size_t i = i0; i < (size_t)M * N; i += stride) out[(i / N) * ldc + i % N] = q;
        if (i0 == 0) { unsigned expect = 0u; __hip_atomic_compare_exchange_strong(st.tmo + 1, &expect, 0x7f0u, __ATOMIC_RELAXED, __ATOMIC_RELAXED, __HIP_MEMORY_SCOPE_AGENT); __hip_atomic_store(st.tmo, 1u, __ATOMIC_RELAXED, __HIP_MEMORY_SCOPE_AGENT); } }
    __device__ __forceinline__ void fused(f32x4 (&acc)[2][2][4][2], const Unit& u, int wr, int wc, int fr, int fq, PG8_LAS unsigned char* lds, int wid, int lane) const {
        typedef float f32x2v __attribute__((ext_vector_type(2)));
        const PG8_LAS f32x2v* S = (const PG8_LAS f32x2v*)(lds + 8192);
        const int col0 = u.pn * BM + wc * 32 + 4 * fq;
#pragma unroll
        for (int bj = 0; bj < 2; ++bj)
#pragma unroll
            for (int n = 0; n < 2; ++n) { const f32x4 bv = bias ? *(const f32x4*)(bias + col0 + bj * HALF + n * 16) : (f32x4){0.f, 0.f, 0.f, 0.f};
#pragma unroll
                for (int ai = 0; ai < 2; ++ai)
#pragma unroll
                    for (int m = 0; m < 4; ++m) acc[ai][bj][m][n] += bv; }
        const bool bad = st.run(acc, u, wr, wc, fr, fq, lds, wid, lane) || poison != 0u;
        const float qnan = __builtin_nanf("");
#pragma unroll
        for (int ai = 0; ai < 2; ++ai)
#pragma unroll
            for (int m = 0; m < 4; ++m) { const int r = ai * HALF + wr * 64 + m * 16 + fr; const f32x2v sr = S[r]; const size_t off = (size_t)(u.pm * BM + r) * ldc + col0;
#pragma unroll
                for (int bj = 0; bj < 2; ++bj)
#pragma unroll
                    for (int n = 0; n < 2; ++n) { const f32x4 bs = *(const f32x4*)(base + off + bj * HALF + n * 16); f32x4 o = bs + (acc[ai][bj][m][n] - sr.x) * sr.y;
                        if (bad) o = (f32x4){qnan, qnan, qnan, qnan}; *(f32x4*)(out + off + bj * HALF + n * 16) = o; }
                asm volatile("" ::: "memory"); }
    }
};
struct EpiLnResLn {
    static constexpr bool PERM = false, AFTER_DRAIN = true;
    const float* base; float* out; bf16_t* xn; int ldc; const float* bias; PanelStats st1, st2; unsigned poison;
    __device__ __forceinline__ void refuse(size_t i0, size_t stride, int M, int N) const { const float q = __builtin_nanf(""); for (size_t i = i0; i < (size_t)M * N; i += stride) { const size_t o = (i / N) * ldc + i % N; out[o] = q; xn[o] = (bf16_t)0x7fc0u; }
        if (i0 == 0) { unsigned expect = 0u; __hip_atomic_compare_exchange_strong(st1.tmo + 1, &expect, 0x7f0u, __ATOMIC_RELAXED, __ATOMIC_RELAXED, __HIP_MEMORY_SCOPE_AGENT); __hip_atomic_store(st1.tmo, 1u, __ATOMIC_RELAXED, __HIP_MEMORY_SCOPE_AGENT); } }
    __device__ __forceinline__ void fused(f32x4 (&acc)[2][2][4][2], const Unit& u, int wr, int wc, int fr, int fq, PG8_LAS unsigned char* lds, int wid, int lane) const {
        typedef float f32x2v __attribute__((ext_vector_type(2))); typedef unsigned u32x2v __attribute__((ext_vector_type(2)));
        const PG8_LAS f32x2v* S = (const PG8_LAS f32x2v*)(lds + 8192);
        const int col0 = u.pn * BM + wc * 32 + 4 * fq;
#pragma unroll
        for (int bj = 0; bj < 2; ++bj)
#pragma unroll
            for (int n = 0; n < 2; ++n) { const f32x4 bv = bias ? *(const f32x4*)(bias + col0 + bj * HALF + n * 16) : (f32x4){0.f, 0.f, 0.f, 0.f};
#pragma unroll
                for (int ai = 0; ai < 2; ++ai)
#pragma unroll
                    for (int m = 0; m < 4; ++m) acc[ai][bj][m][n] += bv; }
        bool bad = st1.run(acc, u, wr, wc, fr, fq, lds, wid, lane) || poison != 0u;
        const float qnan = __builtin_nanf("");
#pragma unroll
        for (int ai = 0; ai < 2; ++ai)
#pragma unroll
            for (int m = 0; m < 4; ++m) { const int r = ai * HALF + wr * 64 + m * 16 + fr; const f32x2v sr = S[r]; const size_t off = (size_t)(u.pm * BM + r) * ldc + col0;
#pragma unroll
                for (int bj = 0; bj < 2; ++bj)
#pragma unroll
                    for (int n = 0; n < 2; ++n) { const f32x4 bs = *(const f32x4*)(base + off + bj * HALF + n * 16); acc[ai][bj][m][n] = bs + (acc[ai][bj][m][n] - sr.x) * sr.y; }
                asm volatile("" : "+v"(acc[ai][0][m][0]), "+v"(acc[ai][0][m][1]), "+v"(acc[ai][1][m][0]), "+v"(acc[ai][1][m][1]));
                if (m & 1) asm volatile("" ::: "memory"); }
        const bool bad1 = bad;
        bad = st2.run(acc, u, wr, wc, fr, fq, lds, wid, lane) || bad;
#pragma unroll
        for (int ai = 0; ai < 2; ++ai)
#pragma unroll
            for (int m = 0; m < 4; ++m) { const int r = ai * HALF + wr * 64 + m * 16 + fr; const f32x2v sr = S[r]; const size_t off = (size_t)(u.pm * BM + r) * ldc + col0;
#pragma unroll
                for (int bj = 0; bj < 2; ++bj)
#pragma unroll
                    for (int n = 0; n < 2; ++n) { const f32x4 x1 = acc[ai][bj][m][n]; *(f32x4*)(out + off + bj * HALF + n * 16) = bad1 ? (f32x4){qnan, qnan, qnan, qnan} : x1;
                        const f32x4 o = (x1 - sr.x) * sr.y; u32x2v w; w.x = cvt_pk_bf16(o[0], o[1]); w.y = cvt_pk_bf16(o[2], o[3]);
                        if (bad) { w.x = 0x7fc07fc0u; w.y = 0x7fc07fc0u; } *(u32x2v*)(xn + off + bj * HALF + n * 16) = w; }
                asm volatile("" ::: "memory"); }
    }
};

template <class Epi, class Sched, bool STAMP = false>
__device__ __forceinline__ void gemm_phase(PG8_LAS unsigned char* lds, const Gemm g, const Sched& S, const Epi& E, unsigned long long* stamps) {
    const int tid = threadIdx.x, wid = __builtin_amdgcn_readfirstlane(tid >> 6), lane = tid & 63, wr = wid >> 2, wc = wid & 3, fr = lane & 15, fq = lane >> 4;
    const int K = g.K, nt = K / BK;
    int ts_lo = 0, ts_hi = 0, nts = 0; const unsigned long long rt_entry = STAMP ? (unsigned long long)wall_clock64() : 0ull;
#define PG8_STAMP() do { if (STAMP && wid == 0 && nts < 64) { const unsigned long long _c = (unsigned long long)clock64(); \
        ts_lo = (lane == nts) ? (int)(unsigned)_c : ts_lo; ts_hi = (lane == nts) ? (int)(unsigned)(_c >> 32) : ts_hi; ++nts; } } while (0)
    PG8_STAMP();
    unsigned voffA[2], voffB[2];
#pragma unroll
    for (int i = 0; i < 2; ++i) { int R, C; stage_rc(tid * 16 + i * 8192, R, C); const int Rb = Epi::PERM ? ((R & ~31) + perm32(R & 31)) : R;
        voffA[i] = (unsigned)(R * K + C) * 2u; voffB[i] = (unsigned)(Rb * K + C) * 2u; }
    const size_t kstep = (size_t)(BK * 2);
    const size_t hstep = (size_t)HALF * K * 2;
    const size_t tstep = 2 * hstep;
    const unsigned ldsw = (unsigned)wid * 1024u;
    const int aoff = lds_byte(wr * 64 + fr, fq * 8), boff = lds_byte(wc * 32 + fr, fq * 8);
#define PG8_SA(b, h) (((b) * 2 + (h)) * HTB)
#define PG8_SB(b, h) ((4 + (b) * 2 + (h)) * HTB)
#define PG8_STAGE(bufoff, gbase, voff) do { _Pragma("unroll") for (int _i = 0; _i < 2; ++_i) \
        __builtin_amdgcn_global_load_lds((const unsigned*)((const char*)(gbase) + (voff)[_i]), (PG8_LAS unsigned*)(lds + (bufoff) + ldsw + _i * 8192), 16, 0, 0); } while (0)
#define PG8_LDA(dst, b, h) do { _Pragma("unroll") for (int m = 0; m < 4; ++m) _Pragma("unroll") for (int k = 0; k < 2; ++k) dst[m][k] = *(const PG8_LAS bf16x8*)(lds + PG8_SA(b, h) + aoff + m * 2048 + k * 1024); } while (0)
#define PG8_LDB(dst, b, h) do { _Pragma("unroll") for (int n = 0; n < 2; ++n) _Pragma("unroll") for (int k = 0; k < 2; ++k) dst[n][k] = *(const PG8_LAS bf16x8*)(lds + PG8_SB(b, h) + boff + n * 2048 + k * 1024); } while (0)
#define PG8_MMA(ai, bj, At, Bt) do { __builtin_amdgcn_s_setprio(1); _Pragma("unroll") for (int m = 0; m < 4; ++m) _Pragma("unroll") for (int n = 0; n < 2; ++n) _Pragma("unroll") for (int k = 0; k < 2; ++k) \
        acc[ai][bj][m][n] = __builtin_amdgcn_mfma_f32_16x16x32_bf16(Bt[n][k], At[m][k], acc[ai][bj][m][n], 0, 0, 0); __builtin_amdgcn_s_setprio(0); } while (0)
#define PG8_WAIT_V(n) asm volatile("s_waitcnt vmcnt(" #n ")" ::: "memory")
#define PG8_WAIT_L(n) asm volatile("s_waitcnt lgkmcnt(" #n ")" ::: "memory")
#define PG8_BAR __builtin_amdgcn_s_barrier()
#define PG8_SCHED __builtin_amdgcn_sched_barrier(0)
    Unit cur, nxt; int ui = 0;
    if (!S.next(0, cur)) return;
    f32x4 acc[2][2][4][2];
#pragma unroll
    for (int a = 0; a < 2; ++a)
#pragma unroll
        for (int b = 0; b < 2; ++b)
#pragma unroll
            for (int m = 0; m < 4; ++m)
#pragma unroll
                for (int n = 0; n < 2; ++n) acc[a][b][m][n] = (f32x4){0.f, 0.f, 0.f, 0.f};
    bf16x8 At[4][2], B0[2][2], B1[2][2];
    const char* cA = (const char*)g.A + (size_t)cur.pm * tstep; const char* cB = (const char*)g.Bt + (size_t)cur.pn * tstep;
    S.a_ready(cur);
    PG8_STAGE(PG8_SB(0, 0), cB, voffB); PG8_STAGE(PG8_SA(0, 0), cA, voffA); PG8_STAGE(PG8_SB(0, 1), cB + hstep, voffB); PG8_STAGE(PG8_SA(0, 1), cA + hstep, voffA);
    if (wr == 1) PG8_BAR;
    PG8_WAIT_V(4); PG8_BAR;
    PG8_STAGE(PG8_SB(1, 0), cB + kstep, voffB); PG8_STAGE(PG8_SA(1, 0), cA + kstep, voffA); PG8_STAGE(PG8_SB(1, 1), cB + hstep + kstep, voffB);
    PG8_WAIT_V(6); PG8_BAR;
    PG8_STAMP();
    for (;;) {
        const bool has_next = S.next(ui + 1, nxt);
        const char* nA = has_next ? (const char*)g.A + (size_t)nxt.pm * tstep : cA; const char* nB = has_next ? (const char*)g.Bt + (size_t)nxt.pn * tstep : cB;
        for (int t = 0; t < nt; t += 2) {
            const bool last = (t == nt - 2);
            const char* a1 = cA + (size_t)(t + 1) * kstep;
            const char* a2 = last ? nA : cA + (size_t)(t + 2) * kstep; const char* b2 = last ? nB : cB + (size_t)(t + 2) * kstep;
            const char* a3 = a2 + kstep; const char* b3 = b2 + kstep;
            if (last && has_next) S.a_ready(nxt);
            PG8_LDB(B0, 0, 0); PG8_SCHED; PG8_LDA(At, 0, 0); PG8_STAGE(PG8_SA(1, 1), a1 + hstep, voffA);
            PG8_WAIT_L(8); PG8_BAR; PG8_WAIT_L(0); PG8_MMA(0, 0, At, B0); PG8_BAR; PG8_SCHED;
            PG8_LDB(B1, 0, 1); PG8_STAGE(PG8_SB(0, 0), b2, voffB);
            PG8_BAR; PG8_WAIT_L(0); PG8_MMA(0, 1, At, B1); PG8_BAR;
            PG8_LDA(At, 0, 1); PG8_STAGE(PG8_SA(0, 0), a2, voffA);
            PG8_BAR; PG8_WAIT_L(0); PG8_MMA(1, 0, At, B0); PG8_BAR; PG8_SCHED;
            PG8_STAGE(PG8_SB(0, 1), b2 + hstep, voffB);
            PG8_WAIT_V(6); PG8_BAR; PG8_MMA(1, 1, At, B1); PG8_BAR;
            PG8_LDB(B0, 1, 0); PG8_SCHED; PG8_LDA(At, 1, 0); PG8_STAGE(PG8_SA(0, 1), a2 + hstep, voffA);
            PG8_WAIT_L(8); PG8_BAR; PG8_WAIT_L(0); PG8_MMA(0, 0, At, B0); PG8_BAR; PG8_SCHED;
            PG8_LDB(B1, 1, 1); PG8_STAGE(PG8_SB(1, 0), b3, voffB);
            PG8_BAR; PG8_WAIT_L(0); PG8_MMA(0, 1, At, B1); PG8_BAR;
            PG8_LDA(At, 1, 1); PG8_STAGE(PG8_SA(1, 0), a3, voffA);
            PG8_BAR; PG8_WAIT_L(0); PG8_MMA(1, 0, At, B0); PG8_BAR; PG8_SCHED;
            PG8_STAGE(PG8_SB(1, 1), b3 + hstep, voffB);
            PG8_WAIT_V(6); PG8_BAR; PG8_MMA(1, 1, At, B1); PG8_BAR;
        }
        PG8_STAMP();
        if constexpr (!Epi::AFTER_DRAIN) { E(acc, cur, wr, wc, fr, fq); S.done(cur); }
        PG8_STAMP();
        if (!has_next) break;
#pragma unroll
        for (int a = 0; a < 2; ++a)
#pragma unroll
            for (int b = 0; b < 2; ++b)
#pragma unroll
                for (int m = 0; m < 4; ++m)
#pragma unroll
                    for (int n = 0; n < 2; ++n) acc[a][b][m][n] = (f32x4){0.f, 0.f, 0.f, 0.f};
        cur = nxt; cA = nA; cB = nB; ++ui;
    }
    PG8_WAIT_V(0);
    if (wr == 0) PG8_BAR;
    PG8_BAR;
    if constexpr (Epi::AFTER_DRAIN) { E.fused(acc, cur, wr, wc, fr, fq, lds, wid, lane); S.done(cur); }
    PG8_STAMP();
    if (STAMP && wid == 0) { stamps[lane] = lane < nts ? (((unsigned long long)(unsigned)ts_hi << 32) | (unsigned)ts_lo) : 0ull;
        if (lane == 62) stamps[62] = rt_entry; if (lane == 63) stamps[63] = (unsigned long long)wall_clock64(); }
#undef PG8_STAMP
#undef PG8_SA
#undef PG8_SB
#undef PG8_STAGE
#undef PG8_LDA
#undef PG8_LDB
#undef PG8_MMA
#undef PG8_WAIT_V
#undef PG8_WAIT_L
#undef PG8_BAR
#undef PG8_SCHED
}
}
#define HD __host__ __device__ __forceinline__
#define HY_LDS __attribute__((address_space(3)))
#ifndef HY_F2_STRUCT
typedef float f2 __attribute__((ext_vector_type(2)));
#else
struct __attribute__((aligned(8))) f2 { float x, y; };
#ifndef HD
#define HD __host__ __device__ __forceinline__
#endif
HD f2 operator+(f2 a, f2 b) { return f2{a.x + b.x, a.y + b.y}; }
HD f2 operator-(f2 a, f2 b) { return f2{a.x - b.x, a.y - b.y}; }
HD f2 operator*(f2 a, float b) { return f2{a.x * b, a.y * b}; }
#endif
#ifndef HD
#define HD __host__ __device__ __forceinline__
#endif
#ifndef HY_LDS
#define HY_LDS
#endif
typedef HY_LDS f2* hy_ldsp;
typedef const HY_LDS f2* hy_cldsp;
#if defined(__HIP_DEVICE_COMPILE__)
#define HY_OPAQUE(v) asm volatile("" : "+v"(v))
#else
#define HY_OPAQUE(v) asm volatile("" : "+r"(v))
#endif
namespace hy {
constexpr int FL = 16384;
constexpr int LDS_F2 = 32 * 560;
HD int laddr(int d2, int d1, int d0) { return d2 * 560 + d1 * 17 + d0; }
HD f2 cmul(f2 a, f2 b) { return (f2){a.x * b.x - a.y * b.y, a.x * b.y + a.y * b.x}; }
HD f2 cconj(f2 a) { return (f2){a.x, -a.y}; }
constexpr float C32[32] = { 1.0f, 0.98078528040323044913f, 0.92387953251128675613f, 0.83146961230254523708f, 0.70710678118654752440f, 0.55557023301960222474f, 0.38268343236508977173f, 0.19509032201612826785f,
                            0.0f, -0.19509032201612826785f, -0.38268343236508977173f, -0.55557023301960222474f, -0.70710678118654752440f, -0.83146961230254523708f, -0.92387953251128675613f, -0.98078528040323044913f,
                           -1.0f, -0.98078528040323044913f, -0.92387953251128675613f, -0.83146961230254523708f, -0.70710678118654752440f, -0.55557023301960222474f, -0.38268343236508977173f, -0.19509032201612826785f,
                            0.0f, 0.19509032201612826785f, 0.38268343236508977173f, 0.55557023301960222474f, 0.70710678118654752440f, 0.83146961230254523708f, 0.92387953251128675613f, 0.98078528040323044913f };
constexpr float S32[32] = { 0.0f, 0.19509032201612826785f, 0.38268343236508977173f, 0.55557023301960222474f, 0.70710678118654752440f, 0.83146961230254523708f, 0.92387953251128675613f, 0.98078528040323044913f,
                            1.0f, 0.98078528040323044913f, 0.92387953251128675613f, 0.83146961230254523708f, 0.70710678118654752440f, 0.55557023301960222474f, 0.38268343236508977173f, 0.19509032201612826785f,
                            0.0f, -0.19509032201612826785f, -0.38268343236508977173f, -0.55557023301960222474f, -0.70710678118654752440f, -0.83146961230254523708f, -0.92387953251128675613f, -0.98078528040323044913f,
                           -1.0f, -0.98078528040323044913f, -0.92387953251128675613f, -0.83146961230254523708f, -0.70710678118654752440f, -0.55557023301960222474f, -0.38268343236508977173f, -0.19509032201612826785f };
template <int BITS> HD constexpr int brev(int k) { int r = 0; for (int i = 0; i < BITS; ++i) r |= ((k >> i) & 1) << (BITS - 1 - i); return r; }
template <bool INV> HD f2 twmul32(f2 d, int k) {
    k &= 31;
    if (k == 0) return d;
    if (k == 8) return INV ? (f2){-d.y, d.x} : (f2){d.y, -d.x};
    if (k == 16) return (f2){-d.x, -d.y};
    if (k == 24) return INV ? (f2){d.y, -d.x} : (f2){-d.y, d.x};
    const float c = C32[k], s = INV ? S32[k] : -S32[k];
    return (f2){d.x * c - d.y * s, d.x * s + d.y * c};
}
template <int N, int SPAN, bool INV> struct DifStage {
    static HD void run(f2 (&v)[N]) {
#pragma unroll
        for (int blk = 0; blk < N; blk += 2 * SPAN)
#pragma unroll
            for (int j = 0; j < SPAN; ++j) {
                const f2 a = v[blk + j], b = v[blk + j + SPAN];
                v[blk + j] = a + b;
                v[blk + j + SPAN] = twmul32<INV>(a - b, j * (16 / SPAN));
            }
        DifStage<N, SPAN / 2, INV>::run(v);
    }
};
template <int N, bool INV> struct DifStage<N, 0, INV> { static HD void run(f2 (&)[N]) {} };
template <int N, bool INV> HD void dft_inreg(f2 (&v)[N]) { DifStage<N, N / 2, INV>::run(v); }

HD f2 cis_rev(float rev) {
#if defined(__HIP_DEVICE_COMPILE__)
    return (f2){__builtin_amdgcn_cosf(rev), __builtin_amdgcn_sinf(rev)};
#else
    return (f2){(float)cos(6.283185307179586476925 * (double)rev), (float)sin(6.283185307179586476925 * (double)rev)};
#endif
}
#define HY_CHAIN_DECL(b0, s) f2 _c0 = (b0), _c1 = hy::cmul(_c0, (s)), _s2 = hy::cmul((s), (s)), _c2 = hy::cmul(_c0, _s2), _c3 = hy::cmul(_c1, _s2), _s4 = hy::cmul(_s2, _s2)

template <bool INV_UNUSED = false> HD void fwd_p1(f2 (&x)[32], int t, hy_ldsp lds) {
    HY_OPAQUE(t);
    dft_inreg<32, false>(x);
    const f2 w1 = cis_rev(-(float)t * (1.0f / 16384.0f));
    HY_CHAIN_DECL(((f2){1.0f, 0.0f}), w1);
    const int base = laddr(0, t >> 4, t & 15);
#pragma unroll
    for (int q = 0; q < 8; ++q) {
        lds[base + (4 * q + 0) * 560] = cmul(x[brev<5>(4 * q + 0)], _c0);
        lds[base + (4 * q + 1) * 560] = cmul(x[brev<5>(4 * q + 1)], _c1);
        lds[base + (4 * q + 2) * 560] = cmul(x[brev<5>(4 * q + 2)], _c2);
        lds[base + (4 * q + 3) * 560] = cmul(x[brev<5>(4 * q + 3)], _c3);
        _c0 = cmul(_c0, _s4); _c1 = cmul(_c1, _s4); _c2 = cmul(_c2, _s4); _c3 = cmul(_c3, _s4);
    }
}
HD void fwd_p2(int t, hy_ldsp lds) {
    HY_OPAQUE(t);
    f2 x[32];
    const int d2 = t >> 4, d0 = t & 15, base = laddr(d2, 0, d0);
#pragma unroll
    for (int j = 0; j < 32; ++j) x[j] = lds[base + j * 17];
    dft_inreg<32, false>(x);
    const f2 w1 = cis_rev(-(float)d0 * (1.0f / 512.0f));
    HY_CHAIN_DECL(((f2){1.0f, 0.0f}), w1);
#pragma unroll
    for (int q = 0; q < 8; ++q) {
        lds[base + (4 * q + 0) * 17] = cmul(x[brev<5>(4 * q + 0)], _c0);
        lds[base + (4 * q + 1) * 17] = cmul(x[brev<5>(4 * q + 1)], _c1);
        lds[base + (4 * q + 2) * 17] = cmul(x[brev<5>(4 * q + 2)], _c2);
        lds[base + (4 * q + 3) * 17] = cmul(x[brev<5>(4 * q + 3)], _c3);
        _c0 = cmul(_c0, _s4); _c1 = cmul(_c1, _s4); _c2 = cmul(_c2, _s4); _c3 = cmul(_c3, _s4);
    }
}
HD void fwd_p3(f2 (&s)[2][16], int t, hy_cldsp lds) {
#pragma unroll
    for (int h = 0; h < 2; ++h) {
        const int R = t + 512 * h, base = laddr(R >> 5, R & 31, 0);
#pragma unroll
        for (int j = 0; j < 16; ++j) s[h][j] = lds[base + j];
        dft_inreg<16, false>(s[h]);
    }
}
HD void inv_p1(f2 (&s)[2][16], int t, hy_ldsp lds) {
    HY_OPAQUE(t);
#pragma unroll
    for (int h = 0; h < 2; ++h) {
        const int R = t + 512 * h, d1 = R & 31, base = laddr(R >> 5, d1, 0);
        f2 y[16];
#pragma unroll
        for (int k = 0; k < 16; ++k) y[k] = s[h][brev<4>(k)];
        dft_inreg<16, true>(y);
        const f2 w1 = cis_rev((float)d1 * (1.0f / 512.0f));
        HY_CHAIN_DECL(((f2){1.0f, 0.0f}), w1);
#pragma unroll
        for (int q = 0; q < 4; ++q) {
            lds[base + 4 * q + 0] = cmul(y[brev<4>(4 * q + 0)], _c0);
            lds[base + 4 * q + 1] = cmul(y[brev<4>(4 * q + 1)], _c1);
            lds[base + 4 * q + 2] = cmul(y[brev<4>(4 * q + 2)], _c2);
            lds[base + 4 * q + 3] = cmul(y[brev<4>(4 * q + 3)], _c3);
            _c0 = cmul(_c0, _s4); _c1 = cmul(_c1, _s4); _c2 = cmul(_c2, _s4); _c3 = cmul(_c3, _s4);
        }
    }
}
HD void inv_p2(int t, hy_ldsp lds) {
    HY_OPAQUE(t);
    f2 x[32];
    const int d2 = t >> 4, d0 = t & 15, base = laddr(d2, 0, d0);
#pragma unroll
    for (int j = 0; j < 32; ++j) x[j] = lds[base + j * 17];
    dft_inreg<32, true>(x);
    const f2 b0 = cis_rev((float)(d0 * d2) * (1.0f / 16384.0f)), st = cis_rev((float)d2 * (1.0f / 1024.0f));
    HY_CHAIN_DECL(b0, st);
#pragma unroll
    for (int q = 0; q < 8; ++q) {
        lds[base + (4 * q + 0) * 17] = cmul(x[brev<5>(4 * q + 0)], _c0);
        lds[base + (4 * q + 1) * 17] = cmul(x[brev<5>(4 * q + 1)], _c1);
        lds[base + (4 * q + 2) * 17] = cmul(x[brev<5>(4 * q + 2)], _c2);
        lds[base + (4 * q + 3) * 17] = cmul(x[brev<5>(4 * q + 3)], _c3);
        _c0 = cmul(_c0, _s4); _c1 = cmul(_c1, _s4); _c2 = cmul(_c2, _s4); _c3 = cmul(_c3, _s4);
    }
}
HD void inv_p3(f2 (&x)[32], int t, hy_cldsp lds) {
    f2 y[32];
    const int base = laddr(0, t >> 4, t & 15);
#pragma unroll
    for (int j = 0; j < 32; ++j) y[j] = lds[base + j * 560];
    dft_inreg<32, true>(y);
#pragma unroll
    for (int j = 0; j < 32; ++j) x[j] = y[brev<5>(j)];
}
}
#define HY_FENCE() asm volatile("" ::: "memory")
namespace hy {
typedef unsigned short bf16_t;
HD float bf2f(bf16_t v) { return __builtin_bit_cast(float, ((unsigned)v) << 16); }
HD bf16_t f2bf(float f) { unsigned u = __builtin_bit_cast(unsigned, f); return (bf16_t)((u + 0x7fffu + ((u >> 16) & 1u)) >> 16); }
constexpr int SEQ = 16384, NTOK = 2 * SEQ;
struct JobArgs {
    const bf16_t* ch;
    const bf16_t* kt;
    const float* conv_w;
    const float* conv_b;
    const float* hbias;
    f2* sbase;
    bf16_t* yh;
};
#if defined(__HIP_DEVICE_COMPILE__)
typedef unsigned hy_u2 __attribute__((ext_vector_type(2)));
struct Stash { __amdgpu_buffer_rsrc_t r; };
__device__ __forceinline__ Stash make_stash(const JobArgs& J) { Stash s; s.r = __builtin_amdgcn_make_buffer_rsrc(J.sbase, (short)0, 393216, 0x00020000); return s; }
__device__ __forceinline__ f2 st_load(const Stash& s, int r, int j, int t) { const hy_u2 v = __builtin_amdgcn_raw_buffer_load_b64(s.r, t * 8, r * 131072 + j * 4096, 0); return __builtin_bit_cast(f2, v); }
__device__ __forceinline__ void st_store(const Stash& s, int r, int j, int t, f2 v) { __builtin_amdgcn_raw_buffer_store_b64(__builtin_bit_cast(hy_u2, v), s.r, t * 8, r * 131072 + j * 4096, 0); }
#else
struct Stash { f2* p; };
inline Stash make_stash(const JobArgs& J) { return Stash{J.sbase}; }
inline f2 st_load(const Stash& s, int r, int j, int t) { return s.p[r * 16384 + j * 512 + t]; }
inline void st_store(const Stash& s, int r, int j, int t, f2 v) { s.p[r * 16384 + j * 512 + t] = v; }
#endif
HD void twist_consts(bool tw, int t, f2& base, f2& step) {
    HY_OPAQUE(t);
    if (tw) { base = cis_rev(-(float)t * (1.0f / 32768.0f)); step = (f2){0.99518472667219688624f, -0.09801714032956060199f}; }
    else { base = (f2){1.0f, 0.0f}; step = (f2){1.0f, 0.0f}; }
}
template <bool FIRST, bool LAST> HD float sconv(const bf16_t* pj, int t, float w0, float w1, float w2, float cb) {
    const float pm = (!FIRST || t > 0) ? bf2f(pj[t - 1]) : 0.0f, pc = bf2f(pj[t]), pp = (!LAST || t < 511) ? bf2f(pj[t + 1]) : 0.0f;
    return cb + w0 * pm + w1 * pc + w2 * pp;
}
#define HY_SCONV(j, p, t, w0, w1, w2, cb) ((j) == 0 ? hy::sconv<true, false>((p) + (j) * 512, t, w0, w1, w2, cb) : (j) == 31 ? hy::sconv<false, true>((p) + (j) * 512, t, w0, w1, w2, cb) : hy::sconv<false, false>((p) + (j) * 512, t, w0, w1, w2, cb))
HD void seg_filter_p1(const JobArgs& J, int c, int o, bool tw, int t, hy_ldsp lds) {
    HY_OPAQUE(t); HY_OPAQUE(c);
    f2 x[32];
    const bf16_t* kf = J.kt + (size_t)((o * 2 + 0) * 512 + c) * SEQ;
    const bf16_t* kr = J.kt + (size_t)((o * 2 + 1) * 512 + c) * SEQ;
    const float sgn = tw ? -1.0f : 1.0f, bias = J.hbias[o * 512 + c];
    f2 base, step; twist_consts(tw, t, base, step);
    f2 cur = base;
#pragma unroll
    for (int j = 0; j < 32; ++j) {
        const int n = j * 512 + t;
        float a = bf2f(kf[n]) + sgn * bf2f(kr[SEQ - 1 - n]);
        if (n == 0) a += bias;
        a *= (1.0f / 32768.0f);
        x[j] = cur * a;
        cur = cmul(cur, step);
        if ((j & 7) == 7) HY_FENCE();
    }
    fwd_p1(x, t, lds);
}
HD void seg_prep(const JobArgs& J, const Stash& S, int c, int t) {
    HY_OPAQUE(t); HY_OPAQUE(c);
    const bf16_t* p0 = J.ch + (size_t)c * NTOK; const bf16_t* p1 = p0 + SEQ;
    const float w0 = J.conv_w[c], w1 = J.conv_w[1536 + c], w2 = J.conv_w[3072 + c], cb = J.conv_b[c];
#pragma unroll
    for (int j = 0; j < 32; ++j) {
        st_store(S, 1, j, t, (f2){HY_SCONV(j, p0, t, w0, w1, w2, cb), HY_SCONV(j, p1, t, w0, w1, w2, cb)});
        if ((j & 3) == 3) HY_FENCE();
    }
}
HD void seg_data_p1(const Stash& S, bool tw, int t, hy_ldsp lds) {
    HY_OPAQUE(t);
    f2 x[32];
    f2 base, step; twist_consts(tw, t, base, step);
    f2 cur = base;
#pragma unroll
    for (int j = 0; j < 32; ++j) { const f2 z = st_load(S, 1, j, t); x[j] = cmul(z, cur); cur = cmul(cur, step); if ((j & 7) == 7) HY_FENCE(); }
    fwd_p1(x, t, lds);
}
HD void seg_filter_p3(const Stash& S, int t, hy_cldsp lds) {
    f2 K[2][16];
    fwd_p3(K, t, lds);
#pragma unroll
    for (int h = 0; h < 2; ++h)
#pragma unroll
        for (int i = 0; i < 16; ++i) st_store(S, 2, h * 16 + i, t, K[h][i]);
    HY_FENCE();
}
HD void seg_mul(const Stash& S, int t, hy_ldsp lds) {
    f2 s[2][16];
    fwd_p3(s, t, lds);
#pragma unroll
    for (int h = 0; h < 2; ++h) {
#pragma unroll
        for (int i = 0; i < 16; ++i) s[h][i] = cmul(s[h][i], st_load(S, 2, h * 16 + i, t));
        HY_FENCE();
    }
    inv_p1(s, t, lds);
}
HD void seg_out(const JobArgs& J, const Stash& S, int c, int o, bool tw, int t, hy_cldsp lds) {
    HY_OPAQUE(t); HY_OPAQUE(c);
    f2 x[32];
    inv_p3(x, t, lds);
    if (!tw) {
#pragma unroll
        for (int j = 0; j < 32; ++j) st_store(S, 0, j, t, x[j]);
        HY_FENCE();
        return;
    }
    f2 base, step; twist_consts(true, t, base, step);
    f2 cur = cconj(base); const f2 stc = cconj(step);
    const int row = (o == 0 ? 512 : 1024) + c;
    const bf16_t* p0 = J.ch + (size_t)row * NTOK; const bf16_t* p1 = p0 + SEQ;
    const float w0 = J.conv_w[row], w1 = J.conv_w[1536 + row], w2 = J.conv_w[3072 + row], cb = J.conv_b[row];
    const bf16_t* g0 = J.ch + (size_t)(1536 + c) * NTOK; const bf16_t* g1 = g0 + SEQ;
#pragma unroll
    for (int j = 0; j < 32; ++j) {
        const int n = j * 512 + t;
        const f2 r = cmul(x[j], cur) + st_load(S, 0, j, t); cur = cmul(cur, stc);
        const float a0 = HY_SCONV(j, p0, t, w0, w1, w2, cb) * r.x, a1 = HY_SCONV(j, p1, t, w0, w1, w2, cb) * r.y;
        if (o == 0) st_store(S, 1, j, t, (f2){a0, a1});
        else {
            const float q0 = bf2f(g0[n]), q1 = bf2f(g1[n]);
            bf16_t* y = J.yh + (size_t)c * NTOK;
            y[n] = f2bf(a0 * q0 / (1.0f + __builtin_expf(-q0)));
            y[SEQ + n] = f2bf(a1 * q1 / (1.0f + __builtin_expf(-q1)));
        }
        if ((j & 3) == 3) HY_FENCE();
    }
}
}
namespace hm {
typedef _Float16 h8 __attribute__((ext_vector_type(8)));
typedef float f32x16 __attribute__((ext_vector_type(16)));
typedef unsigned u4 __attribute__((ext_vector_type(4)));
typedef unsigned u2 __attribute__((ext_vector_type(2)));
typedef unsigned short bf16_t;
constexpr int RS = 132, IMG_DW = 128 * RS;
constexpr int SEQ = 16384, NTOK = 2 * SEQ;
#ifndef HM_LAS
#define HM_LAS __attribute__((address_space(3)))
#endif
__device__ __forceinline__ float asf(unsigned v) { return __builtin_bit_cast(float, v); }
__device__ __forceinline__ unsigned pkh(float re, float im) { return __builtin_bit_cast(unsigned, __builtin_amdgcn_cvt_pkrtz(re, im)); }
__device__ __forceinline__ f2 cisr(float rev) { return (f2){__builtin_amdgcn_cosf(rev), __builtin_amdgcn_sinf(rev)}; }
__device__ __forceinline__ f2 cm(f2 a, f2 b) { return (f2){a.x * b.x - a.y * b.y, a.x * b.y + a.y * b.x}; }
__device__ __forceinline__ float bf2f(bf16_t v) { return __builtin_bit_cast(float, ((unsigned)v) << 16); }
__device__ __forceinline__ bf16_t f2bf(float f) { unsigned u = __builtin_bit_cast(unsigned, f); return (bf16_t)((u + 0x7fffu + ((u >> 16) & 1u)) >> 16); }

struct Job {
    const bf16_t* ch; const bf16_t* kt; const float* conv_w; const float* conv_b; const float* hbias; bf16_t* yh;
    unsigned* dbg;
    __amdgpu_buffer_rsrc_t pk;
    __amdgpu_buffer_rsrc_t st;
};
#ifndef HM_ST_NOP
#define HM_ST_NOP "s_nop 7"
#endif
#ifdef HM_HOST_EMU
#define __builtin_amdgcn_sched_barrier(x) do { } while (0)
#define HM_KEEP1(nop, a) do { } while (0)
#define HM_KEEP2(nop, a, b) do { } while (0)
#else
#define HM_KEEP1(nop, a) asm volatile(nop : "+v"(a))
#define HM_KEEP2(nop, a, b) asm volatile(nop : "+v"(a), "+v"(b))
#endif
__device__ __forceinline__ void st_b128(u4 v, __amdgpu_buffer_rsrc_t r, int vo, int so) { __builtin_amdgcn_raw_buffer_store_b128(v, r, vo, so, 0); HM_KEEP1(HM_ST_NOP, v); }
__device__ __forceinline__ void st_b64(u2 v, __amdgpu_buffer_rsrc_t r, int vo, int so) { __builtin_amdgcn_raw_buffer_store_b64(v, r, vo, so, 0); HM_KEEP1(HM_ST_NOP, v); }
__device__ __forceinline__ void st_b16(short v, __amdgpu_buffer_rsrc_t r, int vo, int so) { int x = v; __builtin_amdgcn_raw_buffer_store_b16((short)x, r, vo, so, 0); HM_KEEP1(HM_ST_NOP, x); }
__device__ __forceinline__ void build_A(h8 (&A)[16], int wave, int lane) {
    const int r = lane & 31, h = lane >> 5, part = (r >> 3) & 1, k = 16 * wave + 8 * (r >> 4) + 4 * ((r >> 2) & 1) + (r & 3);
#pragma unroll
    for (int s = 0; s < 16; ++s) {
        h8 v;
#pragma unroll
        for (int d = 0; d < 4; ++d) {
            const int n = 8 * s + 4 * h + d;
            const float rev = (float)((k * n) & 127) * (1.0f / 128.0f);
            const float c = __builtin_amdgcn_cosf(rev), sn = __builtin_amdgcn_sinf(rev);
            v[2 * d] = (_Float16)(part ? -sn : c); v[2 * d + 1] = (_Float16)(part ? c : sn);
        }
        A[s] = v;
    }
}
__device__ __forceinline__ void flip_A(h8 (&A)[16], int lane) {
    unsigned m = ((lane >> 3) & 1) ? 0x00008000u : 0x80000000u; HM_KEEP1("", m);
#pragma unroll
    for (int s = 0; s < 16; ++s) { u4 v = __builtin_bit_cast(u4, A[s]); v.x ^= m; v.y ^= m; v.z ^= m; v.w ^= m; A[s] = __builtin_bit_cast(h8, v); }
}
#ifndef HM_HOST_EMU
__device__ __forceinline__ void mfma_pass(const HM_LAS unsigned* src, const h8 (&A)[16], f32x16 (&acc)[4], int lane) {
    const int l31 = lane & 31, h = lane >> 5;
    const HM_LAS unsigned* p = src + l31 * RS + 4 * h;
    constexpr int D = 8;
    h8 bq[D];
#pragma unroll
    for (int i = 0; i < D; ++i) bq[i] = *(const HM_LAS h8*)(p + (i >> 4) * 32 * RS + 8 * (i & 15));
    __builtin_amdgcn_sched_barrier(0);
#pragma unroll
    for (int cb = 0; cb < 4; ++cb) {
        f32x16 c;
#pragma unroll
        for (int i = 0; i < 16; ++i) c[i] = 0.0f;
#pragma unroll
        for (int s = 0; s < 16; ++s) {
            const int idx = cb * 16 + s;
            c = __builtin_amdgcn_mfma_f32_32x32x16_f16(A[s], bq[idx % D], c, 0, 0, 0);
            __builtin_amdgcn_sched_barrier(0);
            if (idx + D < 64) { bq[idx % D] = *(const HM_LAS h8*)(p + ((idx + D) >> 4) * 32 * RS + 8 * ((idx + D) & 15)); __builtin_amdgcn_sched_barrier(0); }
        }
        acc[cb] = c;
    }
    HM_KEEP2("s_nop 7", acc[3], bq[7]);
}
#endif
__device__ __forceinline__ void twiddle_store(const f32x16 (&acc)[4], HM_LAS unsigned* dst, int wave, int lane, float sgn, float scale) {
    int l31 = lane & 31, h = lane >> 5; HM_KEEP2("", l31, h);
    const int rb = 16 * wave + 4 * h;
#pragma unroll
    for (int cb = 0; cb < 4; ++cb) {
        const int col = 32 * cb + l31;
        f2 t0 = cisr(sgn * (float)((col * rb) & 16383) * (1.0f / 16384.0f)); t0.x *= scale; t0.y *= scale;
        const f2 s1 = cisr(sgn * (float)col * (1.0f / 16384.0f)), s8 = cisr(sgn * (float)(8 * col) * (1.0f / 16384.0f));
        f2 t[2][4]; t[0][0] = t0; t[0][1] = cm(t0, s1); t[0][2] = cm(t[0][1], s1); t[0][3] = cm(t[0][2], s1);
#pragma unroll
        for (int b = 0; b < 4; ++b) t[1][b] = cm(t[0][b], s8);
#pragma unroll
        for (int a = 0; a < 2; ++a)
#pragma unroll
            for (int b = 0; b < 4; ++b) {
                const f2 v = cm((f2){acc[cb][b + 8 * a], acc[cb][b + 8 * a + 4]}, t[a][b]);
                dst[(rb + 8 * a + b) * RS + col] = pkh(v.x, v.y);
            }
    }
}
__device__ __forceinline__ void stage_filter(const Job& J, int c, int o, bool tw, int t, HM_LAS unsigned* img) {
    int n0 = t & 127, g = t >> 7; HM_KEEP2("", n0, g);
    const __amdgpu_buffer_rsrc_t rf = __builtin_amdgcn_make_buffer_rsrc((void*)(J.kt + (size_t)((o * 2 + 0) * 512 + c) * SEQ), (short)0, SEQ * 2, 0x00020000);
    const __amdgpu_buffer_rsrc_t rr = __builtin_amdgcn_make_buffer_rsrc((void*)(J.kt + (size_t)((o * 2 + 1) * 512 + c) * SEQ), (short)0, SEQ * 2, 0x00020000);
    const int vf = (n0 + 4096 * g) * 2, vr = (SEQ - 1 - n0 - 4096 * g) * 2 - 7936;
    const float sgn = tw ? -64.0f : 64.0f, bias = J.hbias[o * 512 + c] * 64.0f;
    f2 curq = tw ? cisr(-(float)(n0 + 4096 * g) * (1.0f / 32768.0f)) : (f2){1.0f, 0.0f};
    const f2 se = tw ? (f2){0.99969881869620425f, -0.024541228522912288f} : (f2){1.0f, 0.0f};
    const f2 sq = tw ? (f2){0.99518472667219693f, -0.098017140329560604f} : (f2){1.0f, 0.0f};
#pragma unroll
    for (int q = 0; q < 8; ++q) {
        f2 cur = curq; u4 w;
#pragma unroll
        for (int e = 0; e < 4; ++e) {
            const float kfv = bf2f((bf16_t)__builtin_amdgcn_raw_buffer_load_b16(rf, vf, 256 * (4 * q + e), 0));
            const float krv = bf2f((bf16_t)__builtin_amdgcn_raw_buffer_load_b16(rr, vr, 256 * (31 - (4 * q + e)), 0));
            float a = 64.0f * kfv + sgn * krv;
            if (q == 0 && e == 0) a += (n0 == 0 && g == 0) ? bias : 0.0f;
#ifdef HM_IDFILT
            a = (q == 0 && e == 0 && n0 == 0 && g == 0) ? 64.0f : 0.0f;
#endif
            w[e] = pkh(cur.x * a, cur.y * a);
            cur = cm(cur, se);
        }
        *(HM_LAS u4*)(img + n0 * RS + 32 * g + 4 * q) = w;
        curq = cm(curq, sq);
    }
}
__device__ __forceinline__ void stage_data(const Job& J, int o, bool tw, int t, HM_LAS unsigned* img) {
    int n0 = t & 127, g = t >> 7; HM_KEEP2("", n0, g);
    f2 curq = tw ? cisr(-(float)(n0 + 4096 * g) * (1.0f / 32768.0f)) : (f2){1.0f, 0.0f};
    const f2 se = (f2){0.99969881869620425f, -0.024541228522912288f}, sq = (f2){0.99518472667219693f, -0.098017140329560604f};
    const int vo = (4096 * g + n0) * 8, vp = (4096 * g + n0) * 4;
    f2 zz[32];
    if (o == 0) {
#pragma unroll
        for (int i = 0; i < 32; ++i) { const unsigned w = __builtin_amdgcn_raw_buffer_load_b32(J.pk, vp, 128 * i * 4, 0); zz[i] = (f2){asf(w << 16), asf(w & 0xffff0000u)}; }
    } else {
#pragma unroll
        for (int i = 0; i < 32; ++i) { const u2 raw = __builtin_amdgcn_raw_buffer_load_b64(J.st, vo, 131072 + 128 * i * 8, 16); zz[i] = __builtin_bit_cast(f2, raw); }
    }
#pragma unroll
    for (int q = 0; q < 8; ++q) {
        f2 cur = curq; u4 w;
#pragma unroll
        for (int e = 0; e < 4; ++e) {
            f2 z = zz[4 * q + e];
            if (tw) { z = cm(z, cur); cur = cm(cur, se); }
            w[e] = pkh(z.x, z.y);
        }
        *(HM_LAS u4*)(img + n0 * RS + 32 * g + 4 * q) = w;
        if (tw) curq = cm(curq, sq);
    }
}
__device__ __forceinline__ void store_K(const Job& J, const f32x16 (&acc)[4], int t) {
#pragma unroll
    for (int cb = 0; cb < 4; ++cb)
#pragma unroll
        for (int i = 0; i < 4; ++i) {
            u4 w; w.x = __builtin_bit_cast(unsigned, acc[cb][4 * i] * (1.0f / 4096.0f)); w.y = __builtin_bit_cast(unsigned, acc[cb][4 * i + 1] * (1.0f / 4096.0f));
            w.z = __builtin_bit_cast(unsigned, acc[cb][4 * i + 2] * (1.0f / 4096.0f)); w.w = __builtin_bit_cast(unsigned, acc[cb][4 * i + 3] * (1.0f / 4096.0f));
            st_b128(w, J.st, t * 16, 262144 + (cb * 4 + i) * 8192);
        }
}
__device__ __forceinline__ void mul_store(const Job& J, const f32x16 (&acc)[4], HM_LAS unsigned* dst, int wave, int lane, int t) {
    const int l31 = lane & 31, h = lane >> 5, rb = 16 * wave + 4 * h;
#pragma unroll
    for (int cb = 0; cb < 4; ++cb) {
        float k[16];
#pragma unroll
        for (int i = 0; i < 4; ++i) { const u4 w = __builtin_amdgcn_raw_buffer_load_b128(J.st, t * 16, 262144 + (cb * 4 + i) * 8192, 16);
            k[4 * i] = asf(w.x); k[4 * i + 1] = asf(w.y); k[4 * i + 2] = asf(w.z); k[4 * i + 3] = asf(w.w); }
#pragma unroll
        for (int a = 0; a < 2; ++a) {
            u4 w;
#pragma unroll
            for (int b = 0; b < 4; ++b) {
                const float ur = acc[cb][b + 8 * a], ui = acc[cb][b + 8 * a + 4], kr = k[b + 8 * a], ki = k[b + 8 * a + 4];
                w[b] = pkh(ur * kr - ui * ki, ur * ki + ui * kr);
#ifdef HM_DEBUG
                if (t == 0 && cb == 0 && a == 0) printf("k: %g %g %g %g %g %g %g %g\n", k[0], k[1], k[2], k[3], k[4], k[5], k[6], k[7]);
                if (t == 0 && cb == 0 && a == 0) printf("mul dbg b %d ur %g ui %g kr %g ki %g -> %g %g\n", b, ur, ui, kr, ki, ur * kr - ui * ki, ur * ki + ui * kr);
#endif
            }
            *(HM_LAS u4*)(dst + (32 * cb + l31) * RS + rb + 8 * a) = w;
        }
    }
}
__device__ __forceinline__ float sconv_b(__amdgpu_buffer_rsrc_t r, int vo, int so, bool first, bool last, float w0, float w1, float w2, float cb) {
    const float vm = bf2f((bf16_t)__builtin_amdgcn_raw_buffer_load_b16(r, vo, so, 0)), vc = bf2f((bf16_t)__builtin_amdgcn_raw_buffer_load_b16(r, vo, so + 2, 0)),
                vp = bf2f((bf16_t)__builtin_amdgcn_raw_buffer_load_b16(r, vo, so + 4, 0));
    return cb + w0 * (first ? 0.0f : vm) + w1 * vc + w2 * (last ? 0.0f : vp);
}
__device__ __forceinline__ void final_epilogue(const Job& J, const f32x16 (&acc)[4], int c, int o, bool tw, int wave, int lane) {
    int l31 = lane & 31, h = lane >> 5; HM_KEEP2("", l31, h);
    const int rb = 16 * wave + 4 * h;
    const int vo = (128 * rb + l31) * 8;
    if (!tw) {
#pragma unroll
        for (int cb = 0; cb < 4; ++cb)
#pragma unroll
            for (int a = 0; a < 2; ++a)
#pragma unroll
                for (int b = 0; b < 4; ++b) {
                    u2 w; w.x = __builtin_bit_cast(unsigned, acc[cb][b + 8 * a] * 0.0625f); w.y = __builtin_bit_cast(unsigned, acc[cb][b + 8 * a + 4] * 0.0625f);
                    st_b64(w, J.st, vo, (32 * cb + 128 * (8 * a + b)) * 8);
                }
        return;
    }
    const __amdgpu_buffer_rsrc_t ry = __builtin_amdgcn_make_buffer_rsrc((void*)(J.yh + (size_t)c * NTOK), (short)0, NTOK * 2, 0x00020000);
    const int v2 = (128 * rb + l31) * 2, v4 = (128 * rb + l31) * 4;
    const int gofs = (o == 0 ? 65536 : 131072);
    const f2 sb = (f2){0.99969881869620425f, 0.024541228522912288f}, sa = (f2){0.98078528040323044913f, 0.19509032201612826785f};
#pragma unroll
    for (int cb = 0; cb < 4; ++cb) {
        f2 t0 = cisr((float)(128 * rb + 32 * cb + l31) * (1.0f / 32768.0f)); t0.x *= 0.0625f; t0.y *= 0.0625f;
        u2 rc[8]; unsigned gx[8];
#pragma unroll
        for (int i = 0; i < 8; ++i) { const int dn = 32 * cb + 128 * i + (i >= 4 ? 512 : 0);
            rc[i] = __builtin_amdgcn_raw_buffer_load_b64(J.st, vo, dn * 8, 16); gx[i] = __builtin_amdgcn_raw_buffer_load_b32(J.pk, v4, gofs + dn * 4, 0); }
#pragma unroll
        for (int a = 0; a < 2; ++a) {
            f2 cur = t0;
#pragma unroll
            for (int b = 0; b < 4; ++b) {
                const int dn = 32 * cb + 128 * (8 * a + b);
                const f2 r = cm((f2){acc[cb][b + 8 * a], acc[cb][b + 8 * a + 4]}, cur) + __builtin_bit_cast(f2, rc[4 * a + b]);
                cur = cm(cur, sb);
                const unsigned gw = gx[4 * a + b];
                const float a0 = asf(gw << 16) * r.x, a1 = asf(gw & 0xffff0000u) * r.y;
                if (o == 0) { u2 w; w.x = __builtin_bit_cast(unsigned, a0); w.y = __builtin_bit_cast(unsigned, a1); st_b64(w, J.st, vo, 131072 + dn * 8); }
                else { st_b16((short)f2bf(a0), ry, v2, dn * 2); st_b16((short)f2bf(a1), ry, v2, (SEQ + dn) * 2); }
            }
            t0 = cm(t0, sa);
        }
    }
}
__device__ __forceinline__ void load8(const bf16_t* p, int n0, float (&x)[10]) {
    const u4 v = *(const u4*)(p + n0);
    x[1] = asf(v.x << 16); x[2] = asf(v.x & 0xffff0000u); x[3] = asf(v.y << 16); x[4] = asf(v.y & 0xffff0000u); x[5] = asf(v.z << 16); x[6] = asf(v.z & 0xffff0000u); x[7] = asf(v.w << 16); x[8] = asf(v.w & 0xffff0000u);
    const float m = bf2f(p[n0 > 0 ? n0 - 1 : 0]), q = bf2f(p[n0 + 8 < SEQ ? n0 + 8 : SEQ - 1]);
    x[0] = n0 > 0 ? m : 0.0f; x[9] = n0 + 8 < SEQ ? q : 0.0f;
}
__device__ __forceinline__ void prep(const Job& J, int c, int t) {
    const float* cw = J.conv_w; const float* cbp = J.conv_b;
#pragma unroll 1
    for (int it = 0; it < 4; ++it) {
        const int n0 = 8 * (t + 512 * it);
        float o0[3][8], o1[3][8];
#pragma unroll
        for (int s = 0; s < 3; ++s) {
            const int row = s * 512 + c; const bf16_t* p = J.ch + (size_t)row * NTOK;
            const float w0 = cw[row], w1 = cw[1536 + row], w2 = cw[3072 + row], cbv = cbp[row];
            float x[10];
            load8(p, n0, x);
#pragma unroll
            for (int e = 0; e < 8; ++e) o0[s][e] = cbv + w0 * x[e] + w1 * x[e + 1] + w2 * x[e + 2];
            load8(p + SEQ, n0, x);
#pragma unroll
            for (int e = 0; e < 8; ++e) o1[s][e] = cbv + w0 * x[e] + w1 * x[e + 1] + w2 * x[e + 2];
        }
        { const bf16_t* g = J.ch + (size_t)(1536 + c) * NTOK; const u4 g0 = *(const u4*)(g + n0), g1 = *(const u4*)(g + SEQ + n0);
#pragma unroll
          for (int e = 0; e < 8; ++e) { const unsigned a = e < 2 ? g0.x : e < 4 ? g0.y : e < 6 ? g0.z : g0.w, b = e < 2 ? g1.x : e < 4 ? g1.y : e < 6 ? g1.z : g1.w;
              const float q0 = (e & 1) ? asf(a & 0xffff0000u) : asf(a << 16), q1 = (e & 1) ? asf(b & 0xffff0000u) : asf(b << 16);
              o0[2][e] *= q0 / (1.0f + __expf(-q0)); o1[2][e] *= q1 / (1.0f + __expf(-q1)); } }
#pragma unroll
        for (int s = 0; s < 3; ++s)
#pragma unroll
            for (int hh = 0; hh < 2; ++hh) { u4 w;
#pragma unroll
                for (int e = 0; e < 4; ++e) w[e] = (unsigned)f2bf(o0[s][4 * hh + e]) | ((unsigned)f2bf(o1[s][4 * hh + e]) << 16);
                st_b128(w, J.pk, n0 * 4 + hh * 16, s * 65536); }
    }
}
}
#define LAS __attribute__((address_space(3)))
#define GAS __attribute__((address_space(1)))
typedef unsigned short bf16;
typedef unsigned u32x4v __attribute__((ext_vector_type(4)));
typedef float f32x4v __attribute__((ext_vector_type(4)));

#ifndef MK_N_LAUNCHES
#define MK_N_LAUNCHES 1
#endif
constexpr int N_PHASES = 7;
constexpr int NT = 512;
constexpr int DM = 1024, SEQ = 16384, NB = 2, NTOK = NB * SEQ, DINP = 3072, DH = 512;
constexpr float LN_EPS = 1e-5f, DN_ALPHA = 1.18920711500272106672f;
constexpr size_t MiB = 1u << 20;
constexpr size_t WS_CTL = 0, CTL_BYTES = 1 * MiB;
constexpr size_t WS_MOD = WS_CTL + CTL_BYTES;
constexpr size_t WS_WINT = WS_MOD + 1 * MiB;
constexpr size_t WS_WOUTT = WS_WINT + 6 * MiB;
constexpr size_t WS_PWT = WS_WOUTT + 2 * MiB;
constexpr size_t WS_FWT = WS_PWT + 1 * MiB;
constexpr size_t WS_H3 = WS_FWT + 1 * MiB;
constexpr size_t WS_U = WS_H3 + 8 * MiB;
constexpr size_t WS_KT = WS_U + 64 * MiB;
constexpr size_t WS_CH = WS_KT + 64 * MiB;
constexpr size_t WS_TP = WS_CH + 128 * MiB;
constexpr size_t WS_PP = WS_TP + 64 * MiB;
constexpr size_t WS_YH = WS_PP + 32 * MiB;
constexpr size_t WS_ST = WS_YH + 32 * MiB;
constexpr size_t WS_END = WS_ST + 96 * MiB;
constexpr size_t WS_Y = WS_U;
constexpr int LDS_MISC = 143360;
constexpr int LDS_BYTES = LDS_MISC + 256;

#define XB_TMO      128
#define XB_XCNT(j)  (256  + 64 * (j))
#define XB_XSUB(j)  (1280 + 64 * (j))
#define XB_XGEN(j)  (2304 + 64 * (j))
#define XB_TOP      3328
#define XB_TOPGEN   3392
#define XCD_BAR_WORDS 3456
#define XB_SPIN_CAP (1u << 18)
__device__ __forceinline__ unsigned xb_ld(unsigned* p)              { return __hip_atomic_load(p, __ATOMIC_RELAXED, __HIP_MEMORY_SCOPE_AGENT); }
__device__ __forceinline__ unsigned xb_add(unsigned* p, unsigned v) { return __hip_atomic_fetch_add(p, v, __ATOMIC_RELAXED, __HIP_MEMORY_SCOPE_AGENT); }
__device__ __forceinline__ unsigned xb_xcc_id() { return (unsigned)__builtin_amdgcn_s_getreg((3 << 11) | 20) & 0xFu; }
#define XB_SPIN(cond, bar) do { unsigned _sp = 0; while (cond) { __builtin_amdgcn_s_sleep(1); \
    if ((++_sp & 255u) == 0u) { if (xb_ld(&(bar)[XB_TMO])) break; if (_sp > XB_SPIN_CAP) { atomicAdd(&(bar)[XB_TMO], 1u); break; } } } } while (0)
struct XcdBarrier { unsigned* bar; unsigned x; volatile LAS unsigned* st; };
__device__ __forceinline__ XcdBarrier xcd_barrier_post(unsigned* bar, volatile LAS unsigned* st) {
    XcdBarrier b; b.bar = bar; b.x = xb_xcc_id(); b.st = st;
    if (threadIdx.x == 0) (void)xb_add(&bar[XB_XCNT(b.x)], 1u);
    return b;
}
__device__ __forceinline__ void xcd_barrier_complete(unsigned* bar, unsigned x, unsigned& nloc, unsigned& nx) {
    const unsigned G = gridDim.x * gridDim.y * gridDim.z;
    unsigned sum, cnt, mine, sp = 0u;
    for (;;) {
        sum = 0u; cnt = 0u; mine = 0u;
#pragma unroll
        for (unsigned j = 0; j < 16; ++j) { const unsigned c = xb_ld(&bar[XB_XCNT(j)]); sum += c; cnt += (c > 0u) ? 1u : 0u; mine = (j == x) ? c : mine; }
        if (sum == G) break;
        __builtin_amdgcn_s_sleep(1);
        if ((++sp & 255u) == 0u) { if (xb_ld(&bar[XB_TMO])) break; if (sp > XB_SPIN_CAP) { atomicAdd(&bar[XB_TMO], 1u); break; } }
    }
    nloc = mine > 0u ? mine : 1u; nx = cnt > 0u ? cnt : 1u;
}
__device__ __forceinline__ void xcd_barrier(const XcdBarrier& b) {
    asm volatile("s_waitcnt vmcnt(0)" ::: "memory");
    __syncthreads();
    if (threadIdx.x == 0) {
        unsigned* bar = b.bar;
        __builtin_amdgcn_s_waitcnt(0);
        unsigned nloc = b.st[0], nx = b.st[1];
        if (nloc == 0u) { xcd_barrier_complete(bar, b.x, nloc, nx); b.st[0] = nloc; b.st[1] = nx; }
        const unsigned old = xb_add(&bar[XB_XSUB(b.x)], 1u);
        const unsigned gen = old / nloc;
        if (old + 1u == (gen + 1u) * nloc) {
            __builtin_amdgcn_fence(__ATOMIC_RELEASE, "agent");
            asm volatile("s_waitcnt vmcnt(0)" ::: "memory");
            const unsigned og = xb_add(&bar[XB_TOP], 1u);
            const unsigned tg = og / nx;
            if (og + 1u == (tg + 1u) * nx) xb_add(&bar[XB_TOPGEN], 1u);
            else XB_SPIN(xb_ld(&bar[XB_TOPGEN]) == tg, bar);
            __builtin_amdgcn_fence(__ATOMIC_ACQUIRE, "agent");
            xb_add(&bar[XB_XGEN(b.x)], 1u);
            asm volatile("s_waitcnt vmcnt(0)" ::: "memory");
        } else {
            XB_SPIN(xb_ld(&bar[XB_XGEN(b.x)]) == gen, bar);
            __builtin_amdgcn_fence(__ATOMIC_ACQUIRE, "agent");
            asm volatile("s_waitcnt vmcnt(0)" ::: "memory");
        }
    }
    __syncthreads();
}

__device__ __forceinline__ unsigned f2bf_u(float f) { unsigned u = __builtin_bit_cast(unsigned, f); return (u + 0x7fffu + ((u >> 16) & 1u)) >> 16; }
__device__ __forceinline__ unsigned pk2(float lo, float hi) { return f2bf_u(lo) | (f2bf_u(hi) << 16); }
__device__ __forceinline__ float bflo(unsigned w) { return __builtin_bit_cast(float, w << 16); }
__device__ __forceinline__ float bfhi(unsigned w) { return __builtin_bit_cast(float, w & 0xffff0000u); }
__device__ __forceinline__ float silu_f(float v) { return v / (1.0f + __expf(-v)); }

struct Args { const float* in[21]; float* out; unsigned char* ws; int ph_lo, ph_hi; };
enum { I_X = 0, I_C, I_WADA, I_BADA, I_WIN, I_BIN, I_CONVW, I_CONVB, I_FW1, I_FB1, I_FWI, I_FBI, I_FWO, I_FFREQ, I_HBIAS, I_POOLW, I_POOLS, I_WOUT, I_BOUT, I_LNG, I_LNB };
typedef const __attribute__((address_space(4))) Args* ArgsP;
struct Frame { LAS unsigned char* lds; int tid, lane, wave, G, blk; ArgsP ap; };
#define AP_FRESH(F) ArgsP ap = (F).ap; asm volatile("" : "+s"(ap))
template <class T> __device__ __forceinline__ T* wsp(ArgsP ap, size_t off) { return (T*)(ap->ws + off); }

__device__ void tile_transpose(const Frame& F, const float* src, int lds_, int k0s, int n0s, bf16* dst, int ldd, int n0d, int k0d, const float* colscale) {
    LAS float* tile = (LAS float*)F.lds;
    const int t = F.tid;
    if (src) {
        const int i = t >> 3, jq = (t & 7) * 8;
        const f32x4v a = *(const f32x4v*)(src + (size_t)(k0s + i) * lds_ + n0s + jq), b = *(const f32x4v*)(src + (size_t)(k0s + i) * lds_ + n0s + jq + 4);
#pragma unroll
        for (int e = 0; e < 4; ++e) { tile[i * 65 + jq + e] = a[e]; tile[i * 65 + jq + 4 + e] = b[e]; }
    }
    __syncthreads();
    {
        const int j = t >> 3, iq = (t & 7) * 8;
        float v[8];
#pragma unroll
        for (int e = 0; e < 8; ++e) v[e] = src ? tile[(iq + e) * 65 + j] : 0.0f;
        if (src && colscale) { const float s = colscale[n0s + j];
#pragma unroll
            for (int e = 0; e < 8; ++e) v[e] *= s; }
        u32x4v w; w.x = pk2(v[0], v[1]); w.y = pk2(v[2], v[3]); w.z = pk2(v[4], v[5]); w.w = pk2(v[6], v[7]);
        *(u32x4v*)(dst + (size_t)(n0d + j) * ldd + k0d + iq) = w;
    }
    __syncthreads();
}
__device__ void p0_prologue(const Frame& F) {
    const int t = F.tid, blk = F.blk, G = F.G;
    AP_FRESH(F);
    const float *c_in = ap->in[I_C], *w_ada = ap->in[I_WADA], *b_ada = ap->in[I_BADA]; float* mod = wsp<float>(ap, WS_MOD);
    for (int job = blk; job < 256; job += G) {
        const int j0 = job * 12;
        LAS float* red = (LAS float*)F.lds;
        if (t < 510) {
            const int r = t / 3, q = t % 3;
            f32x4v a0 = {0.f, 0.f, 0.f, 0.f}, a1 = {0.f, 0.f, 0.f, 0.f};
            for (int i = r; i < DM; i += 170) {
                const f32x4v w = *(const f32x4v*)(w_ada + (size_t)i * 3072 + j0 + 4 * q);
                const float s0 = silu_f(c_in[i]), s1 = silu_f(c_in[DM + i]);
                a0 += w * s0; a1 += w * s1;
            }
#pragma unroll
            for (int e = 0; e < 4; ++e) { red[(r * 3 + q) * 8 + e] = a0[e]; red[(r * 3 + q) * 8 + 4 + e] = a1[e]; }
        }
        __syncthreads();
        if (t < 24) {
            const int b = t / 12, jj = t % 12, q = jj >> 2, e = jj & 3;
            float s = 0.f;
            for (int r = 0; r < 170; ++r) s += red[(r * 3 + q) * 8 + b * 4 + e];
            mod[b * 3072 + j0 + jj] = s + b_ada[j0 + jj];
        }
        __syncthreads();
    }
    const float *w_in = ap->in[I_WIN], *w_out = ap->in[I_WOUT], *f_wo = ap->in[I_FWO], *pool_w = ap->in[I_POOLW], *pool_scale = ap->in[I_POOLS];
    bf16 *WinT = wsp<bf16>(ap, WS_WINT), *WoutT = wsp<bf16>(ap, WS_WOUTT), *FWT = wsp<bf16>(ap, WS_FWT), *PWT = wsp<bf16>(ap, WS_PWT);
    constexpr int J_WIN = 16 * 48, J_WOUT = 16 * 16, J_FW = 32 * 4, J_PW = 64, J_ALL = J_WIN + J_WOUT + J_FW + J_PW;
    for (int job = blk; job < J_ALL; job += G) {
        int j = job;
        if (j < J_WIN) { const int kt = j / 48, nt = j % 48; tile_transpose(F, w_in, 3072, kt * 64, nt * 64, WinT, 1024, nt * 64, kt * 64, nullptr); continue; }
        j -= J_WIN;
        if (j < J_WOUT) { const int kt = j / 16, nt = j % 16; tile_transpose(F, w_out, 1024, kt * 64, nt * 64, WoutT, 1024, nt * 64, kt * 64, nullptr); continue; }
        j -= J_WOUT;
        if (j < J_FW) { const int nt = j / 4, kt = j % 4; tile_transpose(F, kt == 0 ? f_wo : nullptr, 2048, 0, nt * 64, FWT, 256, nt * 64, kt * 64, nullptr); continue; }
        j -= J_FW;
        { const int nt = j / 8, kt = j % 8, g = nt / 2;
          const bool diag = (kt / 2) == g;
          tile_transpose(F, diag ? pool_w + (size_t)g * 128 * 128 : nullptr, 128, (kt & 1) * 64, (nt & 1) * 64, PWT, 512, nt * 64, kt * 64, pool_scale + g * 128);
        }
    }
    {
        const int lane = F.lane, gw = blk * 8 + F.wave, nw = G * 8;
        const float *f_w1 = ap->in[I_FW1], *f_wi = ap->in[I_FWI], *f_bi = ap->in[I_FBI]; bf16* H3 = wsp<bf16>(ap, WS_H3);
        const float freq = ap->in[I_FFREQ][lane], b1 = ap->in[I_FB1][lane], bi0 = f_bi[lane], bi1 = f_bi[64 + lane];
        for (int grp = gw; grp < SEQ / 8; grp += nw) {
            const int l0 = grp * 8;
            float feat[8];
#pragma unroll
            for (int p = 0; p < 8; ++p) {
                const int l = l0 + p; float f = 0.f;
                if (lane == 0) f = (float)l * (1.0f / (float)(SEQ - 1));
                else if (lane < 33) { const int bi = (lane - 1) & 15; const float fr = 1e-4f + (float)bi * ((15.0f - 1e-4f) / 15.0f);
                    const float w = (6.283185307179586f / (float)SEQ) * (float)l; const float arg = fr * w; f = lane < 17 ? cosf(arg) : -sinf(arg); }
                feat[p] = f;
            }
            float acc[8];
#pragma unroll
            for (int p = 0; p < 8; ++p) acc[p] = b1;
            for (int i = 0; i < 33; ++i) { const float w = f_w1[i * 64 + lane];
#pragma unroll
                for (int p = 0; p < 8; ++p) acc[p] += __shfl(feat[p], i) * w; }
            float h[8];
#pragma unroll
            for (int p = 0; p < 8; ++p) h[p] = sinf(freq * acc[p]);
#pragma unroll
            for (int layer = 0; layer < 2; ++layer) {
                const float* W = f_wi + layer * 4096; const float bb = layer ? bi1 : bi0;
#pragma unroll
                for (int p = 0; p < 8; ++p) acc[p] = bb;
                for (int i = 0; i < 64; ++i) { const float w = W[i * 64 + lane];
#pragma unroll
                    for (int p = 0; p < 8; ++p) acc[p] += __shfl(h[p], i) * w; }
#pragma unroll
                for (int p = 0; p < 8; ++p) h[p] = sinf(freq * acc[p]);
            }
#pragma unroll
            for (int p = 0; p < 8; ++p) { bf16* row = H3 + (size_t)(l0 + p) * 256; row[lane] = (bf16)f2bf_u(h[p]); row[64 + lane] = 0; row[128 + lane] = 0; row[192 + lane] = 0; }
        }
    }
}

namespace pg8 {
struct EpiRowBias {
    static constexpr bool PERM = true, AFTER_DRAIN = false;
    bf16_t* O; int ldc; const float* rbias;
    __device__ __forceinline__ void operator()(const f32x4 (&acc)[2][2][4][2], const Unit& u, int wr, int wc, int fr, int fq) const {
        const int row0 = u.pm * BM + wr * 64 + fr, col0 = u.pn * BM + wc * 32 + 8 * fq;
#pragma unroll
        for (int ai = 0; ai < 2; ++ai)
#pragma unroll
            for (int m = 0; m < 4; ++m) { const int row = row0 + ai * HALF + m * 16; const float b = rbias[row]; bf16_t* rowp = O + (size_t)row * ldc + col0;
#pragma unroll
                for (int bj = 0; bj < 2; ++bj) { const f32x4 v0 = acc[ai][bj][m][0] + b, v1 = acc[ai][bj][m][1] + b;
                    u32x4 w; w.x = cvt_pk_bf16(v0[0], v0[1]); w.y = cvt_pk_bf16(v0[2], v0[3]); w.z = cvt_pk_bf16(v1[0], v1[1]); w.w = cvt_pk_bf16(v1[2], v1[3]);
                    *(u32x4*)(rowp + bj * HALF) = w; } }
    }
};
struct EpiDecay {
    static constexpr bool PERM = true, AFTER_DRAIN = false;
    bf16_t* O; int ldc;
    __device__ __forceinline__ void operator()(const f32x4 (&acc)[2][2][4][2], const Unit& u, int wr, int wc, int fr, int fq) const {
        const int row0 = u.pm * BM + wr * 64 + fr, col0 = u.pn * BM + wc * 32 + 8 * fq;
        const float dmin = -3.0701134573253944f, dmax = -15.350567286626972f;
#pragma unroll
        for (int ai = 0; ai < 2; ++ai)
#pragma unroll
            for (int m = 0; m < 4; ++m) { const int row = row0 + ai * HALF + m * 16, c = row & 511;
                const float dl2 = (dmin + (dmax - dmin) * ((float)c * (1.0f / 511.0f))) * 1.4426950408889634f * (1.0f / 16383.0f);
                bf16_t* rowp = O + (size_t)row * ldc + col0;
#pragma unroll
                for (int bj = 0; bj < 2; ++bj) { float v[8];
#pragma unroll
                    for (int e = 0; e < 8; ++e) { const int l = col0 + bj * HALF + e; v[e] = acc[ai][bj][m][e >> 2][e & 3] * __builtin_amdgcn_exp2f(dl2 * (float)l); }
                    u32x4 w; w.x = cvt_pk_bf16(v[0], v[1]); w.y = cvt_pk_bf16(v[2], v[3]); w.z = cvt_pk_bf16(v[4], v[5]); w.w = cvt_pk_bf16(v[6], v[7]);
                    *(u32x4*)(rowp + bj * HALF) = w; } }
    }
};
struct EpiPoolGate {
    static constexpr bool PERM = true, AFTER_DRAIN = false;
    bf16_t* Y; const bf16_t* TP;
    __device__ __forceinline__ void operator()(const f32x4 (&acc)[2][2][4][2], const Unit& u, int wr, int wc, int fr, int fq) const {
        const int row0 = u.pm * BM + wr * 64 + fr, col0 = u.pn * BM + wc * 32 + 8 * fq;
#pragma unroll
        for (int ai = 0; ai < 2; ++ai)
#pragma unroll
            for (int m = 0; m < 4; ++m) { const int row = row0 + ai * HALF + m * 16;
#pragma unroll
                for (int bj = 0; bj < 2; ++bj) { const size_t off = (size_t)row * 1024 + 512 + col0 + bj * HALF;
                    const u32x4 g = *(const u32x4*)(TP + off); float v[8];
#pragma unroll
                    for (int e = 0; e < 8; ++e) { const unsigned gw = e < 2 ? g.x : e < 4 ? g.y : e < 6 ? g.z : g.w; const float q = (e & 1) ? __builtin_bit_cast(float, gw & 0xffff0000u) : __builtin_bit_cast(float, gw << 16);
                        v[e] = acc[ai][bj][m][e >> 2][e & 3] * (q / (1.0f + __expf(-q))); }
                    u32x4 w; w.x = cvt_pk_bf16(v[0], v[1]); w.y = cvt_pk_bf16(v[2], v[3]); w.z = cvt_pk_bf16(v[4], v[5]); w.w = cvt_pk_bf16(v[6], v[7]);
                    *(u32x4*)(Y + off) = w; } }
    }
};
struct EpiResGate {
    static constexpr bool PERM = false, AFTER_DRAIN = false;
    float* C; const float* X; const float* mod; const float* bout; float alpha;
    __device__ __forceinline__ void operator()(const f32x4 (&acc)[2][2][4][2], const Unit& u, int wr, int wc, int fr, int fq) const {
        const int row0 = u.pm * BM + wr * 64 + fr, col0 = u.pn * BM + wc * 32 + 4 * fq;
        const float* gate = mod + ((u.pm * BM) >= 16384 ? 3072 : 0) + 2048;
        f32x4 bv[2][2], gv[2][2];
#pragma unroll
        for (int bj = 0; bj < 2; ++bj)
#pragma unroll
            for (int n = 0; n < 2; ++n) { bv[bj][n] = *(const f32x4*)(bout + col0 + bj * HALF + n * 16); gv[bj][n] = *(const f32x4*)(gate + col0 + bj * HALF + n * 16); }
#pragma unroll
        for (int ai = 0; ai < 2; ++ai)
#pragma unroll
            for (int m = 0; m < 4; ++m) { const size_t off = (size_t)(row0 + ai * HALF + m * 16) * 1024 + col0;
#pragma unroll
                for (int bj = 0; bj < 2; ++bj)
#pragma unroll
                    for (int n = 0; n < 2; ++n) { const f32x4 xv = *(const f32x4*)(X + off + bj * HALF + n * 16);
                        *(f32x4*)(C + off + bj * HALF + n * 16) = xv * alpha + gv[bj][n] * (acc[ai][bj][m][n] + bv[bj][n]); } }
    }
};
}

__device__ void p1_modulate(const Frame& F) {
    AP_FRESH(F);
    const float* x = ap->in[I_X]; const float* mod = wsp<float>(ap, WS_MOD); bf16* U = wsp<bf16>(ap, WS_U);
    const size_t n8 = (size_t)NTOK * DM / 8, stride = (size_t)F.G * NT;
    for (size_t i = (size_t)F.blk * NT + F.tid; i < n8; i += stride) {
        const size_t e0 = i * 8; const int col = (int)(e0 & (DM - 1)); const int b = (int)(e0 >= (size_t)SEQ * DM);
        const float* md = mod + b * 3072;
        const f32x4v x0 = *(const f32x4v*)(x + e0), x1 = *(const f32x4v*)(x + e0 + 4);
        const f32x4v sh0 = *(const f32x4v*)(md + col), sh1 = *(const f32x4v*)(md + col + 4), sc0 = *(const f32x4v*)(md + 1024 + col), sc1 = *(const f32x4v*)(md + 1024 + col + 4);
        const f32x4v u0 = x0 * (sc0 + 1.0f) + sh0, u1 = x1 * (sc1 + 1.0f) + sh1;
        u32x4v w; w.x = pk2(u0[0], u0[1]); w.y = pk2(u0[2], u0[3]); w.z = pk2(u1[0], u1[1]); w.w = pk2(u1[2], u1[3]);
        *(u32x4v*)(U + e0) = w;
    }
}

__device__ void p3_pool(const Frame& F) {
    AP_FRESH(F);
    const bf16* TP = wsp<bf16>(ap, WS_TP); bf16* PP = wsp<bf16>(ap, WS_PP);
    for (int i = F.blk * NT + F.tid; i < 2048 * 64; i += F.G * NT) {
        const int c8 = (i & 63) * 8, run = i >> 6, g = c8 >> 7, hw = 1 << g;
        const int tok0 = run * 16, b = tok0 >> 14, pos0 = tok0 & (SEQ - 1);
        const bf16* base = TP + (size_t)b * SEQ * 1024 + c8;
        float s[8] = {0.f, 0.f, 0.f, 0.f, 0.f, 0.f, 0.f, 0.f};
        { const int lo = pos0 - hw < 0 ? 0 : pos0 - hw, hi = pos0 + hw > SEQ ? SEQ : pos0 + hw;
          for (int q = lo; q < hi; ++q) { const u32x4v v = *(const u32x4v*)(base + (size_t)q * 1024);
              s[0] += bflo(v.x); s[1] += bfhi(v.x); s[2] += bflo(v.y); s[3] += bfhi(v.y); s[4] += bflo(v.z); s[5] += bfhi(v.z); s[6] += bflo(v.w); s[7] += bfhi(v.w); } }
#pragma unroll 4
        for (int k = 0; k < 16; ++k) {
            const int pos = pos0 + k;
            const int lo = pos - hw < 0 ? 0 : pos - hw, hi = pos + hw > SEQ ? SEQ : pos + hw;
            const u32x4v own = *(const u32x4v*)(base + (size_t)pos * 1024);
            const float inv = 1.0f / (float)(hi - lo);
            u32x4v w; w.x = pk2(s[0] * inv - bflo(own.x), s[1] * inv - bfhi(own.x)); w.y = pk2(s[2] * inv - bflo(own.y), s[3] * inv - bfhi(own.y));
            w.z = pk2(s[4] * inv - bflo(own.z), s[5] * inv - bfhi(own.z)); w.w = pk2(s[6] * inv - bflo(own.w), s[7] * inv - bfhi(own.w));
            *(u32x4v*)(PP + (size_t)(tok0 + k) * 512 + c8) = w;
            if (pos + hw < SEQ) { const u32x4v v = *(const u32x4v*)(base + (size_t)(pos + hw) * 1024);
                s[0] += bflo(v.x); s[1] += bfhi(v.x); s[2] += bflo(v.y); s[3] += bfhi(v.y); s[4] += bflo(v.z); s[5] += bfhi(v.z); s[6] += bflo(v.w); s[7] += bfhi(v.w); }
            if (pos - hw >= 0) { const u32x4v v = *(const u32x4v*)(base + (size_t)(pos - hw) * 1024);
                s[0] -= bflo(v.x); s[1] -= bfhi(v.x); s[2] -= bflo(v.y); s[3] -= bfhi(v.y); s[4] -= bflo(v.z); s[5] -= bfhi(v.z); s[6] -= bflo(v.w); s[7] -= bfhi(v.w); }
        }
    }
}

__device__ void p3_hyena_old(const Frame& F, bf16* yh_dst) {
    LAS f2* L = (LAS f2*)F.lds;
    const int t = F.tid;
    AP_FRESH(F);
    hy::JobArgs J;
    J.ch = wsp<bf16>(ap, WS_CH); J.kt = wsp<bf16>(ap, WS_KT); J.conv_w = ap->in[I_CONVW]; J.conv_b = ap->in[I_CONVB]; J.hbias = ap->in[I_HBIAS];
    J.sbase = (f2*)(ap->ws + WS_ST + (size_t)F.blk * 393216); J.yh = yh_dst;
    const hy::Stash S = hy::make_stash(J);
    for (int c = F.blk; c < DH; c += F.G) {
        hy::seg_prep(J, S, c, t);
        for (int oh = 0; oh < 4; ++oh) {
            const int o = oh >> 1; const bool tw = oh & 1;
            hy::seg_filter_p1(J, c, o, tw, t, L); __syncthreads();
            hy::fwd_p2(t, L); __syncthreads();
            hy::seg_filter_p3(S, t, L); __syncthreads();
            hy::seg_data_p1(S, tw, t, L); __syncthreads();
            hy::fwd_p2(t, L); __syncthreads();
            hy::seg_mul(S, t, L); __syncthreads();
            hy::inv_p2(t, L); __syncthreads();
            hy::seg_out(J, S, c, o, tw, t, L); __syncthreads();
        }
    }
}
#define HM_FULLSYNC0() do { asm volatile("s_waitcnt vmcnt(0) lgkmcnt(0)" ::: "memory"); __syncthreads(); } while (0)
__device__ void p3_hyena(const Frame& F, bf16* yh_dst) {
    LAS unsigned* IMG0 = (LAS unsigned*)F.lds; LAS unsigned* IMG1 = IMG0 + hm::IMG_DW;
    const int t = F.tid, lane = F.lane, wave = F.wave;
    AP_FRESH(F);
    hm::Job J;
    J.ch = wsp<bf16>(ap, WS_CH); J.kt = wsp<bf16>(ap, WS_KT); J.conv_w = ap->in[I_CONVW]; J.conv_b = ap->in[I_CONVB]; J.hbias = ap->in[I_HBIAS]; J.yh = yh_dst ? yh_dst : wsp<bf16>(ap, WS_YH);
    J.st = __builtin_amdgcn_make_buffer_rsrc(ap->ws + WS_ST + (size_t)F.blk * 393216, (short)0, 393216, 0x00020000);
    J.dbg = (unsigned*)(ap->ws + WS_CTL + 65536 + 512);
    J.pk = __builtin_amdgcn_make_buffer_rsrc((unsigned char*)ap->out + (size_t)F.blk * 196608, (short)0, 196608, 0x00020000);
#ifdef HM_POISON
    for (int i = t; i < 2 * hm::IMG_DW; i += NT) IMG0[i] = 0x7e007e00u;
    for (int i = t; i < 393216 / 4; i += NT) __builtin_amdgcn_raw_buffer_store_b32(0x7fc00000u, J.st, i * 4, 0, 0);
    asm volatile("s_waitcnt vmcnt(0) lgkmcnt(0)" ::: "memory"); __syncthreads();
#endif
    hm::h8 A[16];
    hm::build_A(A, wave, lane);
    hm::f32x16 acc[4];
#ifdef HM_FFTTEST
    if (F.blk == 0) {
        unsigned* cnt = (unsigned*)(ap->ws + WS_CTL + 65536 + 512);
        for (int i = t; i < hm::IMG_DW; i += NT) IMG0[i] = 0u;
        __syncthreads();
        if (t == 0) IMG0[3 * hm::RS + 5] = hm::pkh(1.0f, 0.5f);
        HM_FULLSYNC0();
        hm::mfma_pass(IMG0, A, acc, lane); HM_FULLSYNC0(); hm::twiddle_store(acc, IMG1, wave, lane, -1.0f, 0.125f); HM_FULLSYNC0();
        hm::mfma_pass(IMG1, A, acc, lane); HM_FULLSYNC0();
        {
            const int l31 = lane & 31, hh = lane >> 5, rb = 16 * wave + 4 * hh;
            for (int cb = 0; cb < 4; ++cb) for (int a = 0; a < 2; ++a) { hm::u4 w;
                for (int b = 0; b < 4; ++b) { float gr = 0.f, gi = 0.f; for (int q = 0; q < 16; ++q) { if (q == b + 8 * a) gr = acc[cb][q]; if (q == b + 8 * a + 4) gi = acc[cb][q]; } w[b] = hm::pkh(gr, gi); }
                *(LAS hm::u4*)(IMG0 + (32 * cb + l31) * hm::RS + rb + 8 * a) = w; }
        }
        HM_FULLSYNC0();
        hm::flip_A(A, lane);
        hm::mfma_pass(IMG0, A, acc, lane); HM_FULLSYNC0(); hm::twiddle_store(acc, IMG1, wave, lane, 1.0f, 0.25f); HM_FULLSYNC0();
        hm::mfma_pass(IMG1, A, acc, lane); HM_FULLSYNC0();
        hm::flip_A(A, lane);
        int bad = 0; const int nstar = 128 * 5 + 3;
        for (int cb = 0; cb < 4; ++cb) for (int a = 0; a < 2; ++a) for (int b = 0; b < 4; ++b) {
            const int n1 = 16 * wave + 4 * (lane >> 5) + 8 * a + b, n0 = 32 * cb + (lane & 31), n = 128 * n1 + n0;
            const float er = (n == nstar) ? 512.0f : 0.0f, ei = (n == nstar) ? 256.0f : 0.0f;
            float gr = 0.f, gi = 0.f;
            for (int q = 0; q < 16; ++q) { if (q == b + 8 * a) gr = acc[cb][q]; if (q == b + 8 * a + 4) gi = acc[cb][q]; }
            if (fabsf(gr - er) > 3.0f || fabsf(gi - ei) > 3.0f) bad++; }
        if (bad) atomicAdd(cnt, (unsigned)bad);
        __syncthreads();
    }
    return;
#endif
#ifdef HM_STAGETEST
    {
        hm::prep(J, F.blk, t); HM_FULLSYNC0();
        hm::stage_data(J, false, t, IMG0); HM_FULLSYNC0();
        int bad = 0;
        for (int i = t; i < 16384; i += NT) { const int n1 = i >> 7, n0 = i & 127;
            const hm::u2 raw = __builtin_amdgcn_raw_buffer_load_b64(J.st, i * 8, 131072, 16); const f2 z = __builtin_bit_cast(f2, raw);
            const unsigned w = IMG0[n0 * hm::RS + n1]; const unsigned e = hm::pkh(z.x, z.y);
            if (w != e) bad++; }
        if (bad) atomicAdd(J.dbg, (unsigned)bad);
        HM_FULLSYNC0();
        return;
    }
#endif
    for (int c = F.blk; c < DH; c += F.G) {
        for (int _p = 0; _p < 1 + (HP == 4); ++_p) hm::prep(J, c, t);
        for (int oh = 0; oh < 4; ++oh) {
            const int o = oh >> 1; const bool tw = oh & 1;
#ifndef HP
#define HP 0
#endif
#define HREP(k) for (int _h = 0; _h < 1 + (HP == (k)); ++_h)
            HREP(1) {
            hm::stage_filter(J, c, o, tw, t, IMG0);
            asm volatile("s_waitcnt vmcnt(0)" ::: "memory");
            __syncthreads();
            hm::mfma_pass(IMG0, A, acc, lane); hm::twiddle_store(acc, IMG1, wave, lane, -1.0f, 1.0f); __syncthreads();
            hm::mfma_pass(IMG1, A, acc, lane); hm::store_K(J, acc, t);
            if (HP == 1) __syncthreads();
            }
            HREP(2) {
            hm::stage_data(J, o, tw, t, IMG0); __syncthreads();
            hm::mfma_pass(IMG0, A, acc, lane); hm::twiddle_store(acc, IMG1, wave, lane, -1.0f, 0.125f); __syncthreads();
            hm::mfma_pass(IMG1, A, acc, lane); if (HP == 2 && _h == 0) { __syncthreads(); continue; } hm::mul_store(J, acc, IMG0, wave, lane, t); __syncthreads();
            }
            hm::flip_A(A, lane);
            HREP(3) {
            hm::mfma_pass(IMG0, A, acc, lane); hm::twiddle_store(acc, IMG1, wave, lane, 1.0f, 0.25f); __syncthreads();
            hm::mfma_pass(IMG1, A, acc, lane); hm::final_epilogue(J, acc, c, o, tw, wave, lane);
            if (HP == 3) { asm volatile("s_waitcnt vmcnt(0)" ::: "memory"); __syncthreads(); }
            }
            hm::flip_A(A, lane);
        }
        __syncthreads();
    }
}

__device__ void p4_transpose(const Frame& F) {
    LAS bf16* tile = (LAS bf16*)F.lds;
    const int t = F.tid;
    AP_FRESH(F);
    const bf16* YH = wsp<bf16>(ap, WS_YH); bf16* Y = wsp<bf16>(ap, WS_Y);
    for (int job = F.blk; job < 8 * 512; job += F.G) {
        const int ct = job & 7, tt = job >> 3;
        { const int r = t >> 3, q = (t & 7) * 8;
          const u32x4v v = *(const u32x4v*)(YH + (size_t)(ct * 64 + r) * NTOK + tt * 64 + q);
          tile[(q + 0) * 66 + r] = (bf16)(v.x & 0xffff); tile[(q + 1) * 66 + r] = (bf16)(v.x >> 16); tile[(q + 2) * 66 + r] = (bf16)(v.y & 0xffff); tile[(q + 3) * 66 + r] = (bf16)(v.y >> 16);
          tile[(q + 4) * 66 + r] = (bf16)(v.z & 0xffff); tile[(q + 5) * 66 + r] = (bf16)(v.z >> 16); tile[(q + 6) * 66 + r] = (bf16)(v.w & 0xffff); tile[(q + 7) * 66 + r] = (bf16)(v.w >> 16); }
        __syncthreads();
        { const int tok = t >> 3, q = (t & 7) * 8;
          const LAS unsigned* p = (const LAS unsigned*)(tile + tok * 66 + q);
          u32x4v w; w.x = p[0]; w.y = p[1]; w.z = p[2]; w.w = p[3];
          *(u32x4v*)(Y + (size_t)(tt * 64 + tok) * 1024 + ct * 64 + q) = w; }
        __syncthreads();
    }
}

__device__ void p6_layernorm(const Frame& F) {
    const int lane = F.lane;
    AP_FRESH(F);
    float* out = ap->out; const float *ln_g = ap->in[I_LNG], *ln_b = ap->in[I_LNB];
    for (int row = F.blk * 8 + F.wave; row < NTOK; row += F.G * 8) {
        float* p = out + (size_t)row * DM;
        f32x4v v[4]; float s = 0.f;
#pragma unroll
        for (int k = 0; k < 4; ++k) { v[k] = *(const f32x4v*)(p + k * 256 + lane * 4); s += (v[k][0] + v[k][1]) + (v[k][2] + v[k][3]); }
#pragma unroll
        for (int o = 32; o >= 1; o >>= 1) s += __shfl_xor(s, o);
        const float mean = s * (1.0f / DM); float q = 0.f;
#pragma unroll
        for (int k = 0; k < 4; ++k) { const f32x4v d = v[k] - mean; q += (d[0] * d[0] + d[1] * d[1]) + (d[2] * d[2] + d[3] * d[3]); }
#pragma unroll
        for (int o = 32; o >= 1; o >>= 1) q += __shfl_xor(q, o);
        const float rstd = 1.0f / sqrtf(q * (1.0f / DM) + LN_EPS);
#pragma unroll
        for (int k = 0; k < 4; ++k) { const f32x4v g = *(const f32x4v*)(ln_g + k * 256 + lane * 4), b = *(const f32x4v*)(ln_b + k * 256 + lane * 4);
            *(f32x4v*)(p + k * 256 + lane * 4) = (v[k] - mean) * rstd * g + b; }
    }
}

#ifdef HM_SELFTEST
__device__ void hm_selftest(const Frame& F) {
    if (F.blk != 0) return;
    AP_FRESH(F);
    unsigned* flag = (unsigned*)(ap->ws + WS_CTL + 65536);
    LAS unsigned* L = (LAS unsigned*)F.lds;
    const int lane = F.lane;
    unsigned code = 0;
    if (F.wave == 0) {
        hm::h8 a, b;
        const int r = lane & 31, h = lane >> 5;
#pragma unroll
        for (int j = 0; j < 8; ++j) { const int k = 8 * h + j; a[j] = (_Float16)((k == (r & 15)) ? (float)(r + 1) : 0.0f); b[j] = (_Float16)(float)(k * 32 + r); }
        hm::f32x16 c;
#pragma unroll
        for (int i = 0; i < 16; ++i) c[i] = 0.0f;
        c = __builtin_amdgcn_mfma_f32_32x32x16_f16(a, b, c, 0, 0, 0);
        int bad = 0;
#pragma unroll
        for (int reg = 0; reg < 16; ++reg) { const int row = (reg & 3) + 8 * (reg >> 2) + 4 * h, col = r; const float exp = (float)(row + 1) * (float)((row & 15) * 32 + col); if (c[reg] != exp) bad = 1; }
        if (__any(bad)) code |= 1u;
        { const unsigned p = hm::pkh(1.0f, 2.0f); if (p != 0x40003c00u) code |= 2u; }
        __amdgpu_buffer_rsrc_t rs = __builtin_amdgcn_make_buffer_rsrc(ap->ws + WS_ST, (short)0, 393216, 0x00020000);
        hm::u4 w; w.x = 0x11110000u + lane; w.y = 0x22220000u + lane; w.z = 0x33330000u + lane; w.w = 0x44440000u + lane;
        __builtin_amdgcn_raw_buffer_store_b128(w, rs, lane * 16, 262144 + 5 * 8192, 0);
        asm volatile("s_waitcnt vmcnt(0)" ::: "memory");
        const hm::u4 q = __builtin_amdgcn_raw_buffer_load_b128(rs, lane * 16, 262144 + 5 * 8192, 16);
        if (__any(q.x != w.x || q.y != w.y || q.z != w.z || q.w != w.w)) code |= 4u;
        const unsigned* g = (const unsigned*)(ap->ws + WS_ST + 262144 + 5 * 8192);
        asm volatile("s_waitcnt vmcnt(0)" ::: "memory");
        if (__any(hm::asf(q.y) != __builtin_bit_cast(float, 0x22220000u + lane))) code |= 8u;
        const short s16 = __builtin_amdgcn_raw_buffer_load_b16(rs, lane * 16, 262144 + 5 * 8192 + 6, 0);
        if (__any(((unsigned short)s16) != 0x2222u)) code |= 16u;
        { const float cc = __builtin_amdgcn_cosf(0.25f), ss = __builtin_amdgcn_sinf(0.25f); if (!(fabsf(cc) < 1e-4f && fabsf(ss - 1.0f) < 1e-4f)) code |= 32u; }
        { L[lane * 4 + 0] = 0x3c000000u | 0x0000u; L[lane * 4 + 1] = hm::pkh(3.0f, 4.0f); L[lane * 4 + 2] = hm::pkh(5.0f, 6.0f); L[lane * 4 + 3] = hm::pkh(7.0f, 8.0f);
          asm volatile("s_waitcnt lgkmcnt(0)" ::: "memory");
          const hm::h8 v = *(const LAS hm::h8*)(L + lane * 4);
          if (__any(!((float)v[0] == 0.0f && (float)v[1] == 1.0f && (float)v[2] == 3.0f && (float)v[3] == 4.0f && (float)v[7] == 8.0f))) code |= 64u; }
        if (lane == 0) *flag = code;
        (void)g;
    }
}
#endif
__global__ void __launch_bounds__(NT, 2) fwd_kernel(Args args) {
    extern __shared__ __attribute__((aligned(16))) unsigned char lds_raw[];
    Frame F;
    F.lds = (LAS unsigned char*)lds_raw; F.tid = threadIdx.x; F.lane = F.tid & 63; F.wave = __builtin_amdgcn_readfirstlane(F.tid >> 6); F.G = gridDim.x; F.blk = blockIdx.x;
    F.ap = (ArgsP)__builtin_amdgcn_kernarg_segment_ptr();
    unsigned char* ws = args.ws;
    volatile LAS unsigned* MISC = (volatile LAS unsigned*)(F.lds + LDS_MISC);
    if (F.tid < 64) MISC[F.tid] = 0u;
    __syncthreads();
    XcdBarrier bar; bar.bar = (unsigned*)(ws + WS_CTL); bar.x = 0; bar.st = nullptr;
    const int lo = args.ph_lo, hi = args.ph_hi;
    if (hi - lo > 1) bar = xcd_barrier_post((unsigned*)(ws + WS_CTL), MISC + 8);
#define IN(k) (lo <= (k) && (k) < hi)
#define SEAM(k) do { if (IN(k) && IN((k) + 1)) xcd_barrier(bar); } while (0)
    const int vcu = (F.G % 8 == 0) ? (F.blk % 8) * (F.G / 8) + F.blk / 8 : F.blk; (void)vcu;

#ifndef PROBE_MASK
#define PROBE_MASK 0
#endif
#define REPS(i) for (int _r = 0; _r < 1 + ((PROBE_MASK >> (i)) & 1); ++_r)
#ifdef HM_SELFTEST
    if (IN(0)) { hm_selftest(F); __syncthreads(); }
#endif
    if (IN(0)) REPS(0) { p0_prologue(F); __syncthreads(); }
    SEAM(0);
    if (IN(1)) {
        REPS(1) p1_modulate(F);
        REPS(2) { AP_FRESH(F);
        pg8::Gemm g{wsp<bf16>(ap, WS_FWT), wsp<bf16>(ap, WS_H3), 2048, SEQ, 256}; pg8::StaticOrder S; S.init(g.M, g.N, F.G, F.blk); pg8::EpiDecay E{wsp<bf16>(ap, WS_KT), SEQ};
        pg8::gemm_phase<pg8::EpiDecay, pg8::StaticOrder, false>(F.lds, g, S, E, nullptr); __syncthreads(); }
    }
    SEAM(1);
    if (IN(2)) {
        REPS(3) { AP_FRESH(F);
          pg8::Gemm g{wsp<bf16>(ap, WS_WINT), wsp<bf16>(ap, WS_U), 2048, NTOK, DM}; pg8::StaticOrder S; S.init(g.M, g.N, F.G, F.blk); pg8::EpiRowBias E{wsp<bf16>(ap, WS_CH), NTOK, ap->in[I_BIN]};
          pg8::gemm_phase<pg8::EpiRowBias, pg8::StaticOrder, false>(F.lds, g, S, E, nullptr); __syncthreads(); }
        REPS(4) { AP_FRESH(F);
          pg8::Gemm g{wsp<bf16>(ap, WS_U), wsp<bf16>(ap, WS_WINT) + (size_t)2048 * DM, NTOK, 1024, DM}; pg8::StaticOrder S; S.init(g.M, g.N, F.G, F.blk); pg8::EpiBf16<0> E{wsp<bf16>(ap, WS_TP), 1024, ap->in[I_BIN] + 2048, 0, 0};
          pg8::gemm_phase<pg8::EpiBf16<0>, pg8::StaticOrder, false>(F.lds, g, S, E, nullptr); __syncthreads(); }
    }
    SEAM(2);
#if defined(HM_IDFILT) || defined(HM_STAGETEST)
    if (IN(3)) { { AP_FRESH(F); p3_hyena_old(F, wsp<bf16>(ap, WS_YH)); } __syncthreads(); { AP_FRESH(F); p3_hyena(F, (bf16*)ap->out); } __syncthreads(); p3_pool(F); }
#elif defined(HM_FFTTEST)
    if (IN(3)) { { AP_FRESH(F); p3_hyena_old(F, wsp<bf16>(ap, WS_YH)); } __syncthreads(); p3_hyena(F, nullptr); __syncthreads(); p3_pool(F); }
#elif defined(HM_COMPARE)
    if (IN(3)) { { AP_FRESH(F); p3_hyena_old(F, wsp<bf16>(ap, WS_YH)); } __syncthreads(); { AP_FRESH(F); p3_hyena(F, (bf16*)ap->out); } __syncthreads();
        { AP_FRESH(F); const bf16* Y1 = wsp<bf16>(ap, WS_YH); const bf16* Y2 = (const bf16*)ap->out; unsigned* cnt = (unsigned*)(ap->ws + WS_CTL + 65536 + 256);
          LAS float* red = (LAS float*)F.lds;
          for (int c = F.blk; c < DH; c += F.G) { float md = 0.f, mr = 0.f;
              for (int i = F.tid; i < NTOK; i += NT) { const float a = bflo((unsigned)Y1[(size_t)c * NTOK + i]), b = bflo((unsigned)Y2[(size_t)c * NTOK + i]); md = fmaxf(md, fabsf(a - b)); mr = fmaxf(mr, fabsf(a)); if (!(b == b)) md = 1e30f; }
              __syncthreads(); red[F.tid] = md; red[NT + F.tid] = mr; __syncthreads();
              if (F.tid == 0) { float m1 = 0.f, m2 = 0.f; for (int k = 0; k < NT; ++k) { m1 = fmaxf(m1, red[k]); m2 = fmaxf(m2, red[NT + k]); }
                  if (m1 > HM_CMP_TOL * m2) atomicAdd(cnt, 1u); }
              __syncthreads(); } }
        p3_pool(F); }
#else
    if (IN(3)) { REPS(5) p3_hyena(F, nullptr); REPS(6) p3_pool(F); }
#endif
    SEAM(3);
    if (IN(4)) {
        REPS(7) p4_transpose(F);
        __syncthreads();
        REPS(8) { AP_FRESH(F);
        pg8::Gemm g{wsp<bf16>(ap, WS_PP), wsp<bf16>(ap, WS_PWT), NTOK, 512, 512}; pg8::StaticOrder S; S.init(g.M, g.N, F.G, F.blk); pg8::EpiPoolGate E{wsp<bf16>(ap, WS_Y), wsp<bf16>(ap, WS_TP)};
        pg8::gemm_phase<pg8::EpiPoolGate, pg8::StaticOrder, false>(F.lds, g, S, E, nullptr); __syncthreads(); }
    }
    SEAM(4);
    if (IN(5)) {
        REPS(9) { AP_FRESH(F);
        pg8::Gemm g{wsp<bf16>(ap, WS_Y), wsp<bf16>(ap, WS_WOUTT), NTOK, DM, DM}; pg8::StaticOrder S; S.init(g.M, g.N, F.G, F.blk); pg8::EpiResGate E{ap->out, ap->in[I_X], wsp<float>(ap, WS_MOD), ap->in[I_BOUT], DN_ALPHA};
        pg8::gemm_phase<pg8::EpiResGate, pg8::StaticOrder, false>(F.lds, g, S, E, nullptr); __syncthreads(); }
    }
    SEAM(5);
    if (IN(6)) p6_layernorm(F);
#ifdef HM_SELFTEST
    if (IN(6) && F.blk == 0) { __syncthreads(); AP_FRESH(F); const unsigned code = *(const unsigned*)(ap->ws + WS_CTL + 65536); if (F.tid == 0 && code) ap->out[0] = 1000.0f * (float)code; }
#endif
#if defined(HM_FFTTEST) || defined(HM_IDFILT) || defined(HM_STAGETEST)
    if (IN(6) && F.blk == 0) { __syncthreads(); AP_FRESH(F); const unsigned n = __hip_atomic_load((unsigned*)(ap->ws + WS_CTL + 65536 + 512), __ATOMIC_RELAXED, __HIP_MEMORY_SCOPE_AGENT); if (F.tid == 0) { ap->out[0] = 10.0f * (float)n + 50.0f; const unsigned n2 = __hip_atomic_load((unsigned*)(ap->ws + WS_CTL + 65536 + 516), __ATOMIC_RELAXED, __HIP_MEMORY_SCOPE_AGENT); if (n2) ap->out[1] = 1.0e10f + 1.0e6f * (float)n2; } }
#endif
#ifdef HM_COMPARE
    if (IN(6) && F.blk == 0) { __syncthreads(); AP_FRESH(F); const unsigned n = __hip_atomic_load((unsigned*)(ap->ws + WS_CTL + 65536 + 256), __ATOMIC_RELAXED, __HIP_MEMORY_SCOPE_AGENT); if (F.tid == 0) ap->out[0] = 100.0f * (float)n + 50.0f; }
#endif
#undef IN
#undef SEAM
}

extern "C" void kernel_launch(void* const* d_in, const int* in_sizes, int n_in, void* d_out, int out_size, void* d_ws, size_t ws_size, hipStream_t stream) {
    static int grid = 0;
    if (grid == 0) {
        if (n_in != 21 || in_sizes[0] != NTOK * DM || out_size != NTOK * DM || ws_size < WS_END) {
            fprintf(stderr, "kernel_launch: unexpected shapes (n_in %d, in0 %d, out %d, ws %zu < %zu)\n", n_in, n_in > 0 ? in_sizes[0] : -1, out_size, ws_size, (size_t)WS_END); grid = -1; return; }
        int dev = 0, cus = 0, per_cu = 0;
        if (hipGetDevice(&dev) != hipSuccess || hipDeviceGetAttribute(&cus, hipDeviceAttributeMultiprocessorCount, dev) != hipSuccess) { grid = -1; return; }
        if (hipFuncSetAttribute((const void*)fwd_kernel, hipFuncAttributeMaxDynamicSharedMemorySize, LDS_BYTES) != hipSuccess) { fprintf(stderr, "kernel_launch: hipFuncSetAttribute failed\n"); grid = -1; return; }
        if (hipOccupancyMaxActiveBlocksPerMultiprocessor(&per_cu, (const void*)fwd_kernel, NT, LDS_BYTES) != hipSuccess || per_cu < 1) { fprintf(stderr, "kernel_launch: occupancy query says %d blocks per CU\n", per_cu); }
        (void)hipGetLastError();
        grid = cus;
    }
    if (grid < 0) return;
    (void)hipMemsetAsync((char*)d_ws + WS_CTL, 0, CTL_BYTES, stream);
    Args a{};
    for (int i = 0; i < 21; ++i) a.in[i] = (const float*)d_in[i];
    a.out = (float*)d_out; a.ws = (unsigned char*)d_ws;
    if (MK_N_LAUNCHES == 1) { a.ph_lo = 0; a.ph_hi = N_PHASES; hipLaunchKernelGGL(fwd_kernel, dim3(grid), dim3(NT), LDS_BYTES, stream, a); }
    else for (int p = 0; p < N_PHASES; ++p) { a.ph_lo = p; a.ph_hi = p + 1; hipLaunchKernelGGL(fwd_kernel, dim3(grid), dim3(NT), LDS_BYTES, stream, a); }
}
```

```cpp
#include <hip/hip_runtime.h>
#include <cstdio>
#include <cstdint>
#ifndef MK_N_LAUNCHES
#define MK_N_LAUNCHES 1
#define PROBE_MASK 0
#define HP 0
#endif
namespace pg8 {
#define PG8_LAS __attribute__((address_space(3)))
typedef unsigned short bf16_t;
typedef short bf16x8 __attribute__((ext_vector_type(8)));
typedef float f32x4 __attribute__((ext_vector_type(4)));
typedef unsigned u32x4 __attribute__((ext_vector_type(4)));
constexpr int BM = 256, BK = 64, HALF = 128, HTB = HALF * BK * 2  , STAGE_BYTES = 8 * HTB, NXCD = 8, WGM = 8;

__host__ __device__ __forceinline__ int lds_byte(int r, int c) { const int st = (r >> 4) * 2 + (c >> 5), rr = r & 15, cc = c & 31, ob = rr * 64 + cc * 2; return st * 1024 + (ob ^ (((ob >> 9) & 1) << 5)); }
__host__ __device__ __forceinline__ void stage_rc(int b, int& R, int& C) { const int st = b / 1024, sb = b % 1024, swz = sb ^ (((sb >> 9) & 1) << 5); R = (st >> 1) * 16 + swz / 64; C = (st & 1) * 32 + (swz % 64) / 2; }
__host__ __device__ __forceinline__ int perm32(int rho) { const int n = rho >> 4, i = rho & 15; return 8 * (i >> 2) + 4 * n + (i & 3); }

struct Unit { int pm, pn; };
struct Gemm { const bf16_t* A; const bf16_t* Bt; int M, N, K; };

struct StaticOrder {
    int nM, nN, nwg, G, c;
    __host__ __device__ void init(int M, int N, int G_, int c_) { nM = M / BM; nN = N / BM; nwg = nM * nN; G = G_; c = c_; }
    __host__ __device__ bool next(int i, Unit& u) const {
        const long L = (long)i * G + c; if (L >= nwg) return false;
        int wgid = (int)L; { const int q = nwg / NXCD, r = nwg % NXCD, xcd = wgid % NXCD, off = wgid / NXCD; wgid = (xcd < r ? xcd * (q + 1) : r * (q + 1) + (xcd - r) * q) + off; }
        const int nig = WGM * nN, gid = wgid / nig, fm = gid * WGM, gsz = (nM - fm) < WGM ? (nM - fm) : WGM;
        u.pm = fm + ((wgid % nig) % gsz); u.pn = (wgid % nig) / gsz; return true;
    }
    __device__ __forceinline__ void a_ready(const Unit&) const {}
    __device__ __forceinline__ void done(const Unit&) const {}
};
struct CountedOrder : StaticOrder {
    const unsigned* ready; unsigned need; unsigned* tmo;
    __device__ __forceinline__ void a_ready(const Unit& u) const {
        if (threadIdx.x < 64) {
            const unsigned long long t0 = __builtin_amdgcn_s_memrealtime(); unsigned polls = 0;
            while ((unsigned)__builtin_amdgcn_readfirstlane(__hip_atomic_load(ready + 64 * u.pm, __ATOMIC_RELAXED, __HIP_MEMORY_SCOPE_AGENT)) < need) {
                if ((++polls & 255u) == 0u && __builtin_amdgcn_readfirstlane(__hip_atomic_load(tmo, __ATOMIC_RELAXED, __HIP_MEMORY_SCOPE_AGENT)) != 0u) break;
                if (__builtin_amdgcn_s_memrealtime() - t0 > 2000000ull) {
                    if (threadIdx.x == 0) { unsigned expect = 0u; __hip_atomic_compare_exchange_strong(tmo + 1, &expect, 0x600u | (unsigned)(u.pm & 0xff), __ATOMIC_RELAXED, __ATOMIC_RELAXED, __HIP_MEMORY_SCOPE_AGENT); __hip_atomic_store(tmo, 1u, __ATOMIC_RELAXED, __HIP_MEMORY_SCOPE_AGENT); }
                    break; }
                __builtin_amdgcn_s_sleep(2); }
            __builtin_amdgcn_fence(__ATOMIC_ACQUIRE, "agent");
            asm volatile("s_waitcnt vmcnt(0)" ::: "memory");
        }
#if !defined(BROKEN_HOOK_NO_BARRIER)
        asm volatile("" ::: "memory"); __builtin_amdgcn_s_barrier(); asm volatile("" ::: "memory");
#endif
    }
};

__device__ __forceinline__ unsigned cvt_pk_bf16(float lo, float hi) { unsigned r; asm volatile("v_cvt_pk_bf16_f32 %0, %1, %2" : "=v"(r) : "v"(lo), "v"(hi)); return r; }
typedef float f32x2 __attribute__((ext_vector_type(2)));
__device__ __forceinline__ f32x2 gelu_pk(f32x2 v) {
    const f32x2 av = __builtin_elementwise_abs(v), d = av * 0.2316418882f + 1.0f;
    f32x2 t; t.x = __builtin_amdgcn_rcpf(d.x); t.y = __builtin_amdgcn_rcpf(d.y);
    f32x2 q = t * 0.5307027145f + (-0.7265760135f); q = q * t + 0.7107068705f; q = q * t + (-0.142248368f); q = q * t + 0.127414796f; q = q * t;
    const f32x2 s = (v * v) * (-0.72134752044f);
    f32x2 e; e.x = __builtin_amdgcn_exp2f(s.x); e.y = __builtin_amdgcn_exp2f(s.y);
    const f32x2 m = v * (q * e), r = v - m;
    f32x2 o; o.x = v.x < 0.f ? m.x : r.x; o.y = v.y < 0.f ? m.y : r.y; return o;
}

struct EpiF32 {
    static constexpr bool PERM = false, AFTER_DRAIN = false;
    float* C; int ldc; const float* bias;
    __device__ __forceinline__ void operator()(const f32x4 (&acc)[2][2][4][2], const Unit& u, int wr, int wc, int fr, int fq) const {
        const int row0 = u.pm * BM + wr * 64 + fr, col0 = u.pn * BM + wc * 32 + 4 * fq;
        f32x4 bv[2][2];
#pragma unroll
        for (int bj = 0; bj < 2; ++bj)
#pragma unroll
            for (int n = 0; n < 2; ++n) bv[bj][n] = bias ? *(const f32x4*)(bias + col0 + bj * HALF + n * 16) : (f32x4){0.f, 0.f, 0.f, 0.f};
#pragma unroll
        for (int ai = 0; ai < 2; ++ai)
#pragma unroll
            for (int m = 0; m < 4; ++m) { float* rowp = C + (size_t)(row0 + ai * HALF + m * 16) * ldc + col0;
#pragma unroll
                for (int bj = 0; bj < 2; ++bj)
#pragma unroll
                    for (int n = 0; n < 2; ++n) *(f32x4*)(rowp + bj * HALF + n * 16) = acc[ai][bj][m][n] + bv[bj][n]; }
    }
};
template <int ACT  > struct EpiBf16 {
    static constexpr bool PERM = true, AFTER_DRAIN = false;
    bf16_t* O; int ldc; const float* bias; int split_cols; size_t split_stride;
    __device__ __forceinline__ void operator()(const f32x4 (&acc)[2][2][4][2], const Unit& u, int wr, int wc, int fr, int fq) const {
        const int row0 = u.pm * BM + wr * 64 + fr; int colt = u.pn * BM; bf16_t* base = O;
        if (split_cols) { const int t = colt / split_cols; base += (size_t)t * split_stride; colt -= t * split_cols; }
        const int col0 = colt + wc * 32 + 8 * fq, bcol0 = u.pn * BM + wc * 32 + 8 * fq;
        f32x4 bv[2][2];
#pragma unroll
        for (int bj = 0; bj < 2; ++bj)
#pragma unroll
            for (int n = 0; n < 2; ++n) bv[bj][n] = bias ? *(const f32x4*)(bias + bcol0 + bj * HALF + 4 * n) : (f32x4){0.f, 0.f, 0.f, 0.f};
#pragma unroll
        for (int ai = 0; ai < 2; ++ai)
#pragma unroll
            for (int m = 0; m < 4; ++m) { bf16_t* rowp = base + (size_t)(row0 + ai * HALF + m * 16) * ldc + col0;
#pragma unroll
                for (int bj = 0; bj < 2; ++bj) { f32x4 v0 = acc[ai][bj][m][0] + bv[bj][0], v1 = acc[ai][bj][m][1] + bv[bj][1];
                    if (ACT == 1) { f32x2 a = gelu_pk((f32x2){v0[0], v0[1]}), b = gelu_pk((f32x2){v0[2], v0[3]}), c = gelu_pk((f32x2){v1[0], v1[1]}), d = gelu_pk((f32x2){v1[2], v1[3]});
                        v0 = (f32x4){a.x, a.y, b.x, b.y}; v1 = (f32x4){c.x, c.y, d.x, d.y}; }
                    if (ACT == 2) {
#pragma unroll
                        for (int j = 0; j < 4; ++j) { v0[j] = 0.5f * v0[j] * (1.0f + erff(v0[j] * 0.70710678f)); v1[j] = 0.5f * v1[j] * (1.0f + erff(v1[j] * 0.70710678f)); } }
                    u32x4 w; w.x = cvt_pk_bf16(v0[0], v0[1]); w.y = cvt_pk_bf16(v0[2], v0[3]); w.z = cvt_pk_bf16(v1[0], v1[1]); w.w = cvt_pk_bf16(v1[2], v1[3]);
                    *(u32x4*)(rowp + bj * HALF) = w; } }
    }
};

struct PanelStats {
    unsigned* xbuf;
    unsigned* cnt;
    unsigned* tmo;
    int ntn; float eps;
    unsigned code;
    __device__ __forceinline__ bool run(const f32x4 (&v)[2][2][4][2], const Unit& u, int wr, int wc, int fr, int fq, PG8_LAS unsigned char* lds, int wid, int lane) const {
        typedef float f32x2v __attribute__((ext_vector_type(2)));
        PG8_LAS f32x2v* P = (PG8_LAS f32x2v*)lds;
        PG8_LAS f32x2v* S = (PG8_LAS f32x2v*)(lds + 8192);
        PG8_LAS unsigned* flag = (PG8_LAS unsigned*)(lds + 8192 + 2048);
#pragma unroll
        for (int ai = 0; ai < 2; ++ai)
#pragma unroll
            for (int m = 0; m < 4; ++m) {
                float s = 0.f;
#pragma unroll
                for (int bj = 0; bj < 2; ++bj)
#pragma unroll
                    for (int n = 0; n < 2; ++n) { const f32x4 x = v[ai][bj][m][n]; s += (x[0] + x[1]) + (x[2] + x[3]); }
                s += __shfl_xor(s, 16); s += __shfl_xor(s, 32);
                const float mw = s * (1.0f / 64.0f); float q = 0.f;
#pragma unroll
                for (int bj = 0; bj < 2; ++bj)
#pragma unroll
                    for (int n = 0; n < 2; ++n) { const f32x4 d = v[ai][bj][m][n] - mw; q += (d[0] * d[0] + d[1] * d[1]) + (d[2] * d[2] + d[3] * d[3]); }
                q += __shfl_xor(q, 16); q += __shfl_xor(q, 32);
                if (fq == 0) P[(ai * HALF + wr * 64 + m * 16 + fr) * 4 + wc] = (f32x2v){mw, q};
            }
        asm volatile("s_waitcnt lgkmcnt(0)" ::: "memory"); __builtin_amdgcn_s_barrier(); asm volatile("" ::: "memory");
#if defined(BROKEN_NO_WAIT)
        if (blockIdx.x >= 64) { const long long t0 = clock64(); while (clock64() - t0 < 60000) __builtin_amdgcn_s_sleep(8); }
#endif
        const int row = wid * 32 + (lane & 31);
        if (lane < 32) {
            const f32x2v a = P[row * 4 + 0], b = P[row * 4 + 1], c = P[row * 4 + 2], d = P[row * 4 + 3];
            const float mt = (a.x + b.x + c.x + d.x) * 0.25f;
            const float da = a.x - mt, db = b.x - mt, dc = c.x - mt, dd = d.x - mt;
            const float m2 = (a.y + b.y) + (c.y + d.y) + 64.0f * ((da * da + db * db) + (dc * dc + dd * dd));
            unsigned long long* slot = (unsigned long long*)xbuf + ((size_t)(u.pm * BM + row) * 4 + u.pn);
            __hip_atomic_store(slot, ((unsigned long long)__float_as_uint(m2) << 32) | __float_as_uint(mt), __ATOMIC_RELAXED, __HIP_MEMORY_SCOPE_AGENT);
        }
        asm volatile("s_waitcnt vmcnt(0)" ::: "memory");
        if (lane == 0) __hip_atomic_fetch_add(cnt + 64 * u.pm, 1u, __ATOMIC_RELAXED, __HIP_MEMORY_SCOPE_AGENT);
        if (wid == 0) {
            bool dead = false; const unsigned long long t0 = __builtin_amdgcn_s_memrealtime(); const unsigned want = 8u * (unsigned)ntn;
            for (;;) {
#if defined(BROKEN_NO_WAIT)
                break;
#endif
                if ((unsigned)__builtin_amdgcn_readfirstlane(__hip_atomic_load(cnt + 64 * u.pm, __ATOMIC_RELAXED, __HIP_MEMORY_SCOPE_AGENT)) >= want) break;
                if (__builtin_amdgcn_s_memrealtime() - t0 > 2000000ull) {
                    if (lane == 0) { unsigned expect = 0u; __hip_atomic_compare_exchange_strong(tmo + 1, &expect, code | (unsigned)(u.pm & 0xff), __ATOMIC_RELAXED, __ATOMIC_RELAXED, __HIP_MEMORY_SCOPE_AGENT);
                                     __hip_atomic_store(tmo, 1u, __ATOMIC_RELAXED, __HIP_MEMORY_SCOPE_AGENT); }
                    dead = true; break; }
                __builtin_amdgcn_s_sleep(2);
            }
            __builtin_amdgcn_fence(__ATOMIC_ACQUIRE, "agent");
            if (lane == 0) flag[0] = dead ? 1u : 0u;
        }
        asm volatile("s_waitcnt vmcnt(0) lgkmcnt(0)" ::: "memory"); __builtin_amdgcn_s_barrier(); asm volatile("" ::: "memory");
        const bool bad = flag[0] != 0u;
        if (lane < 32) {
            const unsigned long long* slot = (const unsigned long long*)xbuf + (size_t)(u.pm * BM + row) * 4; float mt[4], m2[4]; float ms = 0.f;
#pragma unroll
            for (int t = 0; t < 4; ++t) { if (t < ntn) { const unsigned long long w = __hip_atomic_load(slot + t, __ATOMIC_RELAXED, __HIP_MEMORY_SCOPE_AGENT); mt[t] = __uint_as_float((unsigned)w); m2[t] = __uint_as_float((unsigned)(w >> 32)); } else { mt[t] = 0.f; m2[t] = 0.f; } ms += mt[t]; }
            const float mean = ms / (float)ntn; float q = 0.f;
#pragma unroll
            for (int t = 0; t < 4; ++t) if (t < ntn) { const float dm = mt[t] - mean; q += m2[t] + 256.0f * dm * dm; }
            S[row] = (f32x2v){mean, 1.0f / sqrtf(q / (256.0f * (float)ntn) + eps)};
        }
        asm volatile("s_waitcnt lgkmcnt(0)" ::: "memory"); __builtin_amdgcn_s_barrier(); asm volatile("" ::: "memory");
        return bad;
    }
};
struct EpiLnRes {
    static constexpr bool PERM = false, AFTER_DRAIN = true;
    const float* base; float* out; int ldc; const float* bias; PanelStats st; unsigned poison;
    __device__ __forceinline__ void refuse(size_t i0, size_t stride, int M, int N) const { const float q = __builtin_nanf(""); for (size_t i = i0; i < (size_t)M * N; i += stride) out[(i / N) * ldc + i % N] = q;
        if (i0 == 0) { unsigned expect = 0u; __hip_atomic_compare_exchange_strong(st.tmo + 1, &expect, 0x7f0u, __ATOMIC_RELAXED, __ATOMIC_RELAXED, __HIP_MEMORY_SCOPE_AGENT); __hip_atomic_store(st.tmo, 1u, __ATOMIC_RELAXED, __HIP_MEMORY_SCOPE_AGENT); } }
    __device__ __forceinline__ void fused(f32x4 (&acc)[2][2][4][2], const Unit& u, int wr, int wc, int fr, int fq, PG8_LAS unsigned char* lds, int wid, int lane) const {
        typedef float f32x2v __attribute__((ext_vector_type(2)));
        const PG8_LAS f32x2v* S = (const PG8_LAS f32x2v*)(lds + 8192);
        const int col0 = u.pn * BM + wc * 32 + 4 * fq;
#pragma unroll
        for (int bj = 0; bj < 2; ++bj)
#pragma unroll
            for (int n = 0; n < 2; ++n) { const f32x4 bv = bias ? *(const f32x4*)(bias + col0 + bj * HALF + n * 16) : (f32x4){0.f, 0.f, 0.f, 0.f};
#pragma unroll
                for (int ai = 0; ai < 2; ++ai)
#pragma unroll
                    for (int m = 0; m < 4; ++m) acc[ai][bj][m][n] += bv; }
        const bool bad = st.run(acc, u, wr, wc, fr, fq, lds, wid, lane) || poison != 0u;
        const float qnan = __builtin_nanf("");
#pragma unroll
        for (int ai = 0; ai < 2; ++ai)
#pragma unroll
            for (int m = 0; m < 4; ++m) { const int r = ai * HALF + wr * 64 + m * 16 + fr; const f32x2v sr = S[r]; const size_t off = (size_t)(u.pm * BM + r) * ldc + col0;
#pragma unroll
                for (int bj = 0; bj < 2; ++bj)
#pragma unroll
                    for (int n = 0; n < 2; ++n) { const f32x4 bs = *(const f32x4*)(base + off + bj * HALF + n * 16); f32x4 o = bs + (acc[ai][bj][m][n] - sr.x) * sr.y;
                        if (bad) o = (f32x4){qnan, qnan, qnan, qnan}; *(f32x4*)(out + off + bj * HALF + n * 16) = o; }
                asm volatile("" ::: "memory"); }
    }
};
struct EpiLnResLn {
    static constexpr bool PERM = false, AFTER_DRAIN = true;
    const float* base; float* out; bf16_t* xn; int ldc; const float* bias; PanelStats st1, st2; unsigned poison;
    __device__ __forceinline__ void refuse(size_t i0, size_t stride, int M, int N) const { const float q = __builtin_nanf(""); for (size_t i = i0; i < (size_t)M * N; i += stride) { const size_t o = (i / N) * ldc + i % N; out[o] = q; xn[o] = (bf16_t)0x7fc0u; }
        if (i0 == 0) { unsigned expect = 0u; __hip_atomic_compare_exchange_strong(st1.tmo + 1, &expect, 0x7f0u, __ATOMIC_RELAXED, __ATOMIC_RELAXED, __HIP_MEMORY_SCOPE_AGENT); __hip_atomic_store(st1.tmo, 1u, __ATOMIC_RELAXED, __HIP_MEMORY_SCOPE_AGENT); } }
    __device__ __forceinline__ void fused(f32x4 (&acc)[2][2][4][2], const Unit& u, int wr, int wc, int fr, int fq, PG8_LAS unsigned char* lds, int wid, int lane) const {
        typedef float f32x2v __attribute__((ext_vector_type(2))); typedef unsigned u32x2v __attribute__((ext_vector_type(2)));
        const PG8_LAS f32x2v* S = (const PG8_LAS f32x2v*)(lds + 8192);
        const int col0 = u.pn * BM + wc * 32 + 4 * fq;
#pragma unroll
        for (int bj = 0; bj < 2; ++bj)
#pragma unroll
            for (int n = 0; n < 2; ++n) { const f32x4 bv = bias ? *(const f32x4*)(bias + col0 + bj * HALF + n * 16) : (f32x4){0.f, 0.f, 0.f, 0.f};
#pragma unroll
                for (int ai = 0; ai < 2; ++ai)
#pragma unroll
                    for (int m = 0; m < 4; ++m) acc[ai][bj][m][n] += bv; }
        bool bad = st1.run(acc, u, wr, wc, fr, fq, lds, wid, lane) || poison != 0u;
        const float qnan = __builtin_nanf("");
#pragma unroll
        for (int ai = 0; ai < 2; ++ai)
#pragma unroll
            for (int m = 0; m < 4; ++m) { const int r = ai * HALF + wr * 64 + m * 16 + fr; const f32x2v sr = S[r]; const size_t off = (size_t)(u.pm * BM + r) * ldc + col0;
#pragma unroll
                for (int bj = 0; bj < 2; ++bj)
#pragma unroll
                    for (int n = 0; n < 2; ++n) { const f32x4 bs = *(const f32x4*)(base + off + bj * HALF + n * 16); acc[ai][bj][m][n] = bs + (acc[ai][bj][m][n] - sr.x) * sr.y; }
                asm volatile("" : "+v"(acc[ai][0][m][0]), "+v"(acc[ai][0][m][1]), "+v"(acc[ai][1][m][0]), "+v"(acc[ai][1][m][1]));
                if (m & 1) asm volatile("" ::: "memory"); }
        const bool bad1 = bad;
        bad = st2.run(acc, u, wr, wc, fr, fq, lds, wid, lane) || bad;
#pragma unroll
        for (int ai = 0; ai < 2; ++ai)
#pragma unroll
            for (int m = 0; m < 4; ++m) { const int r = ai * HALF + wr * 64 + m * 16 + fr; const f32x2v sr = S[r]; const size_t off = (size_t)(u.pm * BM + r) * ldc + col0;
#pragma unroll
                for (int bj = 0; bj < 2; ++bj)
#pragma unroll
                    for (int n = 0; n < 2; ++n) { const f32x4 x1 = acc[ai][bj][m][n]; *(f32x4*)(out + off + bj * HALF + n * 16) = bad1 ? (f32x4){qnan, qnan, qnan, qnan} : x1;
                        const f32x4 o = (x1 - sr.x) * sr.y; u32x2v w; w.x = cvt_pk_bf16(o[0], o[1]); w.y = cvt_pk_bf16(o[2], o[3]);
                        if (bad) { w.x = 0x7fc07fc0u; w.y = 0x7fc07fc0u; } *(u32x2v*)(xn + off + bj * HALF + n * 16) = w; }
                asm volatile("" ::: "memory"); }
    }
};

template <class Epi, class Sched, bool STAMP = false>
__device__ __forceinline__ void gemm_phase(PG8_LAS unsigned char* lds, const Gemm g, const Sched& S, const Epi& E, unsigned long long* stamps) {
    const int tid = threadIdx.x, wid = __builtin_amdgcn_readfirstlane(tid >> 6), lane = tid & 63, wr = wid >> 2, wc = wid & 3, fr = lane & 15, fq = lane >> 4;
    const int K = g.K, nt = K / BK;
    int ts_lo = 0, ts_hi = 0, nts = 0; const unsigned long long rt_entry = STAMP ? (unsigned long long)wall_clock64() : 0ull;
#define PG8_STAMP() do { if (STAMP && wid == 0 && nts < 64) { const unsigned long long _c = (unsigned long long)clock64(); \
        ts_lo = (lane == nts) ? (int)(unsigned)_c : ts_lo; ts_hi = (lane == nts) ? (int)(unsigned)(_c >> 32) : ts_hi; ++nts; } } while (0)
    PG8_STAMP();
    unsigned voffA[2], voffB[2];
#pragma unroll
    for (int i = 0; i < 2; ++i) { int R, C; stage_rc(tid * 16 + i * 8192, R, C); const int Rb = Epi::PERM ? ((R & ~31) + perm32(R & 31)) : R;
        voffA[i] = (unsigned)(R * K + C) * 2u; voffB[i] = (unsigned)(Rb * K + C) * 2u; }
    const size_t kstep = (size_t)(BK * 2);
    const size_t hstep = (size_t)HALF * K * 2;
    const size_t tstep = 2 * hstep;
    const unsigned ldsw = (unsigned)wid * 1024u;
    const int aoff = lds_byte(wr * 64 + fr, fq * 8), boff = lds_byte(wc * 32 + fr, fq * 8);
#define PG8_SA(b, h) (((b) * 2 + (h)) * HTB)
#define PG8_SB(b, h) ((4 + (b) * 2 + (h)) * HTB)
#define PG8_STAGE(bufoff, gbase, voff) do { _Pragma("unroll") for (int _i = 0; _i < 2; ++_i) \
        __builtin_amdgcn_global_load_lds((const unsigned*)((const char*)(gbase) + (voff)[_i]), (PG8_LAS unsigned*)(lds + (bufoff) + ldsw + _i * 8192), 16, 0, 0); } while (0)
#define PG8_LDA(dst, b, h) do { _Pragma("unroll") for (int m = 0; m < 4; ++m) _Pragma("unroll") for (int k = 0; k < 2; ++k) dst[m][k] = *(const PG8_LAS bf16x8*)(lds + PG8_SA(b, h) + aoff + m * 2048 + k * 1024); } while (0)
#define PG8_LDB(dst, b, h) do { _Pragma("unroll") for (int n = 0; n < 2; ++n) _Pragma("unroll") for (int k = 0; k < 2; ++k) dst[n][k] = *(const PG8_LAS bf16x8*)(lds + PG8_SB(b, h) + boff + n * 2048 + k * 1024); } while (0)
#define PG8_MMA(ai, bj, At, Bt) do { __builtin_amdgcn_s_setprio(1); _Pragma("unroll") for (int m = 0; m < 4; ++m) _Pragma("unroll") for (int n = 0; n < 2; ++n) _Pragma("unroll") for (int k = 0; k < 2; ++k) \
        acc[ai][bj][m][n] = __builtin_amdgcn_mfma_f32_16x16x32_bf16(Bt[n][k], At[m][k], acc[ai][bj][m][n], 0, 0, 0); __builtin_amdgcn_s_setprio(0); } while (0)
#define PG8_WAIT_V(n) asm volatile("s_waitcnt vmcnt(" #n ")" ::: "memory")
#define PG8_WAIT_L(n) asm volatile("s_waitcnt lgkmcnt(" #n ")" ::: "memory")
#define PG8_BAR __builtin_amdgcn_s_barrier()
#define PG8_SCHED __builtin_amdgcn_sched_barrier(0)
    Unit cur, nxt; int ui = 0;
    if (!S.next(0, cur)) return;
    f32x4 acc[2][2][4][2];
#pragma unroll
    for (int a = 0; a < 2; ++a)
#pragma unroll
        for (int b = 0; b < 2; ++b)
#pragma unroll
            for (int m = 0; m < 4; ++m)
#pragma unroll
                for (int n = 0; n < 2; ++n) acc[a][b][m][n] = (f32x4){0.f, 0.f, 0.f, 0.f};
    bf16x8 At[4][2], B0[2][2], B1[2][2];
    const char* cA = (const char*)g.A + (size_t)cur.pm * tstep; const char* cB = (const char*)g.Bt + (size_t)cur.pn * tstep;
    S.a_ready(cur);
    PG8_STAGE(PG8_SB(0, 0), cB, voffB); PG8_STAGE(PG8_SA(0, 0), cA, voffA); PG8_STAGE(PG8_SB(0, 1), cB + hstep, voffB); PG8_STAGE(PG8_SA(0, 1), cA + hstep, voffA);
    if (wr == 1) PG8_BAR;
    PG8_WAIT_V(4); PG8_BAR;
    PG8_STAGE(PG8_SB(1, 0), cB + kstep, voffB); PG8_STAGE(PG8_SA(1, 0), cA + kstep, voffA); PG8_STAGE(PG8_SB(1, 1), cB + hstep + kstep, voffB);
    PG8_WAIT_V(6); PG8_BAR;
    PG8_STAMP();
    for (;;) {
        const bool has_next = S.next(ui + 1, nxt);
        const char* nA = has_next ? (const char*)g.A + (size_t)nxt.pm * tstep : cA; const char* nB = has_next ? (const char*)g.Bt + (size_t)nxt.pn * tstep : cB;
        for (int t = 0; t < nt; t += 2) {
            const bool last = (t == nt - 2);
            const char* a1 = cA + (size_t)(t + 1) * kstep;
            const char* a2 = last ? nA : cA + (size_t)(t + 2) * kstep; const char* b2 = last ? nB : cB + (size_t)(t + 2) * kstep;
            const char* a3 = a2 + kstep; const char* b3 = b2 + kstep;
            if (last && has_next) S.a_ready(nxt);
            PG8_LDB(B0, 0, 0); PG8_SCHED; PG8_LDA(At, 0, 0); PG8_STAGE(PG8_SA(1, 1), a1 + hstep, voffA);
            PG8_WAIT_L(8); PG8_BAR; PG8_WAIT_L(0); PG8_MMA(0, 0, At, B0); PG8_BAR; PG8_SCHED;
            PG8_LDB(B1, 0, 1); PG8_STAGE(PG8_SB(0, 0), b2, voffB);
            PG8_BAR; PG8_WAIT_L(0); PG8_MMA(0, 1, At, B1); PG8_BAR;
            PG8_LDA(At, 0, 1); PG8_STAGE(PG8_SA(0, 0), a2, voffA);
            PG8_BAR; PG8_WAIT_L(0); PG8_MMA(1, 0, At, B0); PG8_BAR; PG8_SCHED;
            PG8_STAGE(PG8_SB(0, 1), b2 + hstep, voffB);
            PG8_WAIT_V(6); PG8_BAR; PG8_MMA(1, 1, At, B1); PG8_BAR;
            PG8_LDB(B0, 1, 0); PG8_SCHED; PG8_LDA(At, 1, 0); PG8_STAGE(PG8_SA(0, 1), a2 + hstep, voffA);
            PG8_WAIT_L(8); PG8_BAR; PG8_WAIT_L(0); PG8_MMA(0, 0, At, B0); PG8_BAR; PG8_SCHED;
            PG8_LDB(B1, 1, 1); PG8_STAGE(PG8_SB(1, 0), b3, voffB);
            PG8_BAR; PG8_WAIT_L(0); PG8_MMA(0, 1, At, B1); PG8_BAR;
            PG8_LDA(At, 1, 1); PG8_STAGE(PG8_SA(1, 0), a3, voffA);
            PG8_BAR; PG8_WAIT_L(0); PG8_MMA(1, 0, At, B0); PG8_BAR; PG8_SCHED;
            PG8_STAGE(PG8_SB(1, 1), b3 + hstep, voffB);
            PG8_WAIT_V(6); PG8_BAR; PG8_MMA(1, 1, At, B1); PG8_BAR;
        }
        PG8_STAMP();
        if constexpr (!Epi::AFTER_DRAIN) { E(acc, cur, wr, wc, fr, fq); S.done(cur); }
        PG8_STAMP();
        if (!has_next) break;
#pragma unroll
        for (int a = 0; a < 2; ++a)
#pragma unroll
            for (int b = 0; b < 2; ++b)
#pragma unroll
                for (int m = 0; m < 4; ++m)
#pragma unroll
                    for (int n = 0; n < 2; ++n) acc[a][b][m][n] = (f32x4){0.f, 0.f, 0.f, 0.f};
        cur = nxt; cA = nA; cB = nB; ++ui;
    }
    PG8_WAIT_V(0);
    if (wr == 0) PG8_BAR;
    PG8_BAR;
    if constexpr (Epi::AFTER_DRAIN) { E.fused(acc, cur, wr, wc, fr, fq, lds, wid, lane); S.done(cur); }
    PG8_STAMP();
    if (STAMP && wid == 0) { stamps[lane] = lane < nts ? (((unsigned long long)(unsigned)ts_hi << 32) | (unsigned)ts_lo) : 0ull;
        if (lane == 62) stamps[62] = rt_entry; if (lane == 63) stamps[63] = (unsigned long long)wall_clock64(); }
#undef PG8_STAMP
#undef PG8_SA
#undef PG8_SB
#undef PG8_STAGE
#undef PG8_LDA
#undef PG8_LDB
#undef PG8_MMA
#undef PG8_WAIT_V
#undef PG8_WAIT_L
#undef PG8_BAR
#undef PG8_SCHED
}
}
#define HD __host__ __device__ __forceinline__
#define HY_LDS __attribute__((address_space(3)))
#ifndef HY_F2_STRUCT
typedef float f2 __attribute__((ext_vector_type(2)));
#else
struct __attribute__((aligned(8))) f2 { float x, y; };
#ifndef HD
#define HD __host__ __device__ __forceinline__
#endif
HD f2 operator+(f2 a, f2 b) { return f2{a.x + b.x, a.y + b.y}; }
HD f2 operator-(f2 a, f2 b) { return f2{a.x - b.x, a.y - b.y}; }
HD f2 operator*(f2 a, float b) { return f2{a.x * b, a.y * b}; }
#endif
#ifndef HD
#define HD __host__ __device__ __forceinline__
#endif
#ifndef HY_LDS
#define HY_LDS
#endif
typedef HY_LDS f2* hy_ldsp;
typedef const HY_LDS f2* hy_cldsp;
#if defined(__HIP_DEVICE_COMPILE__)
#define HY_OPAQUE(v) asm volatile("" : "+v"(v))
#else
#define HY_OPAQUE(v) asm volatile("" : "+r"(v))
#endif
namespace hy {
constexpr int FL = 16384;
constexpr int LDS_F2 = 32 * 560;
HD int laddr(int d2, int d1, int d0) { return d2 * 560 + d1 * 17 + d0; }
HD f2 cmul(f2 a, f2 b) { return (f2){a.x * b.x - a.y * b.y, a.x * b.y + a.y * b.x}; }
HD f2 cconj(f2 a) { return (f2){a.x, -a.y}; }
constexpr float C32[32] = { 1.0f, 0.98078528040323044913f, 0.92387953251128675613f, 0.83146961230254523708f, 0.70710678118654752440f, 0.55557023301960222474f, 0.38268343236508977173f, 0.19509032201612826785f,
                            0.0f, -0.19509032201612826785f, -0.38268343236508977173f, -0.55557023301960222474f, -0.70710678118654752440f, -0.83146961230254523708f, -0.92387953251128675613f, -0.98078528040323044913f,
                           -1.0f, -0.98078528040323044913f, -0.92387953251128675613f, -0.83146961230254523708f, -0.70710678118654752440f, -0.55557023301960222474f, -0.38268343236508977173f, -0.19509032201612826785f,
                            0.0f, 0.19509032201612826785f, 0.38268343236508977173f, 0.55557023301960222474f, 0.70710678118654752440f, 0.83146961230254523708f, 0.92387953251128675613f, 0.98078528040323044913f };
constexpr float S32[32] = { 0.0f, 0.19509032201612826785f, 0.38268343236508977173f, 0.55557023301960222474f, 0.70710678118654752440f, 0.83146961230254523708f, 0.92387953251128675613f, 0.98078528040323044913f,
                            1.0f, 0.98078528040323044913f, 0.92387953251128675613f, 0.83146961230254523708f, 0.70710678118654752440f, 0.55557023301960222474f, 0.38268343236508977173f, 0.19509032201612826785f,
                            0.0f, -0.19509032201612826785f, -0.38268343236508977173f, -0.55557023301960222474f, -0.70710678118654752440f, -0.83146961230254523708f, -0.92387953251128675613f, -0.98078528040323044913f,
                           -1.0f, -0.98078528040323044913f, -0.92387953251128675613f, -0.83146961230254523708f, -0.70710678118654752440f, -0.55557023301960222474f, -0.38268343236508977173f, -0.19509032201612826785f };
template <int BITS> HD constexpr int brev(int k) { int r = 0; for (int i = 0; i < BITS; ++i) r |= ((k >> i) & 1) << (BITS - 1 - i); return r; }
template <bool INV> HD f2 twmul32(f2 d, int k) {
    k &= 31;
    if (k == 0) return d;
    if (k == 8) return INV ? (f2){-d.y, d.x} : (f2){d.y, -d.x};
    if (k == 16) return (f2){-d.x, -d.y};
    if (k == 24) return INV ? (f2){d.y, -d.x} : (f2){-d.y, d.x};
    const float c = C32[k], s = INV ? S32[k] : -S32[k];
    return (f2){d.x * c - d.y * s, d.x * s + d.y * c};
}
template <int N, int SPAN, bool INV> struct DifStage {
    static HD void run(f2 (&v)[N]) {
#pragma unroll
        for (int blk = 0; blk < N; blk += 2 * SPAN)
#pragma unroll
            for (int j = 0; j < SPAN; ++j) {
                const f2 a = v[blk + j], b = v[blk + j + SPAN];
                v[blk + j] = a + b;
                v[blk + j + SPAN] = twmul32<INV>(a - b, j * (16 / SPAN));
            }
        DifStage<N, SPAN / 2, INV>::run(v);
    }
};
template <int N, bool INV> struct DifStage<N, 0, INV> { static HD void run(f2 (&)[N]) {} };
template <int N, bool INV> HD void dft_inreg(f2 (&v)[N]) { DifStage<N, N / 2, INV>::run(v); }

HD f2 cis_rev(float rev) {
#if defined(__HIP_DEVICE_COMPILE__)
    return (f2){__builtin_amdgcn_cosf(rev), __builtin_amdgcn_sinf(rev)};
#else
    return (f2){(float)cos(6.283185307179586476925 * (double)rev), (float)sin(6.283185307179586476925 * (double)rev)};
#endif
}
#define HY_CHAIN_DECL(b0, s) f2 _c0 = (b0), _c1 = hy::cmul(_c0, (s)), _s2 = hy::cmul((s), (s)), _c2 = hy::cmul(_c0, _s2), _c3 = hy::cmul(_c1, _s2), _s4 = hy::cmul(_s2, _s2)

template <bool INV_UNUSED = false> HD void fwd_p1(f2 (&x)[32], int t, hy_ldsp lds) {
    HY_OPAQUE(t);
    dft_inreg<32, false>(x);
    const f2 w1 = cis_rev(-(float)t * (1.0f / 16384.0f));
    HY_CHAIN_DECL(((f2){1.0f, 0.0f}), w1);
    const int base = laddr(0, t >> 4, t & 15);
#pragma unroll
    for (int q = 0; q < 8; ++q) {
        lds[base + (4 * q + 0) * 560] = cmul(x[brev<5>(4 * q + 0)], _c0);
        lds[base + (4 * q + 1) * 560] = cmul(x[brev<5>(4 * q + 1)], _c1);
        lds[base + (4 * q + 2) * 560] = cmul(x[brev<5>(4 * q + 2)], _c2);
        lds[base + (4 * q + 3) * 560] = cmul(x[brev<5>(4 * q + 3)], _c3);
        _c0 = cmul(_c0, _s4); _c1 = cmul(_c1, _s4); _c2 = cmul(_c2, _s4); _c3 = cmul(_c3, _s4);
    }
}
HD void fwd_p2(int t, hy_ldsp lds) {
    HY_OPAQUE(t);
    f2 x[32];
    const int d2 = t >> 4, d0 = t & 15, base = laddr(d2, 0, d0);
#pragma unroll
    for (int j = 0; j < 32; ++j) x[j] = lds[base + j * 17];
    dft_inreg<32, false>(x);
    const f2 w1 = cis_rev(-(float)d0 * (1.0f / 512.0f));
    HY_CHAIN_DECL(((f2){1.0f, 0.0f}), w1);
#pragma unroll
    for (int q = 0; q < 8; ++q) {
        lds[base + (4 * q + 0) * 17] = cmul(x[brev<5>(4 * q + 0)], _c0);
        lds[base + (4 * q + 1) * 17] = cmul(x[brev<5>(4 * q + 1)], _c1);
        lds[base + (4 * q + 2) * 17] = cmul(x[brev<5>(4 * q + 2)], _c2);
        lds[base + (4 * q + 3) * 17] = cmul(x[brev<5>(4 * q + 3)], _c3);
        _c0 = cmul(_c0, _s4); _c1 = cmul(_c1, _s4); _c2 = cmul(_c2, _s4); _c3 = cmul(_c3, _s4);
    }
}
HD void fwd_p3(f2 (&s)[2][16], int t, hy_cldsp lds) {
#pragma unroll
    for (int h = 0; h < 2; ++h) {
        const int R = t + 512 * h, base = laddr(R >> 5, R & 31, 0);
#pragma unroll
        for (int j = 0; j < 16; ++j) s[h][j] = lds[base + j];
        dft_inreg<16, false>(s[h]);
    }
}
HD void inv_p1(f2 (&s)[2][16], int t, hy_ldsp lds) {
    HY_OPAQUE(t);
#pragma unroll
    for (int h = 0; h < 2; ++h) {
        const int R = t + 512 * h, d1 = R & 31, base = laddr(R >> 5, d1, 0);
        f2 y[16];
#pragma unroll
        for (int k = 0; k < 16; ++k) y[k] = s[h][brev<4>(k)];
        dft_inreg<16, true>(y);
        const f2 w1 = cis_rev((float)d1 * (1.0f / 512.0f));
        HY_CHAIN_DECL(((f2){1.0f, 0.0f}), w1);
#pragma unroll
        for (int q = 0; q < 4; ++q) {
            lds[base + 4 * q + 0] = cmul(y[brev<4>(4 * q + 0)], _c0);
            lds[base + 4 * q + 1] = cmul(y[brev<4>(4 * q + 1)], _c1);
            lds[base + 4 * q + 2] = cmul(y[brev<4>(4 * q + 2)], _c2);
            lds[base + 4 * q + 3] = cmul(y[brev<4>(4 * q + 3)], _c3);
            _c0 = cmul(_c0, _s4); _c1 = cmul(_c1, _s4); _c2 = cmul(_c2, _s4); _c3 = cmul(_c3, _s4);
        }
    }
}
HD void inv_p2(int t, hy_ldsp lds) {
    HY_OPAQUE(t);
    f2 x[32];
    const int d2 = t >> 4, d0 = t & 15, base = laddr(d2, 0, d0);
#pragma unroll
    for (int j = 0; j < 32; ++j) x[j] = lds[base + j * 17];
    dft_inreg<32, true>(x);
    const f2 b0 = cis_rev((float)(d0 * d2) * (1.0f / 16384.0f)), st = cis_rev((float)d2 * (1.0f / 1024.0f));
    HY_CHAIN_DECL(b0, st);
#pragma unroll
    for (int q = 0; q < 8; ++q) {
        lds[base + (4 * q + 0) * 17] = cmul(x[brev<5>(4 * q + 0)], _c0);
        lds[base + (4 * q + 1) * 17] = cmul(x[brev<5>(4 * q + 1)], _c1);
        lds[base + (4 * q + 2) * 17] = cmul(x[brev<5>(4 * q + 2)], _c2);
        lds[base + (4 * q + 3) * 17] = cmul(x[brev<5>(4 * q + 3)], _c3);
        _c0 = cmul(_c0, _s4); _c1 = cmul(_c1, _s4); _c2 = cmul(_c2, _s4); _c3 = cmul(_c3, _s4);
    }
}
HD void inv_p3(f2 (&x)[32], int t, hy_cldsp lds) {
    f2 y[32];
    const int base = laddr(0, t >> 4, t & 15);
#pragma unroll
    for (int j = 0; j < 32; ++j) y[j] = lds[base + j * 560];
    dft_inreg<32, true>(y);
#pragma unroll
    for (int j = 0; j < 32; ++j) x[j] = y[brev<5>(j)];
}
}
#define HY_FENCE() asm volatile("" ::: "memory")
namespace hy {
typedef unsigned short bf16_t;
HD float bf2f(bf16_t v) { return __builtin_bit_cast(float, ((unsigned)v) << 16); }
HD bf16_t f2bf(float f) { unsigned u = __builtin_bit_cast(unsigned, f); return (bf16_t)((u + 0x7fffu + ((u >> 16) & 1u)) >> 16); }
constexpr int SEQ = 16384, NTOK = 2 * SEQ;
struct JobArgs {
    const bf16_t* ch;
    const bf16_t* kt;
    const float* conv_w;
    const float* conv_b;
    const float* hbias;
    f2* sbase;
    bf16_t* yh;
};
#if defined(__HIP_DEVICE_COMPILE__)
typedef unsigned hy_u2 __attribute__((ext_vector_type(2)));
struct Stash { __amdgpu_buffer_rsrc_t r; };
__device__ __forceinline__ Stash make_stash(const JobArgs& J) { Stash s; s.r = __builtin_amdgcn_make_buffer_rsrc(J.sbase, (short)0, 393216, 0x00020000); return s; }
__device__ __forceinline__ f2 st_load(const Stash& s, int r, int j, int t) { const hy_u2 v = __builtin_amdgcn_raw_buffer_load_b64(s.r, t * 8, r * 131072 + j * 4096, 0); return __builtin_bit_cast(f2, v); }
__device__ __forceinline__ void st_store(const Stash& s, int r, int j, int t, f2 v) { __builtin_amdgcn_raw_buffer_store_b64(__builtin_bit_cast(hy_u2, v), s.r, t * 8, r * 131072 + j * 4096, 0); }
#else
struct Stash { f2* p; };
inline Stash make_stash(const JobArgs& J) { return Stash{J.sbase}; }
inline f2 st_load(const Stash& s, int r, int j, int t) { return s.p[r * 16384 + j * 512 + t]; }
inline void st_store(const Stash& s, int r, int j, int t, f2 v) { s.p[r * 16384 + j * 512 + t] = v; }
#endif
HD void twist_consts(bool tw, int t, f2& base, f2& step) {
    HY_OPAQUE(t);
    if (tw) { base = cis_rev(-(float)t * (1.0f / 32768.0f)); step = (f2){0.99518472667219688624f, -0.09801714032956060199f}; }
    else { base = (f2){1.0f, 0.0f}; step = (f2){1.0f, 0.0f}; }
}
template <bool FIRST, bool LAST> HD float sconv(const bf16_t* pj, int t, float w0, float w1, float w2, float cb) {
    const float pm = (!FIRST || t > 0) ? bf2f(pj[t - 1]) : 0.0f, pc = bf2f(pj[t]), pp = (!LAST || t < 511) ? bf2f(pj[t + 1]) : 0.0f;
    return cb + w0 * pm + w1 * pc + w2 * pp;
}
#define HY_SCONV(j, p, t, w0, w1, w2, cb) ((j) == 0 ? hy::sconv<true, false>((p) + (j) * 512, t, w0, w1, w2, cb) : (j) == 31 ? hy::sconv<false, true>((p) + (j) * 512, t, w0, w1, w2, cb) : hy::sconv<false, false>((p) + (j) * 512, t, w0, w1, w2, cb))
HD void seg_filter_p1(const JobArgs& J, int c, int o, bool tw, int t, hy_ldsp lds) {
    HY_OPAQUE(t); HY_OPAQUE(c);
    f2 x[32];
    const bf16_t* kf = J.kt + (size_t)((o * 2 + 0) * 512 + c) * SEQ;
    const bf16_t* kr = J.kt + (size_t)((o * 2 + 1) * 512 + c) * SEQ;
    const float sgn = tw ? -1.0f : 1.0f, bias = J.hbias[o * 512 + c];
    f2 base, step; twist_consts(tw, t, base, step);
    f2 cur = base;
#pragma unroll
    for (int j = 0; j < 32; ++j) {
        const int n = j * 512 + t;
        float a = bf2f(kf[n]) + sgn * bf2f(kr[SEQ - 1 - n]);
        if (n == 0) a += bias;
        a *= (1.0f / 32768.0f);
        x[j] = cur * a;
        cur = cmul(cur, step);
        if ((j & 7) == 7) HY_FENCE();
    }
    fwd_p1(x, t, lds);
}
HD void seg_prep(const JobArgs& J, const Stash& S, int c, int t) {
    HY_OPAQUE(t); HY_OPAQUE(c);
    const bf16_t* p0 = J.ch + (size_t)c * NTOK; const bf16_t* p1 = p0 + SEQ;
    const float w0 = J.conv_w[c], w1 = J.conv_w[1536 + c], w2 = J.conv_w[3072 + c], cb = J.conv_b[c];
#pragma unroll
    for (int j = 0; j < 32; ++j) {
        st_store(S, 1, j, t, (f2){HY_SCONV(j, p0, t, w0, w1, w2, cb), HY_SCONV(j, p1, t, w0, w1, w2, cb)});
        if ((j & 3) == 3) HY_FENCE();
    }
}
HD void seg_data_p1(const Stash& S, bool tw, int t, hy_ldsp lds) {
    HY_OPAQUE(t);
    f2 x[32];
    f2 base, step; twist_consts(tw, t, base, step);
    f2 cur = base;
#pragma unroll
    for (int j = 0; j < 32; ++j) { const f2 z = st_load(S, 1, j, t); x[j] = cmul(z, cur); cur = cmul(cur, step); if ((j & 7) == 7) HY_FENCE(); }
    fwd_p1(x, t, lds);
}
HD void seg_filter_p3(const Stash& S, int t, hy_cldsp lds) {
    f2 K[2][16];
    fwd_p3(K, t, lds);
#pragma unroll
    for (int h = 0; h < 2; ++h)
#pragma unroll
        for (int i = 0; i < 16; ++i) st_store(S, 2, h * 16 + i, t, K[h][i]);
    HY_FENCE();
}
HD void seg_mul(const Stash& S, int t, hy_ldsp lds) {
    f2 s[2][16];
    fwd_p3(s, t, lds);
#pragma unroll
    for (int h = 0; h < 2; ++h) {
#pragma unroll
        for (int i = 0; i < 16; ++i) s[h][i] = cmul(s[h][i], st_load(S, 2, h * 16 + i, t));
        HY_FENCE();
    }
    inv_p1(s, t, lds);
}
HD void seg_out(const JobArgs& J, const Stash& S, int c, int o, bool tw, int t, hy_cldsp lds) {
    HY_OPAQUE(t); HY_OPAQUE(c);
    f2 x[32];
    inv_p3(x, t, lds);
    if (!tw) {
#pragma unroll
        for (int j = 0; j < 32; ++j) st_store(S, 0, j, t, x[j]);
        HY_FENCE();
        return;
    }
    f2 base, step; twist_consts(true, t, base, step);
    f2 cur = cconj(base); const f2 stc = cconj(step);
    const int row = (o == 0 ? 512 : 1024) + c;
    const bf16_t* p0 = J.ch + (size_t)row * NTOK; const bf16_t* p1 = p0 + SEQ;
    const float w0 = J.conv_w[row], w1 = J.conv_w[1536 + row], w2 = J.conv_w[3072 + row], cb = J.conv_b[row];
    const bf16_t* g0 = J.ch + (size_t)(1536 + c) * NTOK; const bf16_t* g1 = g0 + SEQ;
#pragma unroll
    for (int j = 0; j < 32; ++j) {
        const int n = j * 512 + t;
        const f2 r = cmul(x[j], cur) + st_load(S, 0, j, t); cur = cmul(cur, stc);
        const float a0 = HY_SCONV(j, p0, t, w0, w1, w2, cb) * r.x, a1 = HY_SCONV(j, p1, t, w0, w1, w2, cb) * r.y;
        if (o == 0) st_store(S, 1, j, t, (f2){a0, a1});
        else {
            const float q0 = bf2f(g0[n]), q1 = bf2f(g1[n]);
            bf16_t* y = J.yh + (size_t)c * NTOK;
            y[n] = f2bf(a0 * q0 / (1.0f + __builtin_expf(-q0)));
            y[SEQ + n] = f2bf(a1 * q1 / (1.0f + __builtin_expf(-q1)));
        }
        if ((j & 3) == 3) HY_FENCE();
    }
}
}
namespace hm {
typedef _Float16 h8 __attribute__((ext_vector_type(8)));
typedef float f32x16 __attribute__((ext_vector_type(16)));
typedef unsigned u4 __attribute__((ext_vector_type(4)));
typedef unsigned u2 __attribute__((ext_vector_type(2)));
typedef unsigned short bf16_t;
typedef _Float16 hh2v __attribute__((ext_vector_type(2)));
constexpr int RS = 132, IMG_DW = 128 * RS;
constexpr int SEQ = 16384, NTOK = 2 * SEQ;
#ifndef HM_LAS
#define HM_LAS __attribute__((address_space(3)))
#endif
__device__ __forceinline__ float asf(unsigned v) { return __builtin_bit_cast(float, v); }
__device__ __forceinline__ unsigned pkh(float re, float im) { return __builtin_bit_cast(unsigned, __builtin_amdgcn_cvt_pkrtz(re, im)); }
__device__ __forceinline__ f2 cisr(float rev) { return (f2){__builtin_amdgcn_cosf(rev), __builtin_amdgcn_sinf(rev)}; }
__device__ __forceinline__ f2 cm(f2 a, f2 b) { return (f2){a.x * b.x - a.y * b.y, a.x * b.y + a.y * b.x}; }
__device__ __forceinline__ float bf2f(bf16_t v) { return __builtin_bit_cast(float, ((unsigned)v) << 16); }
__device__ __forceinline__ bf16_t f2bf(float f) { unsigned u = __builtin_bit_cast(unsigned, f); return (bf16_t)((u + 0x7fffu + ((u >> 16) & 1u)) >> 16); }

#ifdef HM_HOST_EMU
struct Job { const bf16_t* ch; const bf16_t* kt; const float* conv_w; const float* conv_b; const float* hbias; bf16_t* yh; __amdgpu_buffer_rsrc_t pk; __amdgpu_buffer_rsrc_t st; };
#define JP_CH(J) (J).ch
#define JP_KT(J) (J).kt
#define JP_CONVW(J) (J).conv_w
#define JP_CONVB(J) (J).conv_b
#define JP_HBIAS(J) (J).hbias
#else
typedef const __attribute__((address_space(4))) unsigned char* hm_ka_t;
struct Job {
    hm_ka_t ka;
    bf16_t* yh;
#if defined(HM_IDFILT) || defined(HM_STAGETEST) || defined(HM_KTEST)
    unsigned* dbg;
#endif
    __amdgpu_buffer_rsrc_t pk;
    __amdgpu_buffer_rsrc_t st;
};
template <class T> __device__ __forceinline__ T* hm_kaptr(hm_ka_t ka, int off) { asm volatile("" : "+s"(ka)); return *(T* const __attribute__((address_space(4)))*)(ka + off); }
#define HM_WS_CH (148u << 20)
#define HM_WS_KT (84u << 20)
#define JP_CH(J) ((const bf16_t*)(hm_kaptr<unsigned char>((J).ka, 176) + HM_WS_CH))
#define JP_KT(J) ((const bf16_t*)(hm_kaptr<unsigned char>((J).ka, 176) + HM_WS_KT))
#define JP_CONVW(J) hm_kaptr<const float>((J).ka, 8 * 6)
#define JP_CONVB(J) hm_kaptr<const float>((J).ka, 8 * 7)
#define JP_HBIAS(J) hm_kaptr<const float>((J).ka, 8 * 14)
#endif
#ifndef HM_ST_NOP
#define HM_ST_NOP "s_nop 7"
#endif
#ifdef HM_HOST_EMU
#define __builtin_amdgcn_sched_barrier(x) do { } while (0)
#define HM_KEEP1(nop, a) do { } while (0)
#define HM_KEEP2(nop, a, b) do { } while (0)
#else
#define HM_KEEP1(nop, a) asm volatile(nop : "+v"(a))
#define HM_KEEP2(nop, a, b) asm volatile(nop : "+v"(a), "+v"(b))
#endif
__device__ __forceinline__ void st_b128(u4 v, __amdgpu_buffer_rsrc_t r, int vo, int so) { __builtin_amdgcn_raw_buffer_store_b128(v, r, vo, so, 0); HM_KEEP1(HM_ST_NOP, v); }
__device__ __forceinline__ void st_b64(u2 v, __amdgpu_buffer_rsrc_t r, int vo, int so) { __builtin_amdgcn_raw_buffer_store_b64(v, r, vo, so, 0); HM_KEEP1(HM_ST_NOP, v); }
__device__ __forceinline__ void st_b16(short v, __amdgpu_buffer_rsrc_t r, int vo, int so) { int x = v; __builtin_amdgcn_raw_buffer_store_b16((short)x, r, vo, so, 0); HM_KEEP1(HM_ST_NOP, x); }
#ifdef HM_HOST_EMU
#define SOFS(x) (x)
#else
__device__ __forceinline__ int sofs_(int x) { asm volatile("" : "+s"(x)); return x; }
#define SOFS(x) sofs_(x)
#endif
__device__ __forceinline__ void build_A(h8 (&A)[16], int wave, int lane) {
    const int r = lane & 31, h = lane >> 5, part = (r >> 3) & 1, k = 16 * wave + 8 * (r >> 4) + 4 * ((r >> 2) & 1) + (r & 3);
#pragma unroll
    for (int s = 0; s < 16; ++s) {
        h8 v;
#pragma unroll
        for (int d = 0; d < 4; ++d) {
            const int n = 8 * s + 4 * h + d;
            const float rev = (float)((k * n) & 127) * (1.0f / 128.0f);
            const float c = __builtin_amdgcn_cosf(rev), sn = __builtin_amdgcn_sinf(rev);
            v[2 * d] = (_Float16)(part ? -sn : c); v[2 * d + 1] = (_Float16)(part ? c : sn);
        }
        A[s] = v;
    }
}
__device__ __forceinline__ void flip_A(h8 (&A)[16], int lane) {
    unsigned m = ((lane >> 3) & 1) ? 0x00008000u : 0x80000000u; HM_KEEP1("", m);
#pragma unroll
    for (int s = 0; s < 16; ++s) { u4 v = __builtin_bit_cast(u4, A[s]); v.x ^= m; v.y ^= m; v.z ^= m; v.w ^= m; A[s] = __builtin_bit_cast(h8, v); }
}
#ifndef HM_HOST_EMU
__device__ __forceinline__ void mfma_pass(const HM_LAS unsigned* src, const h8 (&A)[16], f32x16 (&acc)[4], int lane) {
    const int l31 = lane & 31, h = lane >> 5;
    const HM_LAS unsigned* p = src + l31 * RS + 4 * h;
    constexpr int D = 6;
    h8 bq[D];
#pragma unroll
    for (int i = 0; i < D; ++i) bq[i] = *(const HM_LAS h8*)(p + (i >> 4) * 32 * RS + 8 * (i & 15));
    __builtin_amdgcn_sched_barrier(0);
#pragma unroll
    for (int cb = 0; cb < 4; ++cb) {
        f32x16 c;
#pragma unroll
        for (int i = 0; i < 16; ++i) c[i] = 0.0f;
#pragma unroll
        for (int s = 0; s < 16; ++s) {
            const int idx = cb * 16 + s;
            c = __builtin_amdgcn_mfma_f32_32x32x16_f16(A[s], bq[idx % D], c, 0, 0, 0);
            __builtin_amdgcn_sched_barrier(0);
            if (idx + D < 64) { bq[idx % D] = *(const HM_LAS h8*)(p + ((idx + D) >> 4) * 32 * RS + 8 * ((idx + D) & 15)); __builtin_amdgcn_sched_barrier(0); }
        }
        acc[cb] = c;
    }
    HM_KEEP2("s_nop 7", acc[3], bq[63 % D]);
}
#endif
__device__ __forceinline__ void twiddle_store(const f32x16 (&acc)[4], HM_LAS unsigned* dst, int wave, int lane, float sgn, float scale) {
    int l31 = lane & 31, h = lane >> 5; HM_KEEP2("", l31, h);
    const int rb = 16 * wave + 4 * h;
#pragma unroll
    for (int cb = 0; cb < 4; ++cb) {
        const int col = 32 * cb + l31;
        f2 t0 = cisr(sgn * (float)((col * rb) & 16383) * (1.0f / 16384.0f)); t0.x *= scale; t0.y *= scale;
        const f2 s1 = cisr(sgn * (float)col * (1.0f / 16384.0f)), s8 = cisr(sgn * (float)(8 * col) * (1.0f / 16384.0f));
        f2 t[2][4]; t[0][0] = t0; t[0][1] = cm(t0, s1); t[0][2] = cm(t[0][1], s1); t[0][3] = cm(t[0][2], s1);
#pragma unroll
        for (int b = 0; b < 4; ++b) t[1][b] = cm(t[0][b], s8);
#pragma unroll
        for (int a = 0; a < 2; ++a)
#pragma unroll
            for (int b = 0; b < 4; ++b) {
                const f2 v = cm((f2){acc[cb][b + 8 * a], acc[cb][b + 8 * a + 4]}, t[a][b]);
                dst[(rb + 8 * a + b) * RS + col] = pkh(v.x, v.y);
            }
    }
}
__device__ __forceinline__ void stage_filter(const Job& J, int c, int o, bool tw, int t, HM_LAS unsigned* img) {
    int n0 = t & 127, g = t >> 7; HM_KEEP2("", n0, g);
    const bf16_t* ktp = JP_KT(J);
    const bf16_t* kf = ktp + (size_t)(o * 512 + c) * SEQ + n0 * 128 + 32 * g;
    const bf16_t* kr = ktp + (size_t)(1024 + o * 512 + c) * SEQ + n0 * 128 + 32 * g;
    const float sgn = tw ? -64.0f : 64.0f, bias = JP_HBIAS(J)[o * 512 + c] * 64.0f;
    f2 curq = tw ? cisr(-(float)(n0 + 4096 * g) * (1.0f / 32768.0f)) : (f2){1.0f, 0.0f};
    const f2 se = tw ? (f2){0.99969881869620425f, -0.024541228522912288f} : (f2){1.0f, 0.0f};
    const f2 sq = tw ? (f2){0.99518472667219693f, -0.098017140329560604f} : (f2){1.0f, 0.0f};
    u4 fv[4], rv[4];
#pragma unroll
    for (int i = 0; i < 4; ++i) { fv[i] = *(const u4*)(kf + 8 * i); rv[i] = *(const u4*)(kr + 8 * i); }
#pragma unroll
    for (int q = 0; q < 8; ++q) {
        f2 cur = curq; u4 w;
#pragma unroll
        for (int e = 0; e < 4; ++e) {
            const int i = 4 * q + e;
            const unsigned fw = fv[i >> 3][(i >> 1) & 3], rw = rv[i >> 3][(i >> 1) & 3];
            const float kfv = (i & 1) ? asf(fw & 0xffff0000u) : asf(fw << 16), krv = (i & 1) ? asf(rw & 0xffff0000u) : asf(rw << 16);
            float a = 64.0f * kfv + sgn * krv;
            if (q == 0 && e == 0) a += (n0 == 0 && g == 0) ? bias : 0.0f;
            w[e] = pkh(cur.x * a, cur.y * a);
            cur = cm(cur, se);
        }
        *(HM_LAS u4*)(img + n0 * RS + 32 * g + 4 * q) = w;
        curq = cm(curq, sq);
    }
}
__device__ __forceinline__ void stage_data(const Job& J, int o, bool tw, int t, HM_LAS unsigned* img) {
    int n0 = t & 127, g = t >> 7; HM_KEEP2("", n0, g);
    f2 curq = tw ? cisr(-(float)(n0 + 4096 * g) * (1.0f / 32768.0f)) : (f2){1.0f, 0.0f};
    const f2 se = (f2){0.99969881869620425f, -0.024541228522912288f}, sq = (f2){0.99518472667219693f, -0.098017140329560604f};
    const int vo = (4096 * g + n0) * 8, vp = (4096 * g + n0) * 4;
#pragma unroll
    for (int hf = 0; hf < 2; ++hf) {
        f2 zz[16];
        if (o == 0) {
#pragma unroll
            for (int i = 0; i < 16; ++i) { const unsigned w = __builtin_amdgcn_raw_buffer_load_b32(J.pk, vp, SOFS(128 * (16 * hf + i) * 4), 0); zz[i] = (f2){asf(w << 16), asf(w & 0xffff0000u)}; }
        } else {
#pragma unroll
            for (int i = 0; i < 16; ++i) { const u2 raw = __builtin_amdgcn_raw_buffer_load_b64(J.st, vo, SOFS(131072 + 128 * (16 * hf + i) * 8), 16); zz[i] = __builtin_bit_cast(f2, raw); }
        }
#pragma unroll
        for (int q = 0; q < 4; ++q) {
            f2 cur = curq; u4 w;
#pragma unroll
            for (int e = 0; e < 4; ++e) {
                f2 z = zz[4 * q + e];
                if (tw) { z = cm(z, cur); cur = cm(cur, se); }
                w[e] = pkh(z.x, z.y);
            }
            *(HM_LAS u4*)(img + n0 * RS + 32 * g + 16 * hf + 4 * q) = w;
            if (tw) curq = cm(curq, sq);
        }
    }
}
__device__ __forceinline__ void pack_K(const f32x16 (&acc)[4], unsigned (&Kh)[32]) {
#pragma unroll
    for (int cb = 0; cb < 4; ++cb)
#pragma unroll
        for (int a = 0; a < 2; ++a)
#pragma unroll
            for (int b = 0; b < 4; ++b) Kh[cb * 8 + a * 4 + b] = pkh(acc[cb][b + 8 * a] * (1.0f / 64.0f), acc[cb][b + 8 * a + 4] * (1.0f / 64.0f));
}
__device__ __forceinline__ void mul_store(const f32x16 (&acc)[4], const unsigned (&Kh)[32], HM_LAS unsigned* dst, int wave, int lane) {
    const int l31 = lane & 31, h = lane >> 5, rb = 16 * wave + 4 * h;
#pragma unroll
    for (int cb = 0; cb < 4; ++cb)
#pragma unroll
        for (int a = 0; a < 2; ++a) {
            u4 w;
#pragma unroll
            for (int b = 0; b < 4; ++b) {
                const hh2v kk = __builtin_bit_cast(hh2v, Kh[cb * 8 + a * 4 + b]);
                const float ur = acc[cb][b + 8 * a] * (1.0f / 64.0f), ui = acc[cb][b + 8 * a + 4] * (1.0f / 64.0f), kr = (float)kk.x, ki = (float)kk.y;
                w[b] = pkh(ur * kr - ui * ki, ur * ki + ui * kr);
            }
            *(HM_LAS u4*)(dst + (32 * cb + l31) * RS + rb + 8 * a) = w;
        }
}
__device__ __forceinline__ float sconv_b(__amdgpu_buffer_rsrc_t r, int vo, int so, bool first, bool last, float w0, float w1, float w2, float cb) {
    const float vm = bf2f((bf16_t)__builtin_amdgcn_raw_buffer_load_b16(r, vo, so, 0)), vc = bf2f((bf16_t)__builtin_amdgcn_raw_buffer_load_b16(r, vo, so + 2, 0)),
                vp = bf2f((bf16_t)__builtin_amdgcn_raw_buffer_load_b16(r, vo, so + 4, 0));
    return cb + w0 * (first ? 0.0f : vm) + w1 * vc + w2 * (last ? 0.0f : vp);
}
__device__ __forceinline__ void final_epilogue(const Job& J, const f32x16 (&acc)[4], int c, int o, bool tw, int wave, int lane) {
    int l31 = lane & 31, h = lane >> 5; HM_KEEP2("", l31, h);
    const int rb = 16 * wave + 4 * h;
    const int vo = (128 * rb + l31) * 8;
    if (!tw) {
#pragma unroll
        for (int cb = 0; cb < 4; ++cb)
#pragma unroll
            for (int a = 0; a < 2; ++a)
#pragma unroll
                for (int b = 0; b < 4; ++b) {
                    u2 w; w.x = __builtin_bit_cast(unsigned, acc[cb][b + 8 * a] * 0.0625f); w.y = __builtin_bit_cast(unsigned, acc[cb][b + 8 * a + 4] * 0.0625f);
                    st_b64(w, J.st, vo, SOFS((32 * cb + 128 * (8 * a + b)) * 8));
                }
        return;
    }
    const __amdgpu_buffer_rsrc_t ry = __builtin_amdgcn_make_buffer_rsrc((void*)(J.yh + (size_t)c * NTOK), (short)0, NTOK * 2, 0x00020000);
    const int v2 = (128 * rb + l31) * 2, v4 = (128 * rb + l31) * 4;
    const int gofs = (o == 0 ? 65536 : 131072);
    const f2 sb = (f2){0.99969881869620425f, 0.024541228522912288f}, sa = (f2){0.98078528040323044913f, 0.19509032201612826785f};
#pragma unroll
    for (int cb = 0; cb < 4; ++cb) {
        f2 t0 = cisr((float)(128 * rb + 32 * cb + l31) * (1.0f / 32768.0f)); t0.x *= 0.0625f; t0.y *= 0.0625f;
        u2 rc[8]; unsigned gx[8];
#pragma unroll
        for (int i = 0; i < 8; ++i) { const int dn = 32 * cb + 128 * i + (i >= 4 ? 512 : 0);
            rc[i] = __builtin_amdgcn_raw_buffer_load_b64(J.st, vo, SOFS(dn * 8), 16); gx[i] = __builtin_amdgcn_raw_buffer_load_b32(J.pk, v4, SOFS(gofs + dn * 4), 0); }
#pragma unroll
        for (int a = 0; a < 2; ++a) {
            f2 cur = t0;
#pragma unroll
            for (int b = 0; b < 4; ++b) {
                const int dn = 32 * cb + 128 * (8 * a + b);
                const f2 r = cm((f2){acc[cb][b + 8 * a], acc[cb][b + 8 * a + 4]}, cur) + __builtin_bit_cast(f2, rc[4 * a + b]);
                cur = cm(cur, sb);
                const unsigned gw = gx[4 * a + b];
                const float a0 = asf(gw << 16) * r.x, a1 = asf(gw & 0xffff0000u) * r.y;
                if (o == 0) { u2 w; w.x = __builtin_bit_cast(unsigned, a0); w.y = __builtin_bit_cast(unsigned, a1); st_b64(w, J.st, vo, SOFS(131072 + dn * 8)); }
                else { st_b16((short)f2bf(a0), ry, v2, SOFS(dn * 2)); st_b16((short)f2bf(a1), ry, v2, SOFS((SEQ + dn) * 2)); }
            }
            t0 = cm(t0, sa);
        }
    }
}
__device__ __forceinline__ void load8(const bf16_t* p, int n0, float (&x)[10]) {
    const u4 v = *(const u4*)(p + n0);
    x[1] = asf(v.x << 16); x[2] = asf(v.x & 0xffff0000u); x[3] = asf(v.y << 16); x[4] = asf(v.y & 0xffff0000u); x[5] = asf(v.z << 16); x[6] = asf(v.z & 0xffff0000u); x[7] = asf(v.w << 16); x[8] = asf(v.w & 0xffff0000u);
    const float m = bf2f(p[n0 > 0 ? n0 - 1 : 0]), q = bf2f(p[n0 + 8 < SEQ ? n0 + 8 : SEQ - 1]);
    x[0] = n0 > 0 ? m : 0.0f; x[9] = n0 + 8 < SEQ ? q : 0.0f;
}
__device__ __forceinline__ void prep(const Job& J, int c, int t) {
    const float* cw = JP_CONVW(J); const float* cbp = JP_CONVB(J); const bf16_t* chp = JP_CH(J);
#pragma unroll 1
    for (int it = 0; it < 4; ++it) {
        const int n0 = 8 * (t + 512 * it);
        float o0[3][8], o1[3][8];
#pragma unroll
        for (int s = 0; s < 3; ++s) {
            const int row = s * 512 + c; const bf16_t* p = chp + (size_t)row * NTOK;
            const float w0 = cw[row], w1 = cw[1536 + row], w2 = cw[3072 + row], cbv = cbp[row];
            float x[10];
            load8(p, n0, x);
#pragma unroll
            for (int e = 0; e < 8; ++e) o0[s][e] = cbv + w0 * x[e] + w1 * x[e + 1] + w2 * x[e + 2];
            load8(p + SEQ, n0, x);
#pragma unroll
            for (int e = 0; e < 8; ++e) o1[s][e] = cbv + w0 * x[e] + w1 * x[e + 1] + w2 * x[e + 2];
        }
        { const bf16_t* g = chp + (size_t)(1536 + c) * NTOK; const u4 g0 = *(const u4*)(g + n0), g1 = *(const u4*)(g + SEQ + n0);
#pragma unroll
          for (int e = 0; e < 8; ++e) { const unsigned a = e < 2 ? g0.x : e < 4 ? g0.y : e < 6 ? g0.z : g0.w, b = e < 2 ? g1.x : e < 4 ? g1.y : e < 6 ? g1.z : g1.w;
              const float q0 = (e & 1) ? asf(a & 0xffff0000u) : asf(a << 16), q1 = (e & 1) ? asf(b & 0xffff0000u) : asf(b << 16);
              o0[2][e] *= q0 / (1.0f + __expf(-q0)); o1[2][e] *= q1 / (1.0f + __expf(-q1)); } }
#pragma unroll
        for (int s = 0; s < 3; ++s)
#pragma unroll
            for (int hh = 0; hh < 2; ++hh) { u4 w;
#pragma unroll
                for (int e = 0; e < 4; ++e) w[e] = (unsigned)f2bf(o0[s][4 * hh + e]) | ((unsigned)f2bf(o1[s][4 * hh + e]) << 16);
                st_b128(w, J.pk, n0 * 4 + hh * 16, SOFS(s * 65536)); }
    }
}
}
#define LAS __attribute__((address_space(3)))
#define GAS __attribute__((address_space(1)))
typedef unsigned short bf16;
typedef unsigned u32x4v __attribute__((ext_vector_type(4)));
typedef float f32x4v __attribute__((ext_vector_type(4)));

#ifndef MK_N_LAUNCHES
#define MK_N_LAUNCHES 1
#endif
constexpr int N_PHASES = 7;
constexpr int NT = 512;
constexpr int DM = 1024, SEQ = 16384, NB = 2, NTOK = NB * SEQ, DINP = 3072, DH = 512;
constexpr float LN_EPS = 1e-5f, DN_ALPHA = 1.18920711500272106672f;
constexpr size_t MiB = 1u << 20;
constexpr size_t WS_CTL = 0, CTL_BYTES = 1 * MiB;
constexpr size_t WS_MOD = WS_CTL + CTL_BYTES;
constexpr size_t WS_WINT = WS_MOD + 1 * MiB;
constexpr size_t WS_WOUTT = WS_WINT + 6 * MiB;
constexpr size_t WS_PWT = WS_WOUTT + 2 * MiB;
constexpr size_t WS_FWT = WS_PWT + 1 * MiB;
constexpr size_t WS_H3 = WS_FWT + 1 * MiB;
constexpr size_t WS_U = WS_H3 + 8 * MiB;
constexpr size_t WS_KT = WS_U + 64 * MiB;
constexpr size_t WS_CH = WS_KT + 64 * MiB;
constexpr size_t WS_TP = WS_CH + 128 * MiB;
constexpr size_t WS_PP = WS_TP + 64 * MiB;
constexpr size_t WS_YH = WS_PP + 32 * MiB;
constexpr size_t WS_ST = WS_YH + 32 * MiB;
constexpr size_t WS_END = WS_ST + 96 * MiB;
constexpr size_t WS_Y = WS_U;
constexpr int LDS_MISC = 143360;
constexpr int LDS_BYTES = LDS_MISC + 256;

#define XB_TMO      128
#define XB_XCNT(j)  (256  + 64 * (j))
#define XB_XSUB(j)  (1280 + 64 * (j))
#define XB_XGEN(j)  (2304 + 64 * (j))
#define XB_TOP      3328
#define XB_TOPGEN   3392
#define XCD_BAR_WORDS 3456
#define XB_SPIN_CAP (1u << 18)
__device__ __forceinline__ unsigned xb_ld(unsigned* p)              { return __hip_atomic_load(p, __ATOMIC_RELAXED, __HIP_MEMORY_SCOPE_AGENT); }
__device__ __forceinline__ unsigned xb_add(unsigned* p, unsigned v) { return __hip_atomic_fetch_add(p, v, __ATOMIC_RELAXED, __HIP_MEMORY_SCOPE_AGENT); }
__device__ __forceinline__ unsigned xb_xcc_id() { return (unsigned)__builtin_amdgcn_s_getreg((3 << 11) | 20) & 0xFu; }
#define XB_SPIN(cond, bar) do { unsigned _sp = 0; while (cond) { __builtin_amdgcn_s_sleep(1); \
    if ((++_sp & 255u) == 0u) { if (xb_ld(&(bar)[XB_TMO])) break; if (_sp > XB_SPIN_CAP) { atomicAdd(&(bar)[XB_TMO], 1u); break; } } } } while (0)
struct XcdBarrier { unsigned* bar; unsigned x; volatile LAS unsigned* st; };
__device__ __forceinline__ XcdBarrier xcd_barrier_post(unsigned* bar, volatile LAS unsigned* st) {
    XcdBarrier b; b.bar = bar; b.x = xb_xcc_id(); b.st = st;
    if (threadIdx.x == 0) (void)xb_add(&bar[XB_XCNT(b.x)], 1u);
    return b;
}
__device__ __forceinline__ void xcd_barrier_complete(unsigned* bar, unsigned x, unsigned& nloc, unsigned& nx) {
    const unsigned G = gridDim.x * gridDim.y * gridDim.z;
    unsigned sum, cnt, mine, sp = 0u;
    for (;;) {
        sum = 0u; cnt = 0u; mine = 0u;
#pragma unroll
        for (unsigned j = 0; j < 16; ++j) { const unsigned c = xb_ld(&bar[XB_XCNT(j)]); sum += c; cnt += (c > 0u) ? 1u : 0u; mine = (j == x) ? c : mine; }
        if (sum == G) break;
        __builtin_amdgcn_s_sleep(1);
        if ((++sp & 255u) == 0u) { if (xb_ld(&bar[XB_TMO])) break; if (sp > XB_SPIN_CAP) { atomicAdd(&bar[XB_TMO], 1u); break; } }
    }
    nloc = mine > 0u ? mine : 1u; nx = cnt > 0u ? cnt : 1u;
}
__device__ __forceinline__ void xcd_barrier(const XcdBarrier& b) {
    asm volatile("s_waitcnt vmcnt(0)" ::: "memory");
    __syncthreads();
    if (threadIdx.x == 0) {
        unsigned* bar = b.bar;
        __builtin_amdgcn_s_waitcnt(0);
        unsigned nloc = b.st[0], nx = b.st[1];
        if (nloc == 0u) { xcd_barrier_complete(bar, b.x, nloc, nx); b.st[0] = nloc; b.st[1] = nx; }
        const unsigned old = xb_add(&bar[XB_XSUB(b.x)], 1u);
        const unsigned gen = old / nloc;
        if (old + 1u == (gen + 1u) * nloc) {
            __builtin_amdgcn_fence(__ATOMIC_RELEASE, "agent");
            asm volatile("s_waitcnt vmcnt(0)" ::: "memory");
            const unsigned og = xb_add(&bar[XB_TOP], 1u);
            const unsigned tg = og / nx;
            if (og + 1u == (tg + 1u) * nx) xb_add(&bar[XB_TOPGEN], 1u);
            else XB_SPIN(xb_ld(&bar[XB_TOPGEN]) == tg, bar);
            __builtin_amdgcn_fence(__ATOMIC_ACQUIRE, "agent");
            xb_add(&bar[XB_XGEN(b.x)], 1u);
            asm volatile("s_waitcnt vmcnt(0)" ::: "memory");
        } else {
            XB_SPIN(xb_ld(&bar[XB_XGEN(b.x)]) == gen, bar);
            __builtin_amdgcn_fence(__ATOMIC_ACQUIRE, "agent");
            asm volatile("s_waitcnt vmcnt(0)" ::: "memory");
        }
    }
    __syncthreads();
}

__device__ __forceinline__ unsigned f2bf_u(float f) { unsigned u = __builtin_bit_cast(unsigned, f); return (u + 0x7fffu + ((u >> 16) & 1u)) >> 16; }
__device__ __forceinline__ unsigned pk2(float lo, float hi) { return f2bf_u(lo) | (f2bf_u(hi) << 16); }
__device__ __forceinline__ float bflo(unsigned w) { return __builtin_bit_cast(float, w << 16); }
__device__ __forceinline__ float bfhi(unsigned w) { return __builtin_bit_cast(float, w & 0xffff0000u); }
__device__ __forceinline__ float silu_f(float v) { return v / (1.0f + __expf(-v)); }

struct Args { const float* in[21]; float* out; unsigned char* ws; int ph_lo, ph_hi; };
enum { I_X = 0, I_C, I_WADA, I_BADA, I_WIN, I_BIN, I_CONVW, I_CONVB, I_FW1, I_FB1, I_FWI, I_FBI, I_FWO, I_FFREQ, I_HBIAS, I_POOLW, I_POOLS, I_WOUT, I_BOUT, I_LNG, I_LNB };
typedef const __attribute__((address_space(4))) Args* ArgsP;
struct Frame { LAS unsigned char* lds; int wave, G, blk; ArgsP ap; };
__device__ __forceinline__ int f_lane() { int l = (int)__builtin_amdgcn_mbcnt_hi(~0u, __builtin_amdgcn_mbcnt_lo(~0u, 0u)); asm volatile("" : "+v"(l)); return l; }
#define FLANE(F) f_lane()
#define FTID(F) ((F).wave * 64 + f_lane())
#define AP_FRESH(F) ArgsP ap = (F).ap; asm volatile("" : "+s"(ap))
template <class T> __device__ __forceinline__ T* wsp(ArgsP ap, size_t off) { return (T*)(ap->ws + off); }

__device__ void tile_transpose(const Frame& F, const float* src, int lds_, int k0s, int n0s, bf16* dst, int ldd, int n0d, int k0d, const float* colscale) {
    LAS float* tile = (LAS float*)F.lds;
    const int t = FTID(F);
    if (src) {
        const int i = t >> 3, jq = (t & 7) * 8;
        const f32x4v a = *(const f32x4v*)(src + (size_t)(k0s + i) * lds_ + n0s + jq), b = *(const f32x4v*)(src + (size_t)(k0s + i) * lds_ + n0s + jq + 4);
#pragma unroll
        for (int e = 0; e < 4; ++e) { tile[i * 65 + jq + e] = a[e]; tile[i * 65 + jq + 4 + e] = b[e]; }
    }
    __syncthreads();
    {
        const int j = t >> 3, iq = (t & 7) * 8;
        float v[8];
#pragma unroll
        for (int e = 0; e < 8; ++e) v[e] = src ? tile[(iq + e) * 65 + j] : 0.0f;
        if (src && colscale) { const float s = colscale[n0s + j];
#pragma unroll
            for (int e = 0; e < 8; ++e) v[e] *= s; }
        u32x4v w; w.x = pk2(v[0], v[1]); w.y = pk2(v[2], v[3]); w.z = pk2(v[4], v[5]); w.w = pk2(v[6], v[7]);
        *(u32x4v*)(dst + (size_t)(n0d + j) * ldd + k0d + iq) = w;
    }
    __syncthreads();
}
__device__ void p0_prologue(const Frame& F) {
    const int t = FTID(F), blk = F.blk, G = F.G;
    AP_FRESH(F);
    const float *c_in = ap->in[I_C], *w_ada = ap->in[I_WADA], *b_ada = ap->in[I_BADA]; float* mod = wsp<float>(ap, WS_MOD);
    for (int job = blk; job < 256; job += G) {
        const int j0 = job * 12;
        LAS float* red = (LAS float*)F.lds;
        if (t < 510) {
            const int r = t / 3, q = t % 3;
            f32x4v a0 = {0.f, 0.f, 0.f, 0.f}, a1 = {0.f, 0.f, 0.f, 0.f};
            for (int i = r; i < DM; i += 170) {
                const f32x4v w = *(const f32x4v*)(w_ada + (size_t)i * 3072 + j0 + 4 * q);
                const float s0 = silu_f(c_in[i]), s1 = silu_f(c_in[DM + i]);
                a0 += w * s0; a1 += w * s1;
            }
#pragma unroll
            for (int e = 0; e < 4; ++e) { red[(r * 3 + q) * 8 + e] = a0[e]; red[(r * 3 + q) * 8 + 4 + e] = a1[e]; }
        }
        __syncthreads();
        if (t < 24) {
            const int b = t / 12, jj = t % 12, q = jj >> 2, e = jj & 3;
            float s = 0.f;
            for (int r = 0; r < 170; ++r) s += red[(r * 3 + q) * 8 + b * 4 + e];
            mod[b * 3072 + j0 + jj] = s + b_ada[j0 + jj];
        }
        __syncthreads();
    }
    const float *w_in = ap->in[I_WIN], *w_out = ap->in[I_WOUT], *f_wo = ap->in[I_FWO], *pool_w = ap->in[I_POOLW], *pool_scale = ap->in[I_POOLS];
    bf16 *WinT = wsp<bf16>(ap, WS_WINT), *WoutT = wsp<bf16>(ap, WS_WOUTT), *FWT = wsp<bf16>(ap, WS_FWT), *PWT = wsp<bf16>(ap, WS_PWT);
    constexpr int J_WIN = 16 * 48, J_WOUT = 16 * 16, J_FW = 32 * 4, J_PW = 64, J_ALL = J_WIN + J_WOUT + J_FW + J_PW;
    for (int job = blk; job < J_ALL; job += G) {
        int j = job;
        if (j < J_WIN) { const int kt = j / 48, nt = j % 48; tile_transpose(F, w_in, 3072, kt * 64, nt * 64, WinT, 1024, nt * 64, kt * 64, nullptr); continue; }
        j -= J_WIN;
        if (j < J_WOUT) { const int kt = j / 16, nt = j % 16; tile_transpose(F, w_out, 1024, kt * 64, nt * 64, WoutT, 1024, nt * 64, kt * 64, nullptr); continue; }
        j -= J_WOUT;
        if (j < J_FW) { const int nt = j / 4, kt = j % 4, o_ = nt >> 4, d_ = (nt >> 3) & 1, ct = nt & 7, dt = d_ * 16 + o_ * 8 + ct;
            tile_transpose(F, kt == 0 ? f_wo : nullptr, 2048, 0, nt * 64, FWT, 256, dt * 64, kt * 64, nullptr); continue; }
        j -= J_FW;
        { const int nt = j / 8, kt = j % 8, g = nt / 2;
          const bool diag = (kt / 2) == g;
          tile_transpose(F, diag ? pool_w + (size_t)g * 128 * 128 : nullptr, 128, (kt & 1) * 64, (nt & 1) * 64, PWT, 512, nt * 64, kt * 64, pool_scale + g * 128);
        }
    }
    {
        const int lane = FLANE(F), gw = blk * 8 + F.wave, nw = G * 8;
        const float *f_w1 = ap->in[I_FW1], *f_wi = ap->in[I_FWI], *f_bi = ap->in[I_FBI]; bf16* H3 = wsp<bf16>(ap, WS_H3); bf16* H3b = (bf16*)((unsigned char*)ap->out + 64 * MiB);
        const float freq = ap->in[I_FFREQ][lane], b1 = ap->in[I_FB1][lane], bi0 = f_bi[lane], bi1 = f_bi[64 + lane];
        for (int grp = gw; grp < SEQ / 8; grp += nw) {
            const int l0 = grp * 8;
            float feat[8];
#pragma unroll
            for (int p = 0; p < 8; ++p) {
                const int l = l0 + p; float f = 0.f;
                if (lane == 0) f = (float)l * (1.0f / (float)(SEQ - 1));
                else if (lane < 33) { const int bi = (lane - 1) & 15; const float fr = 1e-4f + (float)bi * ((15.0f - 1e-4f) / 15.0f);
                    const float w = (6.283185307179586f / (float)SEQ) * (float)l; const float arg = fr * w; f = lane < 17 ? cosf(arg) : -sinf(arg); }
                feat[p] = f;
            }
            float acc[8];
#pragma unroll
            for (int p = 0; p < 8; ++p) acc[p] = b1;
            for (int i = 0; i < 33; ++i) { const float w = f_w1[i * 64 + lane];
#pragma unroll
                for (int p = 0; p < 8; ++p) acc[p] += __shfl(feat[p], i) * w; }
            float h[8];
#pragma unroll
            for (int p = 0; p < 8; ++p) h[p] = sinf(freq * acc[p]);
#pragma unroll
            for (int layer = 0; layer < 2; ++layer) {
                const float* W = f_wi + layer * 4096; const float bb = layer ? bi1 : bi0;
#pragma unroll
                for (int p = 0; p < 8; ++p) acc[p] = bb;
                for (int i = 0; i < 64; ++i) { const float w = W[i * 64 + lane];
#pragma unroll
                    for (int p = 0; p < 8; ++p) acc[p] += __shfl(h[p], i) * w; }
#pragma unroll
                for (int p = 0; p < 8; ++p) h[p] = sinf(freq * acc[p]);
            }
#pragma unroll
            for (int p = 0; p < 8; ++p) { const int l = l0 + p, lr = SEQ - 1 - l;
                bf16* row = H3 + (size_t)((l & 127) * 128 + (l >> 7)) * 256; row[lane] = (bf16)f2bf_u(h[p]); row[64 + lane] = 0; row[128 + lane] = 0; row[192 + lane] = 0;
                bf16* rowb = H3b + (size_t)((lr & 127) * 128 + (lr >> 7)) * 256; rowb[lane] = (bf16)f2bf_u(h[p]); rowb[64 + lane] = 0; rowb[128 + lane] = 0; rowb[192 + lane] = 0; }
        }
    }
}

namespace pg8 {
struct EpiRowBias {
    static constexpr bool PERM = true, AFTER_DRAIN = false;
    bf16_t* O; int ldc; const float* rbias;
    __device__ __forceinline__ void operator()(const f32x4 (&acc)[2][2][4][2], const Unit& u, int wr, int wc, int fr, int fq) const {
        const int row0 = u.pm * BM + wr * 64 + fr, col0 = u.pn * BM + wc * 32 + 8 * fq;
#pragma unroll
        for (int ai = 0; ai < 2; ++ai)
#pragma unroll
            for (int m = 0; m < 4; ++m) { const int row = row0 + ai * HALF + m * 16; const float b = rbias[row]; bf16_t* rowp = O + (size_t)row * ldc + col0;
#pragma unroll
                for (int bj = 0; bj < 2; ++bj) { const f32x4 v0 = acc[ai][bj][m][0] + b, v1 = acc[ai][bj][m][1] + b;
                    u32x4 w; w.x = cvt_pk_bf16(v0[0], v0[1]); w.y = cvt_pk_bf16(v0[2], v0[3]); w.z = cvt_pk_bf16(v1[0], v1[1]); w.w = cvt_pk_bf16(v1[2], v1[3]);
                    *(u32x4*)(rowp + bj * HALF) = w; } }
    }
};
template <int rev> struct EpiDecay {
    static constexpr bool PERM = true, AFTER_DRAIN = false;
    bf16_t* O; int ldc;
    __device__ __forceinline__ void operator()(const f32x4 (&acc)[2][2][4][2], const Unit& u, int wr, int wc, int fr, int fq) const {
        const int row0 = u.pm * BM + wr * 64 + fr, col0 = u.pn * BM + wc * 32 + 8 * fq;
        const float dmin = -3.0701134573253944f, dmax = -15.350567286626972f;
#pragma unroll
        for (int ai = 0; ai < 2; ++ai)
#pragma unroll
            for (int m = 0; m < 4; ++m) { const int row = row0 + ai * HALF + m * 16, c = row & 511;
                const float dl2 = (dmin + (dmax - dmin) * ((float)c * (1.0f / 511.0f))) * 1.4426950408889634f * (1.0f / 16383.0f);
                bf16_t* rowp = O + (size_t)row * ldc + col0;
                const int nb = (col0 & 127) * 128 + (col0 >> 7);
                const float sg = rev ? -dl2 : dl2;
                const float e0 = __builtin_amdgcn_exp2f(dl2 * (float)(rev ? 16383 - nb : nb)), st = __builtin_amdgcn_exp2f(sg * 128.0f), sj = __builtin_amdgcn_exp2f(sg);
#pragma unroll
                for (int bj = 0; bj < 2; ++bj) { float v[8]; float cur = bj ? e0 * sj : e0;
#pragma unroll
                    for (int e = 0; e < 8; ++e) { v[e] = acc[ai][bj][m][e >> 2][e & 3] * cur; cur *= st; }
                    u32x4 w; w.x = cvt_pk_bf16(v[0], v[1]); w.y = cvt_pk_bf16(v[2], v[3]); w.z = cvt_pk_bf16(v[4], v[5]); w.w = cvt_pk_bf16(v[6], v[7]);
                    *(u32x4*)(rowp + bj * HALF) = w; }
                asm volatile("" ::: "memory"); }
    }
};
struct EpiPoolGate {
    static constexpr bool PERM = true, AFTER_DRAIN = false;
    bf16_t* Y; const bf16_t* TP;
    __device__ __forceinline__ void operator()(const f32x4 (&acc)[2][2][4][2], const Unit& u, int wr, int wc, int fr, int fq) const {
        const int row0 = u.pm * BM + wr * 64 + fr, col0 = u.pn * BM + wc * 32 + 8 * fq;
#pragma unroll
        for (int ai = 0; ai < 2; ++ai)
#pragma unroll
            for (int m = 0; m < 4; ++m) { const int row = row0 + ai * HALF + m * 16;
#pragma unroll
                for (int bj = 0; bj < 2; ++bj) { const size_t off = (size_t)row * 1024 + 512 + col0 + bj * HALF;
                    const u32x4 g = *(const u32x4*)(TP + off); float v[8];
#pragma unroll
                    for (int e = 0; e < 8; ++e) { const unsigned gw = e < 2 ? g.x : e < 4 ? g.y : e < 6 ? g.z : g.w; const float q = (e & 1) ? __builtin_bit_cast(float, gw & 0xffff0000u) : __builtin_bit_cast(float, gw << 16);
                        v[e] = acc[ai][bj][m][e >> 2][e & 3] * (q / (1.0f + __expf(-q))); }
                    u32x4 w; w.x = cvt_pk_bf16(v[0], v[1]); w.y = cvt_pk_bf16(v[2], v[3]); w.z = cvt_pk_bf16(v[4], v[5]); w.w = cvt_pk_bf16(v[6], v[7]);
                    *(u32x4*)(Y + off) = w; } }
    }
};
struct EpiResGate {
    static constexpr bool PERM = false, AFTER_DRAIN = false;
    float* C; const float* X; const float* mod; const float* bout; float alpha;
    __device__ __forceinline__ void operator()(const f32x4 (&acc)[2][2][4][2], const Unit& u, int wr, int wc, int fr, int fq) const {
        const int row0 = u.pm * BM + wr * 64 + fr, col0 = u.pn * BM + wc * 32 + 4 * fq;
        const float* gate = mod + ((u.pm * BM) >= 16384 ? 3072 : 0) + 2048;
        f32x4 bv[2][2], gv[2][2];
#pragma unroll
        for (int bj = 0; bj < 2; ++bj)
#pragma unroll
            for (int n = 0; n < 2; ++n) { bv[bj][n] = *(const f32x4*)(bout + col0 + bj * HALF + n * 16); gv[bj][n] = *(const f32x4*)(gate + col0 + bj * HALF + n * 16); }
#pragma unroll
        for (int ai = 0; ai < 2; ++ai)
#pragma unroll
            for (int m = 0; m < 4; ++m) { const size_t off = (size_t)(row0 + ai * HALF + m * 16) * 1024 + col0;
#pragma unroll
                for (int bj = 0; bj < 2; ++bj)
#pragma unroll
                    for (int n = 0; n < 2; ++n) { const f32x4 xv = *(const f32x4*)(X + off + bj * HALF + n * 16);
                        *(f32x4*)(C + off + bj * HALF + n * 16) = xv * alpha + gv[bj][n] * (acc[ai][bj][m][n] + bv[bj][n]); } }
    }
};
}

__device__ void p1_modulate(const Frame& F) {
    AP_FRESH(F);
    const float* x = ap->in[I_X]; const float* mod = wsp<float>(ap, WS_MOD); bf16* U = wsp<bf16>(ap, WS_U);
    const size_t n8 = (size_t)NTOK * DM / 8, stride = (size_t)F.G * NT;
    for (size_t i = (size_t)F.blk * NT + FTID(F); i < n8; i += stride) {
        const size_t e0 = i * 8; const int col = (int)(e0 & (DM - 1)); const int b = (int)(e0 >= (size_t)SEQ * DM);
        const float* md = mod + b * 3072;
        const f32x4v x0 = *(const f32x4v*)(x + e0), x1 = *(const f32x4v*)(x + e0 + 4);
        const f32x4v sh0 = *(const f32x4v*)(md + col), sh1 = *(const f32x4v*)(md + col + 4), sc0 = *(const f32x4v*)(md + 1024 + col), sc1 = *(const f32x4v*)(md + 1024 + col + 4);
        const f32x4v u0 = x0 * (sc0 + 1.0f) + sh0, u1 = x1 * (sc1 + 1.0f) + sh1;
        u32x4v w; w.x = pk2(u0[0], u0[1]); w.y = pk2(u0[2], u0[3]); w.z = pk2(u1[0], u1[1]); w.w = pk2(u1[2], u1[3]);
        *(u32x4v*)(U + e0) = w;
    }
}

__device__ void p3_pool(const Frame& F) {
    AP_FRESH(F);
    const bf16* TP = wsp<bf16>(ap, WS_TP); bf16* PP = wsp<bf16>(ap, WS_PP);
    for (int i = F.blk * NT + FTID(F); i < 2048 * 64; i += F.G * NT) {
        const int c8 = (i & 63) * 8, run = i >> 6, g = c8 >> 7, hw = 1 << g;
        const int tok0 = run * 16, b = tok0 >> 14, pos0 = tok0 & (SEQ - 1);
        const bf16* base = TP + (size_t)b * SEQ * 1024 + c8;
        float s[8] = {0.f, 0.f, 0.f, 0.f, 0.f, 0.f, 0.f, 0.f};
        { const int lo = pos0 - hw < 0 ? 0 : pos0 - hw, hi = pos0 + hw > SEQ ? SEQ : pos0 + hw;
          for (int q = lo; q < hi; ++q) { const u32x4v v = *(const u32x4v*)(base + (size_t)q * 1024);
              s[0] += bflo(v.x); s[1] += bfhi(v.x); s[2] += bflo(v.y); s[3] += bfhi(v.y); s[4] += bflo(v.z); s[5] += bfhi(v.z); s[6] += bflo(v.w); s[7] += bfhi(v.w); } }
#pragma unroll 4
        for (int k = 0; k < 16; ++k) {
            const int pos = pos0 + k;
            const int lo = pos - hw < 0 ? 0 : pos - hw, hi = pos + hw > SEQ ? SEQ : pos + hw;
            const u32x4v own = *(const u32x4v*)(base + (size_t)pos * 1024);
            const float inv = 1.0f / (float)(hi - lo);
            u32x4v w; w.x = pk2(s[0] * inv - bflo(own.x), s[1] * inv - bfhi(own.x)); w.y = pk2(s[2] * inv - bflo(own.y), s[3] * inv - bfhi(own.y));
            w.z = pk2(s[4] * inv - bflo(own.z), s[5] * inv - bfhi(own.z)); w.w = pk2(s[6] * inv - bflo(own.w), s[7] * inv - bfhi(own.w));
            *(u32x4v*)(PP + (size_t)(tok0 + k) * 512 + c8) = w;
            if (pos + hw < SEQ) { const u32x4v v = *(const u32x4v*)(base + (size_t)(pos + hw) * 1024);
                s[0] += bflo(v.x); s[1] += bfhi(v.x); s[2] += bflo(v.y); s[3] += bfhi(v.y); s[4] += bflo(v.z); s[5] += bfhi(v.z); s[6] += bflo(v.w); s[7] += bfhi(v.w); }
            if (pos - hw >= 0) { const u32x4v v = *(const u32x4v*)(base + (size_t)(pos - hw) * 1024);
                s[0] -= bflo(v.x); s[1] -= bfhi(v.x); s[2] -= bflo(v.y); s[3] -= bfhi(v.y); s[4] -= bflo(v.z); s[5] -= bfhi(v.z); s[6] -= bflo(v.w); s[7] -= bfhi(v.w); }
        }
    }
}

__device__ void p3_hyena_old(const Frame& F, bf16* yh_dst) {
    LAS f2* L = (LAS f2*)F.lds;
    const int t = FTID(F);
    AP_FRESH(F);
    hy::JobArgs J;
    J.ch = wsp<bf16>(ap, WS_CH); J.kt = wsp<bf16>(ap, WS_KT); J.conv_w = ap->in[I_CONVW]; J.conv_b = ap->in[I_CONVB]; J.hbias = ap->in[I_HBIAS];
    J.sbase = (f2*)(ap->ws + WS_ST + (size_t)F.blk * 393216); J.yh = yh_dst;
    const hy::Stash S = hy::make_stash(J);
    for (int c = F.blk; c < DH; c += F.G) {
        hy::seg_prep(J, S, c, t);
        for (int oh = 0; oh < 4; ++oh) {
            const int o = oh >> 1; const bool tw = oh & 1;
            hy::seg_filter_p1(J, c, o, tw, t, L); __syncthreads();
            hy::fwd_p2(t, L); __syncthreads();
            hy::seg_filter_p3(S, t, L); __syncthreads();
            hy::seg_data_p1(S, tw, t, L); __syncthreads();
            hy::fwd_p2(t, L); __syncthreads();
            hy::seg_mul(S, t, L); __syncthreads();
            hy::inv_p2(t, L); __syncthreads();
            hy::seg_out(J, S, c, o, tw, t, L); __syncthreads();
        }
    }
}
#define HM_FULLSYNC0() do { asm volatile("s_waitcnt vmcnt(0) lgkmcnt(0)" ::: "memory"); __syncthreads(); } while (0)
__device__ void p3_hyena(const Frame& F, bf16* yh_dst) {
    LAS unsigned* IMG0 = (LAS unsigned*)F.lds; LAS unsigned* IMG1 = IMG0 + hm::IMG_DW;
    const int t = FTID(F), lane = FLANE(F), wave = F.wave;
    AP_FRESH(F);
    hm::Job J;
    static_assert(WS_CH == ((size_t)148 << 20) && WS_KT == ((size_t)84 << 20), "hm.h hard-codes these workspace offsets");
    J.ka = (hm::hm_ka_t)F.ap; J.yh = yh_dst ? yh_dst : wsp<bf16>(ap, WS_YH);
    J.st = __builtin_amdgcn_make_buffer_rsrc(ap->ws + WS_ST + (size_t)F.blk * 393216, (short)0, 393216, 0x00020000);
#if defined(HM_IDFILT) || defined(HM_STAGETEST) || defined(HM_KTEST)
    J.dbg = (unsigned*)(ap->ws + WS_CTL + 65536 + 512);
#endif
    J.pk = __builtin_amdgcn_make_buffer_rsrc((unsigned char*)ap->out + (size_t)F.blk * 196608, (short)0, 196608, 0x00020000);
#ifdef HM_POISON
    for (int i = t; i < 2 * hm::IMG_DW; i += NT) IMG0[i] = 0x7e007e00u;
    for (int i = t; i < 393216 / 4; i += NT) __builtin_amdgcn_raw_buffer_store_b32(0x7fc00000u, J.st, i * 4, 0, 0);
    asm volatile("s_waitcnt vmcnt(0) lgkmcnt(0)" ::: "memory"); __syncthreads();
#endif
    hm::h8 A[16];
    hm::build_A(A, wave, lane);
    hm::f32x16 acc[4]; unsigned Kh[32];
#ifdef HM_FFTTEST
    if (F.blk == 0) {
        unsigned* cnt = (unsigned*)(ap->ws + WS_CTL + 65536 + 512);
        for (int i = t; i < hm::IMG_DW; i += NT) IMG0[i] = 0u;
        __syncthreads();
        if (t == 0) IMG0[3 * hm::RS + 5] = hm::pkh(1.0f, 0.5f);
        HM_FULLSYNC0();
        hm::mfma_pass(IMG0, A, acc, lane); HM_FULLSYNC0(); hm::twiddle_store(acc, IMG1, wave, lane, -1.0f, 0.125f); HM_FULLSYNC0();
        hm::mfma_pass(IMG1, A, acc, lane); HM_FULLSYNC0();
        {
            const int l31 = lane & 31, hh = lane >> 5, rb = 16 * wave + 4 * hh;
            for (int cb = 0; cb < 4; ++cb) for (int a = 0; a < 2; ++a) { hm::u4 w;
                for (int b = 0; b < 4; ++b) { float gr = 0.f, gi = 0.f; for (int q = 0; q < 16; ++q) { if (q == b + 8 * a) gr = acc[cb][q]; if (q == b + 8 * a + 4) gi = acc[cb][q]; } w[b] = hm::pkh(gr, gi); }
                *(LAS hm::u4*)(IMG0 + (32 * cb + l31) * hm::RS + rb + 8 * a) = w; }
        }
        HM_FULLSYNC0();
        hm::flip_A(A, lane);
        hm::mfma_pass(IMG0, A, acc, lane); HM_FULLSYNC0(); hm::twiddle_store(acc, IMG1, wave, lane, 1.0f, 0.25f); HM_FULLSYNC0();
        hm::mfma_pass(IMG1, A, acc, lane); HM_FULLSYNC0();
        hm::flip_A(A, lane);
        int bad = 0; const int nstar = 128 * 5 + 3;
        for (int cb = 0; cb < 4; ++cb) for (int a = 0; a < 2; ++a) for (int b = 0; b < 4; ++b) {
            const int n1 = 16 * wave + 4 * (lane >> 5) + 8 * a + b, n0 = 32 * cb + (lane & 31), n = 128 * n1 + n0;
            const float er = (n == nstar) ? 512.0f : 0.0f, ei = (n == nstar) ? 256.0f : 0.0f;
            float gr = 0.f, gi = 0.f;
            for (int q = 0; q < 16; ++q) { if (q == b + 8 * a) gr = acc[cb][q]; if (q == b + 8 * a + 4) gi = acc[cb][q]; }
            if (fabsf(gr - er) > 3.0f || fabsf(gi - ei) > 3.0f) bad++; }
        if (bad) atomicAdd(cnt, (unsigned)bad);
        __syncthreads();
    }
    return;
#endif
#ifdef HM_STAGETEST
    {
        hm::prep(J, F.blk, t); HM_FULLSYNC0();
        hm::stage_data(J, false, t, IMG0); HM_FULLSYNC0();
        int bad = 0;
        for (int i = t; i < 16384; i += NT) { const int n1 = i >> 7, n0 = i & 127;
            const hm::u2 raw = __builtin_amdgcn_raw_buffer_load_b64(J.st, i * 8, 131072, 16); const f2 z = __builtin_bit_cast(f2, raw);
            const unsigned w = IMG0[n0 * hm::RS + n1]; const unsigned e = hm::pkh(z.x, z.y);
            if (w != e) bad++; }
        if (bad) atomicAdd(J.dbg, (unsigned)bad);
        HM_FULLSYNC0();
        return;
    }
#endif
    for (int c = F.blk; c < DH; c += F.G) {
        for (int _p = 0; _p < 1 + (HP == 4); ++_p) hm::prep(J, c, t);
        for (int oh = 0; oh < 4; ++oh) {
            const int o = oh >> 1; const bool tw = oh & 1;
#ifndef HP
#define HP 0
#endif
#define HREP(k) for (int _h = 0; _h < 1 + (HP == (k)); ++_h)
            HREP(1) {
            hm::stage_filter(J, c, o, tw, t, IMG0);
            asm volatile("s_waitcnt vmcnt(0)" ::: "memory");
            __syncthreads();
            hm::mfma_pass(IMG0, A, acc, lane); hm::twiddle_store(acc, IMG1, wave, lane, -1.0f, 1.0f); __syncthreads();
            hm::mfma_pass(IMG1, A, acc, lane); hm::pack_K(acc, Kh);
            if (HP == 1) __syncthreads();
            }
            HREP(2) {
            hm::stage_data(J, o, tw, t, IMG0); __syncthreads();
            hm::mfma_pass(IMG0, A, acc, lane); hm::twiddle_store(acc, IMG1, wave, lane, -1.0f, 0.125f); __syncthreads();
            hm::mfma_pass(IMG1, A, acc, lane); if (HP == 2 && _h == 0) { __syncthreads(); continue; } hm::mul_store(acc, Kh, IMG0, wave, lane); __syncthreads();
            }
            hm::flip_A(A, lane);
            HREP(3) {
            hm::mfma_pass(IMG0, A, acc, lane); hm::twiddle_store(acc, IMG1, wave, lane, 1.0f, 0.25f); __syncthreads();
            hm::mfma_pass(IMG1, A, acc, lane); hm::final_epilogue(J, acc, c, o, tw, wave, lane);
            if (HP == 3) { asm volatile("s_waitcnt vmcnt(0)" ::: "memory"); __syncthreads(); }
            }
            hm::flip_A(A, lane);
        }
        __syncthreads();
    }
}

__device__ void p4_transpose(const Frame& F) {
    LAS bf16* tile = (LAS bf16*)F.lds;
    const int t = FTID(F);
    AP_FRESH(F);
    const bf16* YH = wsp<bf16>(ap, WS_YH); bf16* Y = wsp<bf16>(ap, WS_Y);
    for (int job = F.blk; job < 8 * 512; job += F.G) {
        const int ct = job & 7, tt = job >> 3;
        { const int r = t >> 3, q = (t & 7) * 8;
          const u32x4v v = *(const u32x4v*)(YH + (size_t)(ct * 64 + r) * NTOK + tt * 64 + q);
          tile[(q + 0) * 66 + r] = (bf16)(v.x & 0xffff); tile[(q + 1) * 66 + r] = (bf16)(v.x >> 16); tile[(q + 2) * 66 + r] = (bf16)(v.y & 0xffff); tile[(q + 3) * 66 + r] = (bf16)(v.y >> 16);
          tile[(q + 4) * 66 + r] = (bf16)(v.z & 0xffff); tile[(q + 5) * 66 + r] = (bf16)(v.z >> 16); tile[(q + 6) * 66 + r] = (bf16)(v.w & 0xffff); tile[(q + 7) * 66 + r] = (bf16)(v.w >> 16); }
        __syncthreads();
        { const int tok = t >> 3, q = (t & 7) * 8;
          const LAS unsigned* p = (const LAS unsigned*)(tile + tok * 66 + q);
          u32x4v w; w.x = p[0]; w.y = p[1]; w.z = p[2]; w.w = p[3];
          *(u32x4v*)(Y + (size_t)(tt * 64 + tok) * 1024 + ct * 64 + q) = w; }
        __syncthreads();
    }
}

__device__ void p6_layernorm(const Frame& F) {
    const int lane = FLANE(F);
    AP_FRESH(F);
    float* out = ap->out; const float *ln_g = ap->in[I_LNG], *ln_b = ap->in[I_LNB];
    for (int row = F.blk * 8 + F.wave; row < NTOK; row += F.G * 8) {
        float* p = out + (size_t)row * DM;
        f32x4v v[4]; float s = 0.f;
#pragma unroll
        for (int k = 0; k < 4; ++k) { v[k] = *(const f32x4v*)(p + k * 256 + lane * 4); s += (v[k][0] + v[k][1]) + (v[k][2] + v[k][3]); }
#pragma unroll
        for (int o = 32; o >= 1; o >>= 1) s += __shfl_xor(s, o);
        const float mean = s * (1.0f / DM); float q = 0.f;
#pragma unroll
        for (int k = 0; k < 4; ++k) { const f32x4v d = v[k] - mean; q += (d[0] * d[0] + d[1] * d[1]) + (d[2] * d[2] + d[3] * d[3]); }
#pragma unroll
        for (int o = 32; o >= 1; o >>= 1) q += __shfl_xor(q, o);
        const float rstd = 1.0f / sqrtf(q * (1.0f / DM) + LN_EPS);
#pragma unroll
        for (int k = 0; k < 4; ++k) { const f32x4v g = *(const f32x4v*)(ln_g + k * 256 + lane * 4), b = *(const f32x4v*)(ln_b + k * 256 + lane * 4);
            *(f32x4v*)(p + k * 256 + lane * 4) = (v[k] - mean) * rstd * g + b; }
    }
}

#ifdef HM_SELFTEST
__device__ void hm_selftest(const Frame& F) {
    if (F.blk != 0) return;
    AP_FRESH(F);
    unsigned* flag = (unsigned*)(ap->ws + WS_CTL + 65536);
    LAS unsigned* L = (LAS unsigned*)F.lds;
    const int lane = FLANE(F);
    unsigned code = 0;
    if (F.wave == 0) {
        hm::h8 a, b;
        const int r = lane & 31, h = lane >> 5;
#pragma unroll
        for (int j = 0; j < 8; ++j) { const int k = 8 * h + j; a[j] = (_Float16)((k == (r & 15)) ? (float)(r + 1) : 0.0f); b[j] = (_Float16)(float)(k * 32 + r); }
        hm::f32x16 c;
#pragma unroll
        for (int i = 0; i < 16; ++i) c[i] = 0.0f;
        c = __builtin_amdgcn_mfma_f32_32x32x16_f16(a, b, c, 0, 0, 0);
        int bad = 0;
#pragma unroll
        for (int reg = 0; reg < 16; ++reg) { const int row = (reg & 3) + 8 * (reg >> 2) + 4 * h, col = r; const float exp = (float)(row + 1) * (float)((row & 15) * 32 + col); if (c[reg] != exp) bad = 1; }
        if (__any(bad)) code |= 1u;
        { const unsigned p = hm::pkh(1.0f, 2.0f); if (p != 0x40003c00u) code |= 2u; }
        __amdgpu_buffer_rsrc_t rs = __builtin_amdgcn_make_buffer_rsrc(ap->ws + WS_ST, (short)0, 393216, 0x00020000);
        hm::u4 w; w.x = 0x11110000u + lane; w.y = 0x22220000u + lane; w.z = 0x33330000u + lane; w.w = 0x44440000u + lane;
        __builtin_amdgcn_raw_buffer_store_b128(w, rs, lane * 16, 262144 + 5 * 8192, 0);
        asm volatile("s_waitcnt vmcnt(0)" ::: "memory");
        const hm::u4 q = __builtin_amdgcn_raw_buffer_load_b128(rs, lane * 16, 262144 + 5 * 8192, 16);
        if (__any(q.x != w.x || q.y != w.y || q.z != w.z || q.w != w.w)) code |= 4u;
        const unsigned* g = (const unsigned*)(ap->ws + WS_ST + 262144 + 5 * 8192);
        asm volatile("s_waitcnt vmcnt(0)" ::: "memory");
        if (__any(hm::asf(q.y) != __builtin_bit_cast(float, 0x22220000u + lane))) code |= 8u;
        const short s16 = __builtin_amdgcn_raw_buffer_load_b16(rs, lane * 16, 262144 + 5 * 8192 + 6, 0);
        if (__any(((unsigned short)s16) != 0x2222u)) code |= 16u;
        { const float cc = __builtin_amdgcn_cosf(0.25f), ss = __builtin_amdgcn_sinf(0.25f); if (!(fabsf(cc) < 1e-4f && fabsf(ss - 1.0f) < 1e-4f)) code |= 32u; }
        { L[lane * 4 + 0] = 0x3c000000u | 0x0000u; L[lane * 4 + 1] = hm::pkh(3.0f, 4.0f); L[lane * 4 + 2] = hm::pkh(5.0f, 6.0f); L[lane * 4 + 3] = hm::pkh(7.0f, 8.0f);
          asm volatile("s_waitcnt lgkmcnt(0)" ::: "memory");
          const hm::h8 v = *(const LAS hm::h8*)(L + lane * 4);
          if (__any(!((float)v[0] == 0.0f && (float)v[1] == 1.0f && (float)v[2] == 3.0f && (float)v[3] == 4.0f && (float)v[7] == 8.0f))) code |= 64u; }
        if (lane == 0) *flag = code;
        (void)g;
    }
}
#endif
__global__ void __launch_bounds__(NT, 2) fwd_kernel(Args args) {
    extern __shared__ __attribute__((aligned(16))) unsigned char lds_raw[];
    Frame F;
    F.lds = (LAS unsigned char*)lds_raw; F.wave = __builtin_amdgcn_readfirstlane(threadIdx.x >> 6); F.G = gridDim.x; F.blk = blockIdx.x;
    F.ap = (ArgsP)__builtin_amdgcn_kernarg_segment_ptr();
    unsigned char* ws = args.ws;
    volatile LAS unsigned* MISC = (volatile LAS unsigned*)(F.lds + LDS_MISC);
    if (threadIdx.x < 64) MISC[threadIdx.x] = 0u;
    __syncthreads();
    XcdBarrier bar; bar.bar = (unsigned*)(ws + WS_CTL); bar.x = 0; bar.st = nullptr;
    const int lo = args.ph_lo, hi = args.ph_hi;
    if (hi - lo > 1) bar = xcd_barrier_post((unsigned*)(ws + WS_CTL), MISC + 8);
#define IN(k) (lo <= (k) && (k) < hi)
#define SEAM(k) do { if (IN(k) && IN((k) + 1)) xcd_barrier(bar); } while (0)
    const int vcu = (F.G % 8 == 0) ? (F.blk % 8) * (F.G / 8) + F.blk / 8 : F.blk; (void)vcu;

#ifndef PROBE_MASK
#define PROBE_MASK 0
#endif
#define REPS(i) for (int _r = 0; _r < 1 + ((PROBE_MASK >> (i)) & 1); ++_r)
#ifdef HM_SELFTEST
    if (IN(0)) { hm_selftest(F); __syncthreads(); }
#endif
    if (IN(0)) REPS(0) { p0_prologue(F); __syncthreads(); }
    SEAM(0);
    if (IN(1)) {
        REPS(1) p1_modulate(F);
        REPS(2) { { AP_FRESH(F);
        pg8::Gemm g{wsp<bf16>(ap, WS_FWT), wsp<bf16>(ap, WS_H3), 1024, SEQ, 256}; pg8::StaticOrder S; S.init(g.M, g.N, F.G, F.blk); pg8::EpiDecay<0> E{wsp<bf16>(ap, WS_KT), SEQ};
        pg8::gemm_phase<pg8::EpiDecay<0>, pg8::StaticOrder, false>(F.lds, g, S, E, nullptr); __syncthreads(); }
        { AP_FRESH(F);
        pg8::Gemm g{wsp<bf16>(ap, WS_FWT) + (size_t)1024 * 256, (const bf16*)((unsigned char*)ap->out + 64 * MiB), 1024, SEQ, 256}; pg8::StaticOrder S; S.init(g.M, g.N, F.G, F.blk); pg8::EpiDecay<1> E{wsp<bf16>(ap, WS_KT) + (size_t)1024 * SEQ, SEQ};
        pg8::gemm_phase<pg8::EpiDecay<1>, pg8::StaticOrder, false>(F.lds, g, S, E, nullptr); __syncthreads(); } }
    }
    SEAM(1);
    if (IN(2)) {
        REPS(3) { AP_FRESH(F);
          pg8::Gemm g{wsp<bf16>(ap, WS_WINT), wsp<bf16>(ap, WS_U), 2048, NTOK, DM}; pg8::StaticOrder S; S.init(g.M, g.N, F.G, F.blk); pg8::EpiRowBias E{wsp<bf16>(ap, WS_CH), NTOK, ap->in[I_BIN]};
          pg8::gemm_phase<pg8::EpiRowBias, pg8::StaticOrder, false>(F.lds, g, S, E, nullptr); __syncthreads(); }
        REPS(4) { AP_FRESH(F);
          pg8::Gemm g{wsp<bf16>(ap, WS_U), wsp<bf16>(ap, WS_WINT) + (size_t)2048 * DM, NTOK, 1024, DM}; pg8::StaticOrder S; S.init(g.M, g.N, F.G, F.blk); pg8::EpiBf16<0> E{wsp<bf16>(ap, WS_TP), 1024, ap->in[I_BIN] + 2048, 0, 0};
          pg8::gemm_phase<pg8::EpiBf16<0>, pg8::StaticOrder, false>(F.lds, g, S, E, nullptr); __syncthreads(); }
    }
    SEAM(2);
#if defined(HM_IDFILT) || defined(HM_STAGETEST)
    if (IN(3)) { { AP_FRESH(F); p3_hyena_old(F, wsp<bf16>(ap, WS_YH)); } __syncthreads(); { AP_FRESH(F); p3_hyena(F, (bf16*)ap->out); } __syncthreads(); p3_pool(F); }
#elif defined(HM_FFTTEST)
    if (IN(3)) { { AP_FRESH(F); p3_hyena_old(F, wsp<bf16>(ap, WS_YH)); } __syncthreads(); p3_hyena(F, nullptr); __syncthreads(); p3_pool(F); }
#elif defined(HM_COMPARE)
    if (IN(3)) { { AP_FRESH(F); p3_hyena_old(F, wsp<bf16>(ap, WS_YH)); } __syncthreads(); { AP_FRESH(F); p3_hyena(F, (bf16*)ap->out); } __syncthreads();
        { AP_FRESH(F); const bf16* Y1 = wsp<bf16>(ap, WS_YH); const bf16* Y2 = (const bf16*)ap->out; unsigned* cnt = (unsigned*)(ap->ws + WS_CTL + 65536 + 256);
          LAS float* red = (LAS float*)F.lds;
          for (int c = F.blk; c < DH; c += F.G) { float md = 0.f, mr = 0.f;
              for (int i = FTID(F); i < NTOK; i += NT) { const float a = bflo((unsigned)Y1[(size_t)c * NTOK + i]), b = bflo((unsigned)Y2[(size_t)c * NTOK + i]); md = fmaxf(md, fabsf(a - b)); mr = fmaxf(mr, fabsf(a)); if (!(b == b)) md = 1e30f; }
              __syncthreads(); red[FTID(F)] = md; red[NT + FTID(F)] = mr; __syncthreads();
              if (FTID(F) == 0) { float m1 = 0.f, m2 = 0.f; for (int k = 0; k < NT; ++k) { m1 = fmaxf(m1, red[k]); m2 = fmaxf(m2, red[NT + k]); }
                  if (m1 > HM_CMP_TOL * m2) atomicAdd(cnt, 1u); }
              __syncthreads(); } }
        p3_pool(F); }
#else
    if (IN(3)) { REPS(5) p3_hyena(F, nullptr); REPS(6) p3_pool(F); }
#endif
    SEAM(3);
    if (IN(4)) {
        REPS(7) p4_transpose(F);
        __syncthreads();
        REPS(8) { AP_FRESH(F);
        pg8::Gemm g{wsp<bf16>(ap, WS_PP), wsp<bf16>(ap, WS_PWT), NTOK, 512, 512}; pg8::StaticOrder S; S.init(g.M, g.N, F.G, F.blk); pg8::EpiPoolGate E{wsp<bf16>(ap, WS_Y), wsp<bf16>(ap, WS_TP)};
        pg8::gemm_phase<pg8::EpiPoolGate, pg8::StaticOrder, false>(F.lds, g, S, E, nullptr); __syncthreads(); }
    }
    SEAM(4);
    if (IN(5)) {
        REPS(9) { AP_FRESH(F);
        pg8::Gemm g{wsp<bf16>(ap, WS_Y), wsp<bf16>(ap, WS_WOUTT), NTOK, DM, DM}; pg8::StaticOrder S; S.init(g.M, g.N, F.G, F.blk); pg8::EpiResGate E{ap->out, ap->in[I_X], wsp<float>(ap, WS_MOD), ap->in[I_BOUT], DN_ALPHA};
        pg8::gemm_phase<pg8::EpiResGate, pg8::StaticOrder, false>(F.lds, g, S, E, nullptr); __syncthreads(); }
    }
    SEAM(5);
    if (IN(6)) p6_layernorm(F);
#ifdef HM_SELFTEST
    if (IN(6) && F.blk == 0) { __syncthreads(); AP_FRESH(F); const unsigned code = *(const unsigned*)(ap->ws + WS_CTL + 65536); if (FTID(F) == 0 && code) ap->out[0] = 1000.0f * (float)code; }
#endif
#if defined(HM_FFTTEST) || defined(HM_IDFILT) || defined(HM_STAGETEST)
    if (IN(6) && F.blk == 0) { __syncthreads(); AP_FRESH(F); const unsigned n = __hip_atomic_load((unsigned*)(ap->ws + WS_CTL + 65536 + 512), __ATOMIC_RELAXED, __HIP_MEMORY_SCOPE_AGENT); if (FTID(F) == 0) { ap->out[0] = 10.0f * (float)n + 50.0f; const unsigned n2 = __hip_atomic_load((unsigned*)(ap->ws + WS_CTL + 65536 + 516), __ATOMIC_RELAXED, __HIP_MEMORY_SCOPE_AGENT); if (n2) ap->out[1] = 1.0e10f + 1.0e6f * (float)n2; } }
#endif
#ifdef HM_COMPARE
    if (IN(6) && F.blk == 0) { __syncthreads(); AP_FRESH(F); const unsigned n = __hip_atomic_load((unsigned*)(ap->ws + WS_CTL + 65536 + 256), __ATOMIC_RELAXED, __HIP_MEMORY_SCOPE_AGENT); if (FTID(F) == 0) ap->out[0] = 100.0f * (float)n + 50.0f; }
#endif
#undef IN
#undef SEAM
}

extern "C" void kernel_launch(void* const* d_in, const int* in_sizes, int n_in, void* d_out, int out_size, void* d_ws, size_t ws_size, hipStream_t stream) {
    static int grid = 0;
    if (grid == 0) {
        if (n_in != 21 || in_sizes[0] != NTOK * DM || out_size != NTOK * DM || ws_size < WS_END) {
            fprintf(stderr, "kernel_launch: unexpected shapes (n_in %d, in0 %d, out %d, ws %zu < %zu)\n", n_in, n_in > 0 ? in_sizes[0] : -1, out_size, ws_size, (size_t)WS_END); grid = -1; return; }
        int dev = 0, cus = 0, per_cu = 0;
        if (hipGetDevice(&dev) != hipSuccess || hipDeviceGetAttribute(&cus, hipDeviceAttributeMultiprocessorCount, dev) != hipSuccess) { grid = -1; return; }
        if (hipFuncSetAttribute((const void*)fwd_kernel, hipFuncAttributeMaxDynamicSharedMemorySize, LDS_BYTES) != hipSuccess) { fprintf(stderr, "kernel_launch: hipFuncSetAttribute failed\n"); grid = -1; return; }
        if (hipOccupancyMaxActiveBlocksPerMultiprocessor(&per_cu, (const void*)fwd_kernel, NT, LDS_BYTES) != hipSuccess || per_cu < 1) { fprintf(stderr, "kernel_launch: occupancy query says %d blocks per CU\n", per_cu); }
        (void)hipGetLastError();
        grid = cus;
    }
    if (grid < 0) return;
    (void)hipMemsetAsync((char*)d_ws + WS_CTL, 0, CTL_BYTES, stream);
    Args a{};
    for (int i = 0; i < 21; ++i) a.in[i] = (const float*)d_in[i];
    a.out = (float*)d_out; a.ws = (unsigned char*)d_ws;
    if (MK_N_LAUNCHES == 1) { a.ph_lo = 0; a.ph_hi = N_PHASES; hipLaunchKernelGGL(fwd_kernel, dim3(grid), dim3(NT), LDS_BYTES, stream, a); }
    else for (int p = 0; p < N_PHASES; ++p) { a.ph_lo = p; a.ph_hi = p + 1; hipLaunchKernelGGL(fwd_kernel, dim3(grid), dim3(NT), LDS_BYTES, stream, a); }
}
```
